# Optimizing an MI355X kernel written in HIP

```python
import math
import jax, jax.numpy as jnp
from jax import lax
import numpy as np

D_MODEL = 1024
BATCH = 8
SEQ = 2048
DEPTH = 1

D_SSM = 512
SSM_GROUP_WIDTH = 16
SSM_GROUPS = D_SSM // SSM_GROUP_WIDTH
SSM_STATE = 64
DT_MIN = 0.001
DT_MAX = 0.1
D_CONV = 512
CONV_WIDTH = 31
D_IN = D_SSM + 2 * D_CONV + 2 * D_MODEL
N_GROUPS_MOE = 4
EXPERTS_PER_GROUP = 8
N_EXPERTS = N_GROUPS_MOE * EXPERTS_PER_GROUP
TOPK_IN_GROUP = 2
D_EXPERT = 512
ROW_BLOCK = 128
D_PLE = 256
EPS = 1e-6

kernel_name = "hybrid_s5_conformer_hiermoe_block"


def rmsnorm(x, g):
    x32 = x.astype(jnp.float32)
    y = x32 * lax.rsqrt(jnp.mean(x32 * x32, axis=-1, keepdims=True) + EPS)
    return (y * g.astype(jnp.float32)).astype(x.dtype)


def layernorm(x, g, b):
    x32 = x.astype(jnp.float32)
    mu = jnp.mean(x32, axis=-1, keepdims=True)
    var = jnp.mean(jnp.square(x32 - mu), axis=-1, keepdims=True)
    y = (x32 - mu) * lax.rsqrt(var + EPS)
    return (y * g.astype(jnp.float32) + b.astype(jnp.float32)).astype(x.dtype)


def _complex_affine_combine(earlier, later):
    a_re, a_im, b_re, b_im = earlier
    c_re, c_im, d_re, d_im = later
    n_a_re = c_re * a_re - c_im * a_im
    n_a_im = c_re * a_im + c_im * a_re
    n_b_re = c_re * b_re - c_im * b_im + d_re
    n_b_im = c_re * b_im + c_im * b_re + d_im
    return (n_a_re, n_a_im, n_b_re, n_b_im)


def s5_ssm(u, a_re, a_im, log_dt, b_re, b_im, c_re, c_im, d):
    bsz, seq, _ = u.shape
    u32 = u.astype(jnp.float32).reshape(bsz, seq, SSM_GROUPS, SSM_GROUP_WIDTH)
    ar = a_re.astype(jnp.float32)
    ai = a_im.astype(jnp.float32)
    dt = jnp.exp(log_dt.astype(jnp.float32))[:, None]
    mag = jnp.exp(ar * dt)
    lam_re = mag * jnp.cos(ai * dt)
    lam_im = mag * jnp.sin(ai * dt)
    den = ar * ar + ai * ai
    nr = lam_re - 1.0
    ni = lam_im
    z_re = (nr * ar + ni * ai) / den
    z_im = (ni * ar - nr * ai) / den
    br = b_re.astype(jnp.float32)
    bi = b_im.astype(jnp.float32)
    bbar_re = z_re[..., None] * br - z_im[..., None] * bi
    bbar_im = z_re[..., None] * bi + z_im[..., None] * br
    bu_re = jnp.einsum('blgc,gnc->blgn', u32, bbar_re)
    bu_im = jnp.einsum('blgc,gnc->blgn', u32, bbar_im)
    lam_re_b = jnp.broadcast_to(lam_re, bu_re.shape)
    lam_im_b = jnp.broadcast_to(lam_im, bu_im.shape)
    _, _, s_re, s_im = lax.associative_scan(
        _complex_affine_combine, (lam_re_b, lam_im_b, bu_re, bu_im), axis=1)
    y = (jnp.einsum('blgn,gcn->blgc', s_re, c_re.astype(jnp.float32))
         - jnp.einsum('blgn,gcn->blgc', s_im, c_im.astype(jnp.float32)))
    y = y.reshape(bsz, seq, D_SSM) + d.astype(jnp.float32) * u32.reshape(bsz, seq, D_SSM)
    return y.astype(u.dtype)


def conformer_conv(v, dw, dw_b, ln_g, ln_b, w_pw_out):
    val, gate = jnp.split(v, 2, axis=-1)
    z = val * jax.nn.sigmoid(gate)
    z = lax.conv_general_dilated(
        z, dw[:, None, :].astype(z.dtype), window_strides=(1,),
        padding=[(CONV_WIDTH - 1, 0)],
        dimension_numbers=('NWC', 'WIO', 'NWC'),
        feature_group_count=D_CONV) + dw_b
    z = layernorm(z, ln_g, ln_b)
    z = jax.nn.silu(z)
    return z @ w_pw_out


def hierarchical_moe(h, w_rg, b_rg, w_re, b_re, w_gate, w_up, w_down):
    bsz, seq, dm = h.shape
    n_tok = bsz * seq
    ht = h.reshape(n_tok, dm)
    g_logits = (ht @ w_rg + b_rg).astype(jnp.float32)
    g_prob = jax.nn.softmax(g_logits, axis=-1)
    g_sel = jnp.argmax(g_logits, axis=-1).astype(jnp.int32)
    p_g = jnp.take_along_axis(g_prob, g_sel[:, None], axis=1)[:, 0]
    e_logits = (ht @ w_re + b_re).astype(jnp.float32).reshape(n_tok, N_GROUPS_MOE, EXPERTS_PER_GROUP)
    e_sel_logits = jnp.take_along_axis(e_logits, g_sel[:, None, None], axis=1)[:, 0]
    top_v, top_j = lax.top_k(e_sel_logits, TOPK_IN_GROUP)
    wts = jax.nn.softmax(top_v, axis=-1) * p_g[:, None]
    eid = (g_sel[:, None] * EXPERTS_PER_GROUP + top_j).reshape(-1).astype(jnp.int32)
    tok = jnp.repeat(jnp.arange(n_tok, dtype=jnp.int32), TOPK_IN_GROUP)
    wflat = wts.reshape(-1)
    n_assign = n_tok * TOPK_IN_GROUP

    order = jnp.argsort(eid)
    e_sorted = eid[order]
    counts = jnp.bincount(eid, length=N_EXPERTS).astype(jnp.int32)
    starts = jnp.cumsum(counts) - counts
    pcounts = (counts + ROW_BLOCK - 1) // ROW_BLOCK * ROW_BLOCK
    pends = jnp.cumsum(pcounts)
    pstarts = pends - pcounts
    dest = pstarts[e_sorted] + jnp.arange(n_assign, dtype=jnp.int32) - starts[e_sorted]
    n_blocks = (n_assign + N_EXPERTS * (ROW_BLOCK - 1) + ROW_BLOCK - 1) // ROW_BLOCK
    n_rows = n_blocks * ROW_BLOCK
    row_tok = jnp.full((n_rows,), n_tok, jnp.int32).at[dest].set(tok[order])
    row_w = jnp.zeros((n_rows,), jnp.float32).at[dest].set(wflat[order])
    blk_exp = jnp.minimum(
        jnp.searchsorted(pends, jnp.arange(n_blocks, dtype=jnp.int32) * ROW_BLOCK, side='right'),
        N_EXPERTS - 1).astype(jnp.int32)
    x_pad = jnp.concatenate([ht, jnp.zeros((1, dm), ht.dtype)], axis=0)
    xr = x_pad[row_tok].reshape(n_blocks, ROW_BLOCK, dm)

    def expert_block(args):
        xb, e = args
        return (jax.nn.silu(xb @ w_gate[e]) * (xb @ w_up[e])) @ w_down[e]

    yr = lax.map(expert_block, (xr, blk_exp)).reshape(n_rows, dm)
    out = jnp.zeros((n_tok, dm), h.dtype).at[row_tok].add(
        yr * row_w[:, None].astype(h.dtype), mode='drop')
    return out.reshape(bsz, seq, dm)


def setup_inputs(seed: int = 0) -> dict:
    key = jax.random.key(seed)
    ks = jax.random.split(key, 40)
    f32 = jnp.float32
    L, D = DEPTH, D_MODEL
    G, N, C = SSM_GROUPS, SSM_STATE, SSM_GROUP_WIDTH

    def nrm(k, shape, scale):
        return jax.random.normal(k, shape, f32) * scale

    def gain(k, shape):
        return 1.0 + 0.02 * jax.random.normal(k, shape, f32)

    a_re = -0.5 + 0.01 * jax.random.normal(ks[3], (L, G, N), f32)
    a_im = (math.pi * jnp.arange(N, dtype=f32))[None, None, :] + 0.01 * jax.random.normal(ks[4], (L, G, N), f32)
    log_dt = jax.random.uniform(ks[5], (L, G), f32, math.log(DT_MIN), math.log(DT_MAX))
    return {
        "x": jax.random.normal(ks[0], (BATCH, SEQ, D), f32),
        "p": jax.random.normal(ks[1], (DEPTH, BATCH, SEQ, D_PLE), f32),
        "g_mix": gain(ks[2], (L, D)),
        "w_in": nrm(ks[6], (L, D, D_IN), D ** -0.5),
        "b_gate": nrm(ks[7], (L, 2 * D), 0.02),
        "ssm_a_re": a_re,
        "ssm_a_im": a_im,
        "ssm_log_dt": log_dt,
        "ssm_b_re": nrm(ks[8], (L, G, N, C), (2 * C) ** -0.5),
        "ssm_b_im": nrm(ks[9], (L, G, N, C), (2 * C) ** -0.5),
        "ssm_c_re": nrm(ks[10], (L, G, C, N), N ** -0.5),
        "ssm_c_im": nrm(ks[11], (L, G, C, N), N ** -0.5),
        "ssm_d": nrm(ks[12], (L, D_SSM), 1.0),
        "w_glu": nrm(ks[13], (L, D_SSM, 2 * D), D_SSM ** -0.5),
        "conv_dw": nrm(ks[14], (L, CONV_WIDTH, D_CONV), CONV_WIDTH ** -0.5),
        "conv_dw_b": nrm(ks[15], (L, D_CONV), 0.02),
        "conv_ln_g": gain(ks[16], (L, D_CONV)),
        "conv_ln_b": nrm(ks[17], (L, D_CONV), 0.02),
        "w_conv_out": nrm(ks[18], (L, D_CONV, D), D_CONV ** -0.5),
        "w_out": nrm(ks[19], (L, D, D), D ** -0.5),
        "g_moe": gain(ks[20], (L, D)),
        "w_router_group": nrm(ks[21], (L, D, N_GROUPS_MOE), D ** -0.5),
        "b_router_group": nrm(ks[22], (L, N_GROUPS_MOE), 0.01),
        "w_router_expert": nrm(ks[23], (L, D, N_EXPERTS), D ** -0.5),
        "b_router_expert": nrm(ks[24], (L, N_EXPERTS), 0.01),
        "w_exp_gate": nrm(ks[25], (L, N_EXPERTS, D, D_EXPERT), D ** -0.5),
        "w_exp_up": nrm(ks[26], (L, N_EXPERTS, D, D_EXPERT), D ** -0.5),
        "w_exp_down": nrm(ks[27], (L, N_EXPERTS, D_EXPERT, D), D_EXPERT ** -0.5),
        "g_ple": gain(ks[28], (L, D)),
        "w_ple_gate": nrm(ks[29], (L, D, D), D ** -0.5),
        "w_ple": nrm(ks[30], (L, D_PLE, D), D_PLE ** -0.5),
        "g_final": gain(ks[31], (D,)),
    }


def reference(x, p, g_mix, w_in, b_gate, ssm_a_re, ssm_a_im, ssm_log_dt, ssm_b_re, ssm_b_im,
              ssm_c_re, ssm_c_im, ssm_d, w_glu, conv_dw, conv_dw_b, conv_ln_g, conv_ln_b,
              w_conv_out, w_out, g_moe, w_router_group, b_router_group, w_router_expert,
              b_router_expert, w_exp_gate, w_exp_up, w_exp_down, g_ple, w_ple_gate, w_ple,
              g_final):
    for i in range(DEPTH):
        h = rmsnorm(x, g_mix[i])
        proj = h @ w_in[i]
        u_ssm = proj[..., :D_SSM]
        v_conv = proj[..., D_SSM:D_SSM + 2 * D_CONV]
        gates = proj[..., D_SSM + 2 * D_CONV:] + b_gate[i]
        gate_ssm, gate_conv = jnp.split(gates, 2, axis=-1)

        y = s5_ssm(u_ssm, ssm_a_re[i], ssm_a_im[i], ssm_log_dt[i], ssm_b_re[i], ssm_b_im[i],
                   ssm_c_re[i], ssm_c_im[i], ssm_d[i])
        z_val, z_gate = jnp.split(jax.nn.gelu(y) @ w_glu[i], 2, axis=-1)
        y_ssm = z_val * jax.nn.sigmoid(z_gate)

        y_conv = conformer_conv(v_conv, conv_dw[i], conv_dw_b[i], conv_ln_g[i], conv_ln_b[i],
                                w_conv_out[i])

        merged = jax.nn.sigmoid(gate_ssm) * y_ssm + jax.nn.sigmoid(gate_conv) * y_conv
        x = x + merged @ w_out[i]

        x = x + hierarchical_moe(rmsnorm(x, g_moe[i]), w_router_group[i], b_router_group[i],
                                 w_router_expert[i], b_router_expert[i], w_exp_gate[i],
                                 w_exp_up[i], w_exp_down[i])

        ple_gate = jax.nn.sigmoid(rmsnorm(x, g_ple[i]) @ w_ple_gate[i])
        x = x + ple_gate * (p[i] @ w_ple[i])
    return rmsnorm(x, g_final)
```

```cpp
#include <hip/hip_runtime.h>
#include <cstdio>
#include <cstdint>

namespace pg8 {
#define PG8_LAS __attribute__((address_space(3)))
typedef unsigned short bf16_t;
typedef short bf16x8 __attribute__((ext_vector_type(8)));
typedef float f32x4 __attribute__((ext_vector_type(4)));
typedef unsigned u32x4 __attribute__((ext_vector_type(4)));
typedef unsigned u32x2 __attribute__((ext_vector_type(2)));
constexpr int BM = 256, BK = 64, HALF = 128, HTB = HALF * BK * 2  , STAGE_BYTES = 8 * HTB, NXCD = 8, WGM = 8;

__host__ __device__ __forceinline__ int lds_byte(int r, int c) { const int st = (r >> 4) * 2 + (c >> 5), rr = r & 15, cc = c & 31, ob = rr * 64 + cc * 2; return st * 1024 + (ob ^ (((ob >> 9) & 1) << 5)); }
__host__ __device__ __forceinline__ void stage_rc(int b, int& R, int& C) { const int st = b / 1024, sb = b % 1024, swz = sb ^ (((sb >> 9) & 1) << 5); R = (st >> 1) * 16 + swz / 64; C = (st & 1) * 32 + (swz % 64) / 2; }
__host__ __device__ __forceinline__ int perm32(int rho) { const int n = rho >> 4, i = rho & 15; return 8 * (i >> 2) + 4 * n + (i & 3); }

struct Unit { int pm, pn, e, rows, mt; };

typedef float cvt_f32x2 __attribute__((ext_vector_type(2)));
typedef __bf16 cvt_bf16x2 __attribute__((ext_vector_type(2)));
__device__ __forceinline__ unsigned cvt_pk_bf16(float lo, float hi) { const cvt_f32x2 v = {lo, hi}; const cvt_bf16x2 b = __builtin_convertvector(v, cvt_bf16x2); return __builtin_bit_cast(unsigned, b); }

struct StaticOrder {
    int nM, nN, nwg, G, c;
    __host__ __device__ void init(int M, int N, int G_, int c_) { nM = M / BM; nN = N / BM; nwg = nM * nN; G = G_; c = c_; }
    __host__ __device__ bool next(int i, Unit& u) const {
        const long L = (long)i * G + c; if (L >= nwg) return false;
        int wgid = (int)L; { const int q = nwg / NXCD, r = nwg % NXCD, xcd = wgid % NXCD, off = wgid / NXCD; wgid = (xcd < r ? xcd * (q + 1) : r * (q + 1) + (xcd - r) * q) + off; }
        const int nig = WGM * nN, gid = wgid / nig, fm = gid * WGM, gsz = (nM - fm) < WGM ? (nM - fm) : WGM;
        u.pm = fm + ((wgid % nig) % gsz); u.pn = (wgid % nig) / gsz; u.e = 0; u.rows = BM; u.mt = 0; return true;
    }
};

template <class Epi, class Sched, bool GATHER = false, bool ALIGN_EPI = true>
__device__ __forceinline__ void gemm_phase(PG8_LAS unsigned char* lds, const int tid, const int K, const Sched& S, const Epi& E) {
    const int wid = __builtin_amdgcn_readfirstlane(tid >> 6), lane = tid & 63, wr = wid >> 2, wc = wid & 3, fr = lane & 15, fq = lane >> 4;
    const int nt = K / BK;
    unsigned voffA[2], voffB[2]; int rowA[2], colA[2];
#pragma unroll
    for (int i = 0; i < 2; ++i) { int R, C; stage_rc(tid * 16 + i * 8192, R, C); const int Rb = (R & ~31) + perm32(R & 31);
        voffA[i] = (unsigned)(R * K + C) * 2u; voffB[i] = (unsigned)(Rb * K + C) * 2u; rowA[i] = R; colA[i] = C * 2; }
    const size_t kstep = (size_t)(BK * 2);
    const unsigned hstep = (unsigned)HALF * (unsigned)K * 2u;
    const unsigned ldsw = (unsigned)wid * 1024u;
    const int aoff = lds_byte(wr * 64 + fr, fq * 8), boff = lds_byte(wc * 32 + fr, fq * 8);
#define PG8_SA(b, h) (((b) * 2 + (h)) * HTB)
#define PG8_SB(b, h) ((4 + (b) * 2 + (h)) * HTB)
#define PG8_STAGE(bufoff, gbase, voff) do { _Pragma("unroll") for (int _i = 0; _i < 2; ++_i) \
        __builtin_amdgcn_global_load_lds((const unsigned*)((const char*)(gbase) + (voff)[_i]), (PG8_LAS unsigned*)(lds + (bufoff) + ldsw + _i * 8192), 16, 0, 0); } while (0)
#define PG8_STAGE_A(bufoff, gbase, V, h) do { _Pragma("unroll") for (int _i = 0; _i < 2; ++_i) { const unsigned _o = GATHER ? (V)[h][_i] : (voffA[_i] + (unsigned)(h) * hstep); \
        __builtin_amdgcn_global_load_lds((const unsigned*)((const char*)(gbase) + _o), (PG8_LAS unsigned*)(lds + (bufoff) + ldsw + _i * 8192), 16, 0, 0); } } while (0)
#define PG8_LDA(dst, b, h) do { _Pragma("unroll") for (int m = 0; m < 4; ++m) _Pragma("unroll") for (int k = 0; k < 2; ++k) dst[m][k] = *(const PG8_LAS bf16x8*)(lds + PG8_SA(b, h) + aoff + m * 2048 + k * 1024); } while (0)
#define PG8_LDB(dst, b, h) do { _Pragma("unroll") for (int n = 0; n < 2; ++n) _Pragma("unroll") for (int k = 0; k < 2; ++k) dst[n][k] = *(const PG8_LAS bf16x8*)(lds + PG8_SB(b, h) + boff + n * 2048 + k * 1024); } while (0)
#define PG8_MMA(ai, bj, At, Bt) do { __builtin_amdgcn_s_setprio(1); _Pragma("unroll") for (int m = 0; m < 4; ++m) _Pragma("unroll") for (int n = 0; n < 2; ++n) _Pragma("unroll") for (int k = 0; k < 2; ++k) \
        acc[ai][bj][m][n] = __builtin_amdgcn_mfma_f32_16x16x32_bf16(Bt[n][k], At[m][k], acc[ai][bj][m][n], 0, 0, 0); __builtin_amdgcn_s_setprio(0); } while (0)
#define PG8_WAIT_V(n) asm volatile("s_waitcnt vmcnt(" #n ")" ::: "memory")
#define PG8_WAIT_L(n) asm volatile("s_waitcnt lgkmcnt(" #n ")" ::: "memory")
#define PG8_BAR __builtin_amdgcn_s_barrier()
#define PG8_SCHED __builtin_amdgcn_sched_barrier(0)
    Unit cur, nxt; int ui = 0;
    if (!S.next(0, cur)) return;
    f32x4 acc[2][2][4][2];
#pragma unroll
    for (int a = 0; a < 2; ++a)
#pragma unroll
        for (int b = 0; b < 2; ++b)
#pragma unroll
            for (int m = 0; m < 4; ++m)
#pragma unroll
                for (int n = 0; n < 2; ++n) acc[a][b][m][n] = (f32x4){0.f, 0.f, 0.f, 0.f};
    bf16x8 At[4][2], B0[2][2], B1[2][2];
    unsigned cva[2][2] = {{0u, 0u}, {0u, 0u}}, nva[2][2] = {{0u, 0u}, {0u, 0u}};
    const char* cA = S.a_base(cur); const char* cB = S.b_base(cur);
    if constexpr (GATHER) {
#pragma unroll
        for (int h = 0; h < 2; ++h)
#pragma unroll
            for (int i = 0; i < 2; ++i) cva[h][i] = S.row_off(cur, h * HALF + rowA[i]) + (unsigned)colA[i];
    }
    PG8_STAGE(PG8_SB(0, 0), cB, voffB); PG8_STAGE(PG8_SB(0, 1), cB + hstep, voffB); PG8_STAGE_A(PG8_SA(0, 0), cA, cva, 0); PG8_STAGE_A(PG8_SA(0, 1), cA, cva, 1);
    if (wr == 1) PG8_BAR;
    PG8_WAIT_V(2); PG8_BAR;
    PG8_STAGE(PG8_SB(1, 0), cB + kstep, voffB); PG8_STAGE_A(PG8_SA(1, 0), cA + kstep, cva, 0); PG8_STAGE(PG8_SB(1, 1), cB + hstep + kstep, voffB);
    PG8_WAIT_V(6); PG8_BAR;
    for (;;) {
        const bool has_next = S.next(ui + 1, nxt);
        const char* nA = has_next ? S.a_base(nxt) : cA; const char* nB = has_next ? S.b_base(nxt) : cB;
        if constexpr (GATHER) {
#pragma unroll
            for (int h = 0; h < 2; ++h)
#pragma unroll
                for (int i = 0; i < 2; ++i) nva[h][i] = has_next ? (S.row_off(nxt, h * HALF + rowA[i]) + (unsigned)colA[i]) : cva[h][i];
        }
#pragma unroll 1
        for (int t = 0; t < nt; t += 2) {
            const bool last = (t == nt - 2);
            const char* a1 = cA + (size_t)(t + 1) * kstep;
            const char* a2 = last ? nA : cA + (size_t)(t + 2) * kstep; const char* b2 = last ? nB : cB + (size_t)(t + 2) * kstep;
            const char* a3 = a2 + kstep; const char* b3 = b2 + kstep;
            PG8_LDB(B0, 0, 0); PG8_LDB(B1, 0, 1); PG8_SCHED; PG8_LDA(At, 0, 0); PG8_STAGE_A(PG8_SA(1, 1), a1, cva, 1);
            if constexpr (GATHER) { if (last) {
#pragma unroll
                for (int h = 0; h < 2; ++h)
#pragma unroll
                    for (int i = 0; i < 2; ++i) cva[h][i] = nva[h][i]; } }
            PG8_WAIT_V(8); PG8_WAIT_L(0); PG8_BAR; PG8_MMA(0, 0, At, B0); PG8_MMA(0, 1, At, B1); PG8_BAR; PG8_SCHED;
            PG8_LDA(At, 0, 1); PG8_STAGE(PG8_SB(0, 0), b2, voffB); PG8_STAGE(PG8_SB(0, 1), b2 + hstep, voffB); PG8_STAGE_A(PG8_SA(0, 0), a2, cva, 0);
            PG8_WAIT_V(8); PG8_WAIT_L(0); PG8_BAR; PG8_MMA(1, 0, At, B0); PG8_MMA(1, 1, At, B1); PG8_BAR; PG8_SCHED;
            PG8_LDB(B0, 1, 0); PG8_LDB(B1, 1, 1); PG8_SCHED; PG8_LDA(At, 1, 0); PG8_STAGE_A(PG8_SA(0, 1), a2, cva, 1);
            PG8_WAIT_V(8); PG8_WAIT_L(0); PG8_BAR; PG8_MMA(0, 0, At, B0); PG8_MMA(0, 1, At, B1); PG8_BAR; PG8_SCHED;
            PG8_LDA(At, 1, 1); PG8_STAGE(PG8_SB(1, 0), b3, voffB); PG8_STAGE(PG8_SB(1, 1), b3 + hstep, voffB); PG8_STAGE_A(PG8_SA(1, 0), a3, cva, 0);
            PG8_WAIT_V(8); PG8_WAIT_L(0); PG8_BAR; PG8_MMA(1, 0, At, B0); PG8_MMA(1, 1, At, B1); PG8_BAR; PG8_SCHED;
        }
        if constexpr (ALIGN_EPI) { if (wr == 0) PG8_BAR; }
#ifdef DBG_EPI_NOP
        asm volatile("s_nop 15\n s_nop 15\n s_nop 15\n s_nop 15" ::: "memory");
#endif
        E(acc, cur, wr, wc, fr, fq);
        if (!has_next) break;
#pragma unroll
        for (int a = 0; a < 2; ++a)
#pragma unroll
            for (int b = 0; b < 2; ++b)
#pragma unroll
                for (int m = 0; m < 4; ++m)
#pragma unroll
                    for (int n = 0; n < 2; ++n) acc[a][b][m][n] = (f32x4){0.f, 0.f, 0.f, 0.f};
        cur = nxt; cA = nA; cB = nB; ++ui;
        if constexpr (ALIGN_EPI) { if (wr == 1) PG8_BAR; }
    }
    PG8_WAIT_V(0);
    if constexpr (!ALIGN_EPI) { if (wr == 0) PG8_BAR; }
    PG8_BAR;
#undef PG8_SA
#undef PG8_SB
#undef PG8_STAGE
#undef PG8_STAGE_A
#undef PG8_LDA
#undef PG8_LDB
#undef PG8_MMA
#undef PG8_WAIT_V
#undef PG8_WAIT_L
#undef PG8_BAR
#undef PG8_SCHED
}
}

constexpr int NWAVES = 8;
#ifndef MK_N_LAUNCHES
#define MK_N_LAUNCHES 1
#endif
constexpr int PER_PHASE = 13;
constexpr int N_LAUNCHES = MK_N_LAUNCHES;

constexpr int NTOK = 16384, SEQ = 2048, D = 1024, DIN = 3584, DSSM = 512, DCONV = 512, NGRP = 32, NST = 64, GWID = 16, CONVW = 31;
constexpr int NEXP = 32, EPG = 8, DEXP = 512, DPLE = 256, LC = 32, NCH = 64;
constexpr float EPS = 1e-6f;
enum In { I_X = 0, I_P, I_GMIX, I_WIN, I_BGATE, I_ARE, I_AIM, I_LOGDT, I_BRE, I_BIM, I_CRE, I_CIM, I_SD, I_WGLU, I_CDW, I_CDWB, I_CLNG, I_CLNB, I_WCO, I_WOUT, I_GMOE, I_WRG, I_BRG, I_WRE, I_BRE2,
          I_WEG, I_WEU, I_WED, I_GPLE, I_WPG, I_WPLE, I_GFIN, N_IN };

constexpr size_t MiB = 1u << 20;
constexpr size_t WS_CTL = 0, CTL_ZERO_BYTES = 1 * MiB;
constexpr size_t WS_LTOK = 1 * MiB;
constexpr size_t WS_LW = 3 * MiB;
constexpr size_t WS_R2 = 5 * MiB, WS_R3 = WS_R2 + 65536, WS_LAM32 = WS_R3 + 65536, WS_WRT = WS_R2 + 262144;
constexpr size_t WS_WST = 6 * MiB;
constexpr size_t WS_BT2 = 10 * MiB;
constexpr size_t WS_WIN = 31 * MiB, WS_WGLU = 38 * MiB, WS_WCO = 40 * MiB, WS_WO = 41 * MiB, WS_WPG = 43 * MiB, WS_WPLE = 45 * MiB;
constexpr size_t WS_PB = 46 * MiB;
constexpr size_t WS_WGU = 54 * MiB;
constexpr size_t WS_WD = 118 * MiB;
constexpr size_t WS_B = 150 * MiB;
constexpr size_t WS_C = 182 * MiB;
constexpr size_t WS_E = 224 * MiB;
constexpr size_t WS_END = 288 * MiB;
constexpr int CW_TMO = 0, CW_CODE = 1, CW_BAR = 4096, CW_ECNT = 16384;
static_assert((CW_ECNT + 64 * NEXP) * 4 <= (int)CTL_ZERO_BYTES, "CTL words inside the memset region");

constexpr int RING_OFF = 0, RING_BYTES = 131072;
constexpr int LDSCTL_OFF = RING_BYTES, MISC_OFF = LDSCTL_OFF + 320;
constexpr int TB_OFF = LDSCTL_OFF + 1024;
constexpr int LDS_BYTES = 147456;
static_assert(TB_OFF + 66 * 4 <= LDS_BYTES, "LDS map");

#define GAS __attribute__((address_space(1)))
#define LAS __attribute__((address_space(3)))
typedef unsigned short bf16;
typedef unsigned v4u __attribute__((ext_vector_type(4)));
typedef unsigned v2u __attribute__((ext_vector_type(2)));
typedef float f32x4 __attribute__((ext_vector_type(4)));
typedef short bf16x8 __attribute__((ext_vector_type(8)));
typedef GAS unsigned gu32;
#define RLX_AGENT __ATOMIC_RELAXED, __HIP_MEMORY_SCOPE_AGENT
#define LDS_WAIT() asm volatile("s_waitcnt lgkmcnt(0)" ::: "memory")
#define VM_WAIT() asm volatile("s_waitcnt vmcnt(0)" ::: "memory")
__device__ __forceinline__ unsigned f2bf(float f) { unsigned u = __builtin_bit_cast(unsigned, f); return (u + 0x7fffu + ((u >> 16) & 1u)) >> 16; }
__device__ __forceinline__ unsigned pk2(float lo, float hi) { return pg8::cvt_pk_bf16(lo, hi); }
__device__ __forceinline__ float bflo(unsigned v) { return __builtin_bit_cast(float, v << 16); }
__device__ __forceinline__ float bfhi(unsigned v) { return __builtin_bit_cast(float, v & 0xffff0000u); }
__device__ __forceinline__ float sigm(float x) { return __builtin_amdgcn_rcpf(1.0f + __expf(-x)); }
__device__ __forceinline__ float gelu_tanh(float y) { const float t = 1.5957691216f * (y + 0.044715f * y * y * y); return y * sigm(t); }

#define XB_TMO      128
#define XB_XCNT(j)  (256  + 64 * (j))
#define XB_XSUB(j)  (1280 + 64 * (j))
#define XB_XGEN(j)  (2304 + 64 * (j))
#define XB_TOP      3328
#define XB_TOPGEN   3392
#define XCD_BAR_WORDS 3456
#define XB_SPIN_CAP (1u << 18)

__device__ __forceinline__ unsigned xb_ld(unsigned* p)              { return __hip_atomic_load(p, __ATOMIC_RELAXED, __HIP_MEMORY_SCOPE_AGENT); }
__device__ __forceinline__ unsigned xb_add(unsigned* p, unsigned v) { return __hip_atomic_fetch_add(p, v, __ATOMIC_RELAXED, __HIP_MEMORY_SCOPE_AGENT); }
__device__ __forceinline__ unsigned xb_xcc_id() { return (unsigned)__builtin_amdgcn_s_getreg((3 << 11) | 20) & 0xFu; }
#define XB_SPIN(cond, bar) do { unsigned _sp = 0; while (cond) { __builtin_amdgcn_s_sleep(1); \
    if ((++_sp & 255u) == 0u) { if (xb_ld(&(bar)[XB_TMO])) break; if (_sp > XB_SPIN_CAP) { atomicAdd(&(bar)[XB_TMO], 1u); break; } } } } while (0)

struct XcdBarrier {
    unsigned* bar; unsigned x;
    volatile LAS unsigned* st;
    int wv;
};

__device__ __forceinline__ XcdBarrier xcd_barrier_post(unsigned* bar, volatile LAS unsigned* st) {
    XcdBarrier b; b.bar = bar; b.x = xb_xcc_id(); b.st = st; b.wv = 0;
    if (threadIdx.x == 0) (void)xb_add(&bar[XB_XCNT(b.x)], 1u);
    return b;
}
__device__ __forceinline__ void xcd_barrier_complete(unsigned* bar, unsigned x, unsigned& nloc, unsigned& nx) {
    const unsigned G = gridDim.x * gridDim.y * gridDim.z;
    unsigned sum, cnt, mine, sp = 0u;
    for (;;) {
        sum = 0u; cnt = 0u; mine = 0u;
#pragma unroll
        for (unsigned j = 0; j < 16; ++j) { const unsigned c = xb_ld(&bar[XB_XCNT(j)]); sum += c; cnt += (c > 0u) ? 1u : 0u; mine = (j == x) ? c : mine; }
        if (sum == G) break;
        __builtin_amdgcn_s_sleep(1);
        if ((++sp & 255u) == 0u) { if (xb_ld(&bar[XB_TMO])) break; if (sp > XB_SPIN_CAP) { atomicAdd(&bar[XB_TMO], 1u); break; } }
    }
    nloc = mine > 0u ? mine : 1u; nx = cnt > 0u ? cnt : 1u;
}

__device__ __forceinline__ void xcd_barrier(const XcdBarrier& b) {
    asm volatile("s_waitcnt vmcnt(0)" ::: "memory");
    __syncthreads();
    if (b.wv == 0 && __builtin_amdgcn_mbcnt_hi(~0u, __builtin_amdgcn_mbcnt_lo(~0u, 0u)) == 0u) {
        unsigned* bar = b.bar;
        __builtin_amdgcn_s_waitcnt(0);
        unsigned nloc = b.st[0], nx = b.st[1];
        if (nloc == 0u) { xcd_barrier_complete(bar, b.x, nloc, nx); b.st[0] = nloc; b.st[1] = nx; }
        const unsigned old = xb_add(&bar[XB_XSUB(b.x)], 1u);
        const unsigned gen = old / nloc;
        if (old + 1u == (gen + 1u) * nloc) {
            __builtin_amdgcn_fence(__ATOMIC_RELEASE, "agent");
            asm volatile("s_waitcnt vmcnt(0)" ::: "memory");
            const unsigned og = xb_add(&bar[XB_TOP], 1u);
            const unsigned tg = og / nx;
            if (og + 1u == (tg + 1u) * nx) xb_add(&bar[XB_TOPGEN], 1u);
            else XB_SPIN(xb_ld(&bar[XB_TOPGEN]) == tg, bar);
            __builtin_amdgcn_fence(__ATOMIC_ACQUIRE, "agent");
            xb_add(&bar[XB_XGEN(b.x)], 1u);
            asm volatile("s_waitcnt vmcnt(0)" ::: "memory");
        } else {
            XB_SPIN(xb_ld(&bar[XB_XGEN(b.x)]) == gen, bar);
            __builtin_amdgcn_fence(__ATOMIC_ACQUIRE, "agent");
            asm volatile("s_waitcnt vmcnt(0)" ::: "memory");
        }
    }
    __syncthreads();
}

struct Frame {
    LAS unsigned char* lds;
    volatile LAS unsigned* MISC;
    gu32* ctl;
    int tid, lane, wave;
    int vcu, G;
    const float* const* in;
    float* out; unsigned char* ws;
};
__device__ __forceinline__ float wave_sum(float v) {
#pragma unroll
    for (int o = 1; o < 64; o <<= 1) v += __shfl_xor(v, o);
    return v;
}

__device__ __forceinline__ int map_glu(int base, int o, int gate) { return base + 8 * (o >> 2) + 4 * gate + (o & 3); }
__device__ __forceinline__ int dest_row(int mode, int n, int half) {
    if (mode == 0) return n;
    if (mode == 1) { if (n < 512) return n; if (n < 1024) return map_glu(512, n - 512, 0); if (n < 1536) return map_glu(512, n - 1024, 1); return n; }
    if (mode == 2) return n < half ? map_glu(0, n, 0) : map_glu(0, n - half, 1);
    if (mode == 3) return map_glu(0, n, 0);
    return map_glu(0, n, 1);
}
__device__ __forceinline__ void tr_item(const float* W, int K, int N, bf16* WT, int mode, int half, const float* ks, LAS float* scr, int item, int lane) {
    const int nblk = N / 32, kb = item / nblk, nb = item % nblk, k0 = 64 * kb, n0 = 32 * nb;
#pragma unroll 8
    for (int i = 0; i < 32; ++i) { const int kk = 2 * i + (lane >> 5); float v = W[(size_t)(k0 + kk) * N + n0 + (lane & 31)]; if (ks) v *= ks[k0 + kk]; scr[kk * 33 + (lane & 31)] = v; }
    LDS_WAIT(); asm volatile("" ::: "memory");
    const int c = lane & 7;
#pragma unroll
    for (int j = 0; j < 4; ++j) { const int n = (lane >> 3) + 8 * j; const LAS float* s = scr + (8 * c) * 33 + n;
        v4u o; o.x = pk2(s[0 * 33], s[1 * 33]); o.y = pk2(s[2 * 33], s[3 * 33]); o.z = pk2(s[4 * 33], s[5 * 33]); o.w = pk2(s[6 * 33], s[7 * 33]);
        *(GAS v4u*)(WT + (size_t)dest_row(mode, n0 + n, half) * K + k0 + 8 * c) = o; }
    LDS_WAIT(); asm volatile("" ::: "memory");
}
__device__ __forceinline__ void ssm_tables(Frame& F, int g) {
    LAS float* LP = (LAS float*)F.lds;
    LAS float* BB = LP + 33 * 64 * 2;
    LAS float* CC = BB + 2048;
    LAS float* KT = CC + 2048;
    const float* a_re = F.in[I_ARE]; const float* a_im = F.in[I_AIM]; const float* b_re = F.in[I_BRE]; const float* b_im = F.in[I_BIM];
    const float* c_re = F.in[I_CRE]; const float* c_im = F.in[I_CIM]; const float* sd = F.in[I_SD];
    if (F.tid < 64) {
        const int n = F.tid; const float dt = expf(F.in[I_LOGDT][g]); const float ar = a_re[g * 64 + n], ai = a_im[g * 64 + n];
        const float bm = ar * dt, ba = ai * dt;
        for (int tau = 0; tau <= 32; ++tau) { const float mag = expf(bm * (float)tau); float s, c; sincosf(ba * (float)tau, &s, &c); LP[(tau * 64 + n) * 2] = mag * c; LP[(tau * 64 + n) * 2 + 1] = mag * s; }
        const float lr = LP[(64 + n) * 2], li = LP[(64 + n) * 2 + 1];
        const float den = ar * ar + ai * ai, nr = lr - 1.0f, ni = li;
        const float zr = (nr * ar + ni * ai) / den, zi = (ni * ar - nr * ai) / den;
        for (int ch = 0; ch < 16; ++ch) { const float br = b_re[(g * 64 + n) * 16 + ch], bi = b_im[(g * 64 + n) * 16 + ch];
            BB[(n * 16 + ch) * 2] = zr * br - zi * bi; BB[(n * 16 + ch) * 2 + 1] = zr * bi + zi * br; }
        float* l32 = (float*)(F.ws + WS_LAM32);
        l32[(g * 64 + n) * 2] = LP[(32 * 64 + n) * 2]; l32[(g * 64 + n) * 2 + 1] = LP[(32 * 64 + n) * 2 + 1];
    }
    for (int e = F.tid; e < 1024; e += 512) { CC[e * 2] = c_re[g * 1024 + e]; CC[e * 2 + 1] = c_im[g * 1024 + e]; }
    __syncthreads();
    for (int e = F.tid; e < 8192; e += 512) {
        const int tau = e >> 8, cp = (e >> 4) & 15, ch = e & 15; float sum = 0.f;
        for (int n = 0; n < 64; ++n) { const float cr = CC[(cp * 64 + n) * 2], ci = CC[(cp * 64 + n) * 2 + 1], lr = LP[(tau * 64 + n) * 2], li = LP[(tau * 64 + n) * 2 + 1];
            const float pr = cr * lr - ci * li, pi = cr * li + ci * lr; sum += pr * BB[(n * 16 + ch) * 2] - pi * BB[(n * 16 + ch) * 2 + 1]; }
        KT[e] = sum;
    }
    __syncthreads();
    bf16* Bt2 = (bf16*)(F.ws + WS_BT2) + (size_t)g * 512 * 640;
    for (int q = F.tid; q < 512 * 80; q += 512) {
        const int R = q / 80, cc = q % 80, t = R >> 4, cp = R & 15; float v[8];
        if (cc < 64) { const int j = cc >> 1, chb = (cc & 1) * 8;
#pragma unroll
            for (int i = 0; i < 8; ++i) { const int ch = chb + i; float x = (t >= j) ? KT[((t - j) << 8) + cp * 16 + ch] : 0.f; if (t == j && ch == cp) x += sd[g * 16 + ch]; v[i] = x; }
        } else { const int nb = (cc - 64) * 4;
#pragma unroll
            for (int i = 0; i < 4; ++i) { const int n = nb + i; const float cr = CC[(cp * 64 + n) * 2], ci = CC[(cp * 64 + n) * 2 + 1], lr = LP[((t + 1) * 64 + n) * 2], li = LP[((t + 1) * 64 + n) * 2 + 1];
                v[2 * i] = cr * lr - ci * li; v[2 * i + 1] = -(cr * li + ci * lr); }
        }
        v4u o; o.x = pk2(v[0], v[1]); o.y = pk2(v[2], v[3]); o.z = pk2(v[4], v[5]); o.w = pk2(v[6], v[7]);
        *(GAS v4u*)(Bt2 + (size_t)R * 640 + cc * 8) = o;
    }
    bf16* WsT = (bf16*)(F.ws + WS_WST) + (size_t)g * 128 * 512;
    for (int q = F.tid; q < 128 * 64; q += 512) {
        const int R = q >> 6, cc = q & 63, n = R >> 1, ri = R & 1, j = cc >> 1, chb = (cc & 1) * 8; float v[8];
        const float lr = LP[((31 - j) * 64 + n) * 2], li = LP[((31 - j) * 64 + n) * 2 + 1];
#pragma unroll
        for (int i = 0; i < 8; ++i) { const float br = BB[(n * 16 + chb + i) * 2], bi = BB[(n * 16 + chb + i) * 2 + 1]; v[i] = ri == 0 ? (lr * br - li * bi) : (lr * bi + li * br); }
        v4u o; o.x = pk2(v[0], v[1]); o.y = pk2(v[2], v[3]); o.z = pk2(v[4], v[5]); o.w = pk2(v[6], v[7]);
        *(GAS v4u*)(WsT + (size_t)R * 512 + cc * 8) = o;
    }
    __syncthreads();
}
__device__ __forceinline__ void p0_prologue(Frame& F) {
    for (int g = blockIdx.x; g < NGRP; g += F.G) ssm_tables(F, g);
    LAS float* scr = (LAS float*)(F.lds + RING_OFF + F.wave * 16384);
    const int gw = F.vcu * NWAVES + F.wave, NGW = F.G * NWAVES;
    constexpr int I_IN = 16 * 112, I_GLU = 8 * 64, I_CO = 8 * 32, I_O = 16 * 32, I_PG = 16 * 32, I_PLE = 4 * 32, I_EG = 16 * 16, I_ED = 8 * 32;
    constexpr int NITEMS = I_IN + I_GLU + I_CO + I_O + I_PG + I_PLE + NEXP * (2 * I_EG + I_ED);
    for (int it = gw; it < NITEMS; it += NGW) {
        int r = it;
        if (r < I_IN) { tr_item(F.in[I_WIN], D, DIN, (bf16*)(F.ws + WS_WIN), 1, 0, nullptr, scr, r, F.lane); continue; } r -= I_IN;
        if (r < I_GLU) { tr_item(F.in[I_WGLU], DSSM, 2 * D, (bf16*)(F.ws + WS_WGLU), 2, D, nullptr, scr, r, F.lane); continue; } r -= I_GLU;
        if (r < I_CO) { tr_item(F.in[I_WCO], DCONV, D, (bf16*)(F.ws + WS_WCO), 0, 0, nullptr, scr, r, F.lane); continue; } r -= I_CO;
        if (r < I_O) { tr_item(F.in[I_WOUT], D, D, (bf16*)(F.ws + WS_WO), 0, 0, nullptr, scr, r, F.lane); continue; } r -= I_O;
        if (r < I_PG) { tr_item(F.in[I_WPG], D, D, (bf16*)(F.ws + WS_WPG), 0, 0, F.in[I_GPLE], scr, r, F.lane); continue; } r -= I_PG;
        if (r < I_PLE) { tr_item(F.in[I_WPLE], DPLE, D, (bf16*)(F.ws + WS_WPLE), 0, 0, nullptr, scr, r, F.lane); continue; } r -= I_PLE;
        const int e = r / (2 * I_EG + I_ED); r -= e * (2 * I_EG + I_ED);
        if (r < I_EG) { tr_item(F.in[I_WEG] + (size_t)e * D * DEXP, D, DEXP, (bf16*)(F.ws + WS_WGU) + (size_t)e * D * D, 3, 0, F.in[I_GMOE], scr, r, F.lane); continue; } r -= I_EG;
        if (r < I_EG) { tr_item(F.in[I_WEU] + (size_t)e * D * DEXP, D, DEXP, (bf16*)(F.ws + WS_WGU) + (size_t)e * D * D, 4, 0, F.in[I_GMOE], scr, r, F.lane); continue; } r -= I_EG;
        tr_item(F.in[I_WED] + (size_t)e * DEXP * D, DEXP, D, (bf16*)(F.ws + WS_WD) + (size_t)e * D * DEXP, 0, 0, nullptr, scr, r, F.lane);
    }
    { const float* x = F.in[I_X]; const float* gm = F.in[I_GMIX]; bf16* XN = (bf16*)(F.ws + WS_B);
      f32x4 gv[4];
#pragma unroll
      for (int j = 0; j < 4; ++j) gv[j] = *(const f32x4*)(gm + 4 * F.lane + 256 * j);
      for (int m = gw; m < NTOK; m += NGW) {
        const GAS f32x4* xr = (const GAS f32x4*)(x + (size_t)m * D) + F.lane; f32x4 v[4]; float s = 0.f;
#pragma unroll
        for (int j = 0; j < 4; ++j) { v[j] = xr[64 * j]; s += (v[j].x * v[j].x + v[j].y * v[j].y) + (v[j].z * v[j].z + v[j].w * v[j].w); }
        const float r = 1.0f / sqrtf(wave_sum(s) * (1.f / D) + EPS);
        GAS v2u* o8 = (GAS v2u*)(XN + (size_t)m * D) + F.lane;
#pragma unroll
        for (int j = 0; j < 4; ++j) { v2u o; o.x = pk2(v[j].x * r * gv[j].x, v[j].y * r * gv[j].y); o.y = pk2(v[j].z * r * gv[j].z, v[j].w * r * gv[j].w); o8[64 * j] = o; }
      } }
    { const float* p = F.in[I_P]; bf16* PB = (bf16*)(F.ws + WS_PB); const int gt = F.vcu * 512 + F.tid, NGT = F.G * 512;
      for (int q = gt; q < NTOK * DPLE / 8; q += NGT) { const f32x4 a = *(const f32x4*)(p + (size_t)q * 8), b = *(const f32x4*)(p + (size_t)q * 8 + 4);
        v4u o; o.x = pk2(a.x, a.y); o.y = pk2(a.z, a.w); o.z = pk2(b.x, b.y); o.w = pk2(b.z, b.w); *(GAS v4u*)(PB + (size_t)q * 8) = o; }
      bf16* WRT = (bf16*)(F.ws + WS_WRT); const float* gmoe = F.in[I_GMOE];
      for (int q = gt; q < 48 * 1024; q += NGT) { const int o = q >> 10, k = q & 1023; float v = 0.f;
        if (o < 4) v = F.in[I_WRG][k * 4 + o] * gmoe[k]; else if (o < 36) v = F.in[I_WRE][k * 32 + (o - 4)] * gmoe[k];
        const unsigned h = f2bf(v); const float lo = v - __builtin_bit_cast(float, h << 16); WRT[q] = (bf16)h; WRT[48 * 1024 + q] = (bf16)f2bf(lo); } }
}

using pg8::Unit;
typedef const f32x4 (&AccRef)[2][2][4][2];
struct EpiP1 {
    bf16* U; bf16* Z; bf16* SG; const float* bg;
    __device__ __forceinline__ void operator()(AccRef acc, const Unit& u, int wr, int wc, int fr, int fq) const {
        const int r0 = u.pm * 256 + wr * 64 + fr;
        if (u.pn < 2) {
#pragma unroll
            for (int ai = 0; ai < 2; ++ai)
#pragma unroll
                for (int m = 0; m < 4; ++m) { const int r = r0 + ai * 128 + m * 16, b = r >> 11, t = r & 2047;
#pragma unroll
                    for (int bj = 0; bj < 2; ++bj) { const int c0 = u.pn * 256 + bj * 128 + wc * 32 + fq * 8, g = c0 >> 4, ch0 = c0 & 15;
                        const f32x4 v0 = acc[ai][bj][m][0], v1 = acc[ai][bj][m][1];
                        v4u w; w.x = pk2(v0[0], v0[1]); w.y = pk2(v0[2], v0[3]); w.z = pk2(v1[0], v1[1]); w.w = pk2(v1[2], v1[3]);
                        *(GAS v4u*)(U + (((size_t)(b * 32 + g) * 2048 + t) * 16 + ch0)) = w; } }
        } else if (u.pn < 6) {
#pragma unroll
            for (int ai = 0; ai < 2; ++ai)
#pragma unroll
                for (int m = 0; m < 4; ++m) { const int r = r0 + ai * 128 + m * 16;
#pragma unroll
                    for (int bj = 0; bj < 2; ++bj) { const int o0 = (u.pn - 2) * 128 + bj * 64 + wc * 16 + fq * 4;
                        const f32x4 va = acc[ai][bj][m][0], ga = acc[ai][bj][m][1];
                        v2u w; w.x = pk2(va[0] * sigm(ga[0]), va[1] * sigm(ga[1])); w.y = pk2(va[2] * sigm(ga[2]), va[3] * sigm(ga[3]));
                        *(GAS v2u*)(Z + (size_t)r * 512 + o0) = w; } }
        } else {
#pragma unroll
            for (int bj = 0; bj < 2; ++bj) { const int s0 = (u.pn - 6) * 256 + bj * 128 + wc * 32 + fq * 8;
#ifdef DBG_NO_BIAS
                const f32x4 b0 = (f32x4){0.f, 0.f, 0.f, 0.f}, b1 = b0;
#else
                const f32x4 b0 = *(const f32x4*)(bg + s0), b1 = *(const f32x4*)(bg + s0 + 4);
#endif
#pragma unroll
                for (int ai = 0; ai < 2; ++ai)
#pragma unroll
                    for (int m = 0; m < 4; ++m) { const int r = r0 + ai * 128 + m * 16;
#ifdef DBG_BIAS_ONLY
                        const f32x4 v0 = b0, v1 = b1;
#else
                        const f32x4 v0 = acc[ai][bj][m][0] + b0, v1 = acc[ai][bj][m][1] + b1;
#endif
                        v4u w; w.x = pk2(sigm(v0[0]), sigm(v0[1])); w.y = pk2(sigm(v0[2]), sigm(v0[3])); w.z = pk2(sigm(v1[0]), sigm(v1[1])); w.w = pk2(sigm(v1[2]), sigm(v1[3]));
#ifdef DBG_SG_CONST
                        w.x = w.y = w.z = w.w = 0x3f003f00u;
#endif
                        *(GAS v4u*)(SG + (size_t)r * 2048 + s0) = w; } }
        }
    }
};
struct EpiGlu {
    float* MS; const bf16* SG;
    __device__ __forceinline__ void operator()(AccRef acc, const Unit& u, int wr, int wc, int fr, int fq) const {
        const int r0 = u.pm * 256 + wr * 64 + fr;
#pragma unroll
        for (int ai = 0; ai < 2; ++ai)
#pragma unroll
            for (int m = 0; m < 4; ++m) { const int r = r0 + ai * 128 + m * 16;
#pragma unroll
                for (int bj = 0; bj < 2; ++bj) { const int o0 = u.pn * 128 + bj * 64 + wc * 16 + fq * 4;
#ifdef DBG_NO_SG
                    v2u sg; sg.x = 0x3f803f80u; sg.y = 0x3f803f80u;
#else
                    const v2u sg = *(const GAS v2u*)(SG + (size_t)r * 2048 + o0);
#endif
                    const f32x4 va = acc[ai][bj][m][0], ga = acc[ai][bj][m][1];
                    f32x4 o; o[0] = va[0] * sigm(ga[0]) * bflo(sg.x); o[1] = va[1] * sigm(ga[1]) * bfhi(sg.x); o[2] = va[2] * sigm(ga[2]) * bflo(sg.y); o[3] = va[3] * sigm(ga[3]) * bfhi(sg.y);
                    *(GAS f32x4*)(MS + (size_t)r * 1024 + o0) = o; } }
    }
};
struct EpiCo {
    const float* MS; const bf16* SG; bf16* MG;
    __device__ __forceinline__ void operator()(AccRef acc, const Unit& u, int wr, int wc, int fr, int fq) const {
        const int r0 = u.pm * 256 + wr * 64 + fr;
#pragma unroll
        for (int ai = 0; ai < 2; ++ai)
#pragma unroll
            for (int m = 0; m < 4; ++m) { const int r = r0 + ai * 128 + m * 16;
#pragma unroll
                for (int bj = 0; bj < 2; ++bj) { const int c0 = u.pn * 256 + bj * 128 + wc * 32 + fq * 8;
                    const f32x4 m0 = *(const GAS f32x4*)(MS + (size_t)r * 1024 + c0), m1 = *(const GAS f32x4*)(MS + (size_t)r * 1024 + c0 + 4);
                    const v4u sg = *(const GAS v4u*)(SG + (size_t)r * 2048 + 1024 + c0);
                    const f32x4 v0 = acc[ai][bj][m][0], v1 = acc[ai][bj][m][1];
                    v4u w; w.x = pk2(m0[0] + bflo(sg.x) * v0[0], m0[1] + bfhi(sg.x) * v0[1]); w.y = pk2(m0[2] + bflo(sg.y) * v0[2], m0[3] + bfhi(sg.y) * v0[3]);
                    w.z = pk2(m1[0] + bflo(sg.z) * v1[0], m1[1] + bfhi(sg.z) * v1[1]); w.w = pk2(m1[2] + bflo(sg.w) * v1[2], m1[3] + bfhi(sg.w) * v1[3]);
                    *(GAS v4u*)(MG + (size_t)r * 1024 + c0) = w; } }
    }
};
struct EpiRes {
    const float* X; float* X1;
    __device__ __forceinline__ void operator()(AccRef acc, const Unit& u, int wr, int wc, int fr, int fq) const {
        const int r0 = u.pm * 256 + wr * 64 + fr;
#pragma unroll
        for (int ai = 0; ai < 2; ++ai)
#pragma unroll
            for (int m = 0; m < 4; ++m) { const int r = r0 + ai * 128 + m * 16;
#pragma unroll
                for (int bj = 0; bj < 2; ++bj) { const size_t o = (size_t)r * 1024 + u.pn * 256 + bj * 128 + wc * 32 + fq * 8;
                    const f32x4 x0 = *(const GAS f32x4*)(X + o), x1 = *(const GAS f32x4*)(X + o + 4);
                    *(GAS f32x4*)(X1 + o) = x0 + acc[ai][bj][m][0]; *(GAS f32x4*)(X1 + o + 4) = x1 + acc[ai][bj][m][1]; } }
    }
};
struct EpiAct {
    bf16* ACT; const int* ltok; const float* R2;
    __device__ __forceinline__ void operator()(AccRef acc, const Unit& u, int wr, int wc, int fr, int fq) const {
#pragma unroll
        for (int ai = 0; ai < 2; ++ai)
#pragma unroll
            for (int m = 0; m < 4; ++m) { const int rl = ai * 128 + wr * 64 + m * 16 + fr;
                if (rl < u.rows) { const int tok = ltok[u.e * NTOK + u.mt * 256 + rl]; const float rr = R2[tok];
#pragma unroll
                    for (int bj = 0; bj < 2; ++bj) { const int o0 = u.pn * 128 + bj * 64 + wc * 16 + fq * 4;
                        const f32x4 ga = acc[ai][bj][m][0] * rr, ua = acc[ai][bj][m][1] * rr;
                        v2u w; w.x = pk2(ga[0] * sigm(ga[0]) * ua[0], ga[1] * sigm(ga[1]) * ua[1]); w.y = pk2(ga[2] * sigm(ga[2]) * ua[2], ga[3] * sigm(ga[3]) * ua[3]);
                        *(GAS v2u*)(ACT + (size_t)(u.pm * 256 + rl) * 512 + o0) = w; } } }
    }
};
struct EpiDown {
    float* X1; const int* ltok; const float* lw;
    __device__ __forceinline__ void operator()(AccRef acc, const Unit& u, int wr, int wc, int fr, int fq) const {
#pragma unroll
        for (int ai = 0; ai < 2; ++ai)
#pragma unroll
            for (int m = 0; m < 4; ++m) { const int rl = ai * 128 + wr * 64 + m * 16 + fr;
                if (rl < u.rows) { const int li = u.e * NTOK + u.mt * 256 + rl; const int tok = ltok[li]; const float w = lw[li];
#pragma unroll
                    for (int bj = 0; bj < 2; ++bj) { float* o = X1 + (size_t)tok * 1024 + u.pn * 256 + bj * 128 + wc * 32 + fq * 8;
#pragma unroll
                        for (int n = 0; n < 2; ++n)
#pragma unroll
                            for (int j = 0; j < 4; ++j) (void)__builtin_amdgcn_global_atomic_fadd_f32((GAS float*)(o + 4 * n + j), w * acc[ai][bj][m][n][j]); } } }
    }
};
struct EpiE {
    float* EO;
    __device__ __forceinline__ void operator()(AccRef acc, const Unit& u, int wr, int wc, int fr, int fq) const {
        const int r0 = u.pm * 256 + wr * 64 + fr;
#pragma unroll
        for (int ai = 0; ai < 2; ++ai)
#pragma unroll
            for (int m = 0; m < 4; ++m) { const int r = r0 + ai * 128 + m * 16;
#pragma unroll
                for (int bj = 0; bj < 2; ++bj) { const size_t o = (size_t)r * 1024 + u.pn * 256 + bj * 128 + wc * 32 + fq * 8;
                    *(GAS f32x4*)(EO + o) = acc[ai][bj][m][0]; *(GAS f32x4*)(EO + o + 4) = acc[ai][bj][m][1]; } }
    }
};
struct EpiPle {
    float* X2; const float* EO; const float* R3;
    __device__ __forceinline__ void operator()(AccRef acc, const Unit& u, int wr, int wc, int fr, int fq) const {
        const int r0 = u.pm * 256 + wr * 64 + fr;
#pragma unroll
        for (int ai = 0; ai < 2; ++ai)
#pragma unroll
            for (int m = 0; m < 4; ++m) { const int r = r0 + ai * 128 + m * 16; const float r3 = R3[r];
#pragma unroll
                for (int bj = 0; bj < 2; ++bj) { const size_t o = (size_t)r * 1024 + u.pn * 256 + bj * 128 + wc * 32 + fq * 8;
                    const f32x4 x0 = *(const GAS f32x4*)(X2 + o), x1 = *(const GAS f32x4*)(X2 + o + 4), e0 = *(const GAS f32x4*)(EO + o), e1 = *(const GAS f32x4*)(EO + o + 4);
                    const f32x4 a0 = acc[ai][bj][m][0] * r3, a1 = acc[ai][bj][m][1] * r3; f32x4 y0, y1;
#pragma unroll
                    for (int j = 0; j < 4; ++j) { y0[j] = x0[j] + sigm(a0[j]) * e0[j]; y1[j] = x1[j] + sigm(a1[j]) * e1[j]; }
                    *(GAS f32x4*)(X2 + o) = y0; *(GAS f32x4*)(X2 + o + 4) = y1; } }
    }
};
struct DenseOrder : pg8::StaticOrder {
    const char* A; const char* Bt; size_t tstep;
    __device__ __forceinline__ const char* a_base(const Unit& u) const { return A + (size_t)u.pm * tstep; }
    __device__ __forceinline__ const char* b_base(const Unit& u) const { return Bt + (size_t)u.pn * tstep; }
    __device__ __forceinline__ unsigned row_off(const Unit&, int) const { return 0u; }
};
struct MoeOrder {
    const LAS int* tb; const LAS int* cn; int G, c, K, npn;
    const char* A; const char* Bt; size_t b_estride; const int* ltok; bool gather;
    __device__ __forceinline__ bool next(int i, Unit& u) const {
        const int L = i * G + c, total = tb[NEXP] * npn; if (L >= total) return false;
        const int tile = L / npn; int e = 0;
        for (int k = 1; k < NEXP; ++k) e += (tb[k] <= tile) ? 1 : 0;
        u.e = e; u.pm = tile; u.pn = L % npn; u.mt = tile - tb[e]; const int left = cn[e] - u.mt * 256; u.rows = left < 256 ? left : 256; return true;
    }
    __device__ __forceinline__ const char* a_base(const Unit& u) const { return gather ? A : A + (size_t)u.pm * 256 * K * 2; }
    __device__ __forceinline__ const char* b_base(const Unit& u) const { return Bt + (size_t)u.e * b_estride + (size_t)u.pn * 256 * K * 2; }
    __device__ __forceinline__ unsigned row_off(const Unit& u, int r) const { const int tok = (r < u.rows) ? ltok[u.e * NTOK + u.mt * 256 + r] : 0; return (unsigned)tok * (unsigned)(K * 2); }
};

constexpr int SSM_AP = 1296;
__device__ __forceinline__ void ssm_unit(Frame& F, int b, int g) {
    LAS unsigned char* Al = F.lds;
    LAS float* SL = (LAS float*)(F.lds + 64 * SSM_AP);
    const int fr = F.lane & 15, fq = F.lane >> 4, w = F.wave;
    const bf16* Ug = (const bf16*)(F.ws + WS_C) + (size_t)(b * 32 + g) * 2048 * 16;
#pragma unroll 4
    for (int q = F.tid; q < 4096; q += 512) { const int row = q >> 6, cc = q & 63; const v4u v = *(const GAS v4u*)(Ug + row * 512 + cc * 8); *(LAS v4u*)(Al + row * SSM_AP + cc * 16) = v; }
    __syncthreads();
    {
        const bf16* WS = (const bf16*)(F.ws + WS_WST) + ((size_t)g * 128 + 16 * w + fr) * 512 + 8 * fq;
        f32x4 acc[4];
#pragma unroll
        for (int m = 0; m < 4; ++m) acc[m] = (f32x4){0.f, 0.f, 0.f, 0.f};
#pragma unroll 4
        for (int s = 0; s < 16; ++s) { const bf16x8 bw = *(const GAS bf16x8*)(WS + 32 * s);
#pragma unroll
            for (int m = 0; m < 4; ++m) { const bf16x8 a = *(const LAS bf16x8*)(Al + (16 * m + fr) * SSM_AP + (32 * s + 8 * fq) * 2); acc[m] = __builtin_amdgcn_mfma_f32_16x16x32_bf16(bw, a, acc[m], 0, 0, 0); } }
#pragma unroll
        for (int m = 0; m < 4; ++m) *(LAS f32x4*)(SL + (16 * m + fr) * 132 + 16 * w + 4 * fq) = acc[m];
    }
    __syncthreads();
    if (w == 0) {
        const int n = F.lane; const float* l32 = (const float*)(F.ws + WS_LAM32) + (g * 64 + n) * 2; const float lr = l32[0], li = l32[1]; float sr = 0.f, si = 0.f;
        for (int c = 0; c < NCH; ++c) { *(LAS unsigned*)(Al + c * SSM_AP + 1024 + 4 * n) = pk2(sr, si);
            const float ur = SL[c * 132 + 2 * n], ui = SL[c * 132 + 2 * n + 1]; const float nr = lr * sr - li * si + ur, ni = lr * si + li * sr + ui; sr = nr; si = ni; }
    }
    __syncthreads();
    {
        const bf16* BT = (const bf16*)(F.ws + WS_BT2) + ((size_t)g * 512 + 64 * w + fr) * 640 + 8 * fq;
        f32x4 acc[4][4];
#pragma unroll
        for (int m = 0; m < 4; ++m)
#pragma unroll
            for (int n = 0; n < 4; ++n) acc[m][n] = (f32x4){0.f, 0.f, 0.f, 0.f};
#pragma unroll 2
        for (int s = 0; s < 20; ++s) { bf16x8 bf[4], af[4];
#pragma unroll
            for (int n = 0; n < 4; ++n) bf[n] = *(const GAS bf16x8*)(BT + (size_t)n * 16 * 640 + 32 * s);
#pragma unroll
            for (int m = 0; m < 4; ++m) af[m] = *(const LAS bf16x8*)(Al + (16 * m + fr) * SSM_AP + (32 * s + 8 * fq) * 2);
#pragma unroll
            for (int m = 0; m < 4; ++m)
#pragma unroll
                for (int n = 0; n < 4; ++n) acc[m][n] = __builtin_amdgcn_mfma_f32_16x16x32_bf16(bf[n], af[m], acc[m][n], 0, 0, 0); }
        bf16* GY = (bf16*)(F.ws + WS_B);
#pragma unroll
        for (int m = 0; m < 4; ++m)
#pragma unroll
            for (int n = 0; n < 4; ++n) { const int tok = b * SEQ + LC * (16 * m + fr) + 4 * w + n; const f32x4 y = acc[m][n];
                v2u o; o.x = pk2(gelu_tanh(y[0]), gelu_tanh(y[1])); o.y = pk2(gelu_tanh(y[2]), gelu_tanh(y[3]));
                *(GAS v2u*)(GY + (size_t)tok * 512 + 16 * g + 4 * fq) = o; }
    }
    __syncthreads();
}
__device__ __forceinline__ void conv_tile(Frame& F, int tile) {
    const int tok0 = tile * 64, b = tok0 >> 11, t0 = tok0 & 2047;
    LAS unsigned* zl = (LAS unsigned*)F.lds;
    LAS float* red = (LAS float*)(F.lds + 98304);
    const bf16* Z = (const bf16*)(F.ws + WS_C + 16 * MiB);
#pragma unroll 2
    for (int q = F.tid; q < 94 * 64; q += 512) { const int rr = q >> 6, cc = q & 63, t = t0 - 30 + rr; v4u v = (v4u){0u, 0u, 0u, 0u};
        if (t >= 0) v = *(const GAS v4u*)(Z + (size_t)(b * SEQ + t) * 512 + cc * 8); *(LAS v4u*)(zl + rr * 256 + cc * 4) = v; }
    __syncthreads();
    const int wq = F.wave & 3, th = F.wave >> 2, cp = wq * 64 + F.lane;
    float dw0[31], dw1[31];
    {   const float* pw = F.in[I_CDW] + 2 * cp;
        typedef float f32x2 __attribute__((ext_vector_type(2)));
#pragma unroll
        for (int k = 0; k < 31; ++k) { const f32x2 v = *(const GAS f32x2*)pw; dw0[k] = v.x; dw1[k] = v.y; pw += 512; asm volatile("" : "+v"(pw)); } }
    const float cb0 = F.in[I_CDWB][2 * cp], cb1 = F.in[I_CDWB][2 * cp + 1], lg0 = F.in[I_CLNG][2 * cp], lg1 = F.in[I_CLNG][2 * cp + 1], lb0 = F.in[I_CLNB][2 * cp], lb1 = F.in[I_CLNB][2 * cp + 1];
    bf16* CA = (bf16*)(F.ws + WS_B + 16 * MiB);
#pragma unroll 1
    for (int ch = 0; ch < 4; ++ch) {
        float a0[8], a1[8];
#pragma unroll
        for (int o = 0; o < 8; ++o) { a0[o] = cb0; a1[o] = cb1; }
        const int rbase = th * 32 + ch * 8;
#pragma unroll
        for (int r = 0; r < 38; ++r) { const unsigned v = zl[(rbase + r) * 256 + cp]; const float x0 = bflo(v), x1 = bfhi(v);
#pragma unroll
            for (int o = 0; o < 8; ++o) { const int k = r - o; if (k >= 0 && k <= 30) { a0[o] += dw0[k] * x0; a1[o] += dw1[k] * x1; } }
            __builtin_amdgcn_sched_barrier(0); }
        LAS float* rp = red + ((ch & 1) * 2 + th) * 64;
#pragma unroll
        for (int o = 0; o < 8; ++o) { const float s = wave_sum(a0[o] + a1[o]), q = wave_sum(a0[o] * a0[o] + a1[o] * a1[o]); if (F.lane == 0) { rp[(o * 4 + wq) * 2] = s; rp[(o * 4 + wq) * 2 + 1] = q; } }
        __syncthreads();
#pragma unroll
        for (int o = 0; o < 8; ++o) { float s = 0.f, q = 0.f;
#pragma unroll
            for (int k = 0; k < 4; ++k) { s += rp[(o * 4 + k) * 2]; q += rp[(o * 4 + k) * 2 + 1]; }
            const float mean = s * (1.f / 512.f), var = q * (1.f / 512.f) - mean * mean, rstd = 1.0f / sqrtf(var + EPS);
            const float y0 = (a0[o] - mean) * rstd * lg0 + lb0, y1 = (a1[o] - mean) * rstd * lg1 + lb1;
            *(GAS unsigned*)(CA + (size_t)(tok0 + rbase + o) * 512 + 2 * cp) = pk2(y0 * sigm(y0), y1 * sigm(y1)); }
    }
    __syncthreads();
}
__device__ __forceinline__ void router_phase(Frame& F) {
    const int fr = F.lane & 15, fq = F.lane >> 4;
    const float* X1 = (const float*)(F.ws + WS_E); bf16* XB = (bf16*)(F.ws + WS_B); float* R2 = (float*)(F.ws + WS_R2);
    const bf16* WRT = (const bf16*)(F.ws + WS_WRT); int* ltok = (int*)(F.ws + WS_LTOK); float* lw = (float*)(F.ws + WS_LW);
    LAS float* lg = (LAS float*)(F.lds + F.wave * 4096);
    for (int tile = F.wave * F.G + F.vcu; tile < NTOK / 16; tile += NWAVES * F.G) {
        const int tok = tile * 16 + fr;
        const float* xr = X1 + (size_t)tok * D + 8 * fq; bf16* xb = XB + (size_t)tok * D + 8 * fq; const bf16* wh = WRT + (size_t)fr * D + 8 * fq;
        f32x4 acc[3]; float ss = 0.f;
#pragma unroll
        for (int n = 0; n < 3; ++n) acc[n] = (f32x4){0.f, 0.f, 0.f, 0.f};
#pragma unroll 2
        for (int s = 0; s < 32; ++s) {
            const f32x4 v0 = *(const GAS f32x4*)(xr + 32 * s), v1 = *(const GAS f32x4*)(xr + 32 * s + 4);
            ss += (v0[0] * v0[0] + v0[1] * v0[1]) + (v0[2] * v0[2] + v0[3] * v0[3]) + (v1[0] * v1[0] + v1[1] * v1[1]) + (v1[2] * v1[2] + v1[3] * v1[3]);
            v4u h; h.x = pk2(v0[0], v0[1]); h.y = pk2(v0[2], v0[3]); h.z = pk2(v1[0], v1[1]); h.w = pk2(v1[2], v1[3]);
            *(GAS v4u*)(xb + 32 * s) = h;
            v4u l; l.x = pk2(v0[0] - bflo(h.x), v0[1] - bfhi(h.x)); l.y = pk2(v0[2] - bflo(h.y), v0[3] - bfhi(h.y)); l.z = pk2(v1[0] - bflo(h.z), v1[1] - bfhi(h.z)); l.w = pk2(v1[2] - bflo(h.w), v1[3] - bfhi(h.w));
            const bf16x8 xh = __builtin_bit_cast(bf16x8, h), xl = __builtin_bit_cast(bf16x8, l);
#pragma unroll
            for (int n = 0; n < 3; ++n) { const bf16x8 whi = *(const GAS bf16x8*)(wh + (size_t)n * 16 * D + 32 * s), wlo = *(const GAS bf16x8*)(wh + (size_t)(48 + n * 16) * D + 32 * s);
                acc[n] = __builtin_amdgcn_mfma_f32_16x16x32_bf16(whi, xh, acc[n], 0, 0, 0); acc[n] = __builtin_amdgcn_mfma_f32_16x16x32_bf16(whi, xl, acc[n], 0, 0, 0);
                acc[n] = __builtin_amdgcn_mfma_f32_16x16x32_bf16(wlo, xh, acc[n], 0, 0, 0); }
        }
        ss += __shfl_xor(ss, 16); ss += __shfl_xor(ss, 32);
        const float r = 1.0f / sqrtf(ss * (1.f / D) + EPS);
        if (fq == 0) R2[tok] = r;
#pragma unroll
        for (int n = 0; n < 3; ++n)
#pragma unroll
            for (int j = 0; j < 4; ++j) { const int o = 16 * n + 4 * fq + j; if (o < 36) { const float bias = o < 4 ? F.in[I_BRG][o] : F.in[I_BRE2][o - 4]; lg[fr * 49 + o] = acc[n][j] * r + bias; } }
        LDS_WAIT(); asm volatile("" ::: "memory");
        if (F.lane < 16) {
            const LAS float* l = lg + F.lane * 49; const int token = tile * 16 + F.lane;
            float gm = l[0]; int gs = 0;
#pragma unroll
            for (int i = 1; i < 4; ++i) if (l[i] > gm) { gm = l[i]; gs = i; }
            float den = 0.f;
#pragma unroll
            for (int i = 0; i < 4; ++i) den += __expf(l[i] - gm);
            const float pg = 1.0f / den;
            const LAS float* el = l + 4 + 8 * gs;
            float v1 = el[0]; int j1 = 0;
#pragma unroll
            for (int i = 1; i < 8; ++i) if (el[i] > v1) { v1 = el[i]; j1 = i; }
            float v2 = -3.0e38f; int j2 = 0;
#pragma unroll
            for (int i = 0; i < 8; ++i) if (i != j1 && el[i] > v2) { v2 = el[i]; j2 = i; }
            const float w1 = pg / (1.0f + __expf(v2 - v1)), w2 = pg - w1;
            const int e1 = gs * 8 + j1, e2 = gs * 8 + j2;
            const unsigned s1 = __hip_atomic_fetch_add((unsigned*)(F.ctl + CW_ECNT + 64 * e1), 1u, RLX_AGENT);
            const unsigned s2 = __hip_atomic_fetch_add((unsigned*)(F.ctl + CW_ECNT + 64 * e2), 1u, RLX_AGENT);
            ltok[e1 * NTOK + s1] = token; lw[e1 * NTOK + s1] = w1; ltok[e2 * NTOK + s2] = token; lw[e2 * NTOK + s2] = w2;
        }
        LDS_WAIT(); asm volatile("" ::: "memory");
    }
}
__device__ __forceinline__ void rows_to_bf16(Frame& F, const float* X, bf16* XB, float* RR) {
    const int gw = F.vcu * NWAVES + F.wave, NGW = F.G * NWAVES;
    for (int m = gw; m < NTOK; m += NGW) {
        const GAS f32x4* xr = (const GAS f32x4*)(X + (size_t)m * D) + F.lane; f32x4 v[4]; float s = 0.f;
#pragma unroll
        for (int j = 0; j < 4; ++j) { v[j] = xr[64 * j]; s += (v[j].x * v[j].x + v[j].y * v[j].y) + (v[j].z * v[j].z + v[j].w * v[j].w); }
        const float r = 1.0f / sqrtf(wave_sum(s) * (1.f / D) + EPS);
        if (F.lane == 0) RR[m] = r;
        GAS v2u* o8 = (GAS v2u*)(XB + (size_t)m * D) + F.lane;
#pragma unroll
        for (int j = 0; j < 4; ++j) { v2u o; o.x = pk2(v[j].x, v[j].y); o.y = pk2(v[j].z, v[j].w); o8[64 * j] = o; }
    }
}
__device__ __forceinline__ void final_norm(Frame& F, const float* X, float* out, const float* gf) {
    const int gw = F.vcu * NWAVES + F.wave, NGW = F.G * NWAVES;
    f32x4 gv[4];
#pragma unroll
    for (int j = 0; j < 4; ++j) gv[j] = *(const f32x4*)(gf + 4 * F.lane + 256 * j);
    for (int m = gw; m < NTOK; m += NGW) {
        const GAS f32x4* xr = (const GAS f32x4*)(X + (size_t)m * D) + F.lane; f32x4 v[4]; float s = 0.f;
#pragma unroll
        for (int j = 0; j < 4; ++j) { v[j] = xr[64 * j]; s += (v[j].x * v[j].x + v[j].y * v[j].y) + (v[j].z * v[j].z + v[j].w * v[j].w); }
        const float r = 1.0f / sqrtf(wave_sum(s) * (1.f / D) + EPS);
        GAS f32x4* o = (GAS f32x4*)(out + (size_t)m * D) + F.lane;
#pragma unroll
        for (int j = 0; j < 4; ++j) o[64 * j] = v[j] * r * gv[j];
    }
}
__device__ __forceinline__ void moe_tables(Frame& F) {
    LAS int* tb = (LAS int*)(F.lds + TB_OFF); LAS int* cn = tb + 33;
    if (F.tid == 0) { int t = 0; for (int e = 0; e < NEXP; ++e) { const int c = (int)__hip_atomic_load((unsigned*)(F.ctl + CW_ECNT + 64 * e), RLX_AGENT); cn[e] = c; tb[e] = t; t += (c + 255) >> 8; } tb[NEXP] = t; }
    __syncthreads();
}

struct Args { const float* in[N_IN]; float* out; unsigned char* ws; int ph_lo, ph_hi; };
__global__ void __launch_bounds__(NWAVES * 64, 2) mk_fwd(Args args) {
    extern __shared__ __attribute__((aligned(16))) unsigned char lds[];
    Frame F;
    F.lds = (LAS unsigned char*)lds;
    F.MISC = (volatile LAS unsigned*)(F.lds + MISC_OFF);
    F.tid = threadIdx.x; F.lane = F.tid & 63; F.wave = __builtin_amdgcn_readfirstlane(F.tid >> 6);
    const int wave_s = F.wave;
    F.G = gridDim.x; { const int bx = blockIdx.x; F.vcu = (F.G % 8 == 0) ? (bx % 8) * (F.G / 8) + bx / 8 : bx; }
    F.in = args.in; F.out = args.out; F.ws = args.ws; F.ctl = (gu32*)(args.ws + WS_CTL);
    for (int u = F.tid; u < (LDS_BYTES - LDSCTL_OFF) / 4; u += NWAVES * 64) ((LAS unsigned*)(F.lds + LDSCTL_OFF))[u] = 0u;
    __syncthreads();
    if (N_LAUNCHES != PER_PHASE) (void)xcd_barrier_post((unsigned*)(F.ctl + CW_BAR), F.MISC + 8);
#define GRID_BAR() do { if (N_LAUNCHES == PER_PHASE) { if (F.tid == 0) __hip_atomic_store(F.ctl + CW_TMO, 0xBADBA0u, RLX_AGENT); } else { \
        XcdBarrier bb_; bb_.bar = (unsigned*)(F.ctl + CW_BAR); bb_.x = xb_xcc_id(); bb_.st = (volatile LAS unsigned*)(F.lds + MISC_OFF) + 8; bb_.wv = wave_s; xcd_barrier(bb_); } } while (0)
#define PHASE_BEGIN() do { int l_ = (int)__builtin_amdgcn_mbcnt_hi(~0u, __builtin_amdgcn_mbcnt_lo(~0u, 0u)); asm volatile("" : "+v"(l_)); F.lane = l_; F.wave = wave_s; F.tid = wave_s * 64 + l_; \
        unsigned long long w_ = (unsigned long long)args.ws; asm volatile("" : "+s"(w_)); ws = (unsigned char*)(GAS unsigned char*)w_; F.ws = ws; F.ctl = (gu32*)(ws + WS_CTL); } while (0)
    const int lo = args.ph_lo, hi = args.ph_hi;
#ifndef PHASE_MASK
#define PHASE_MASK 0x1FFF
#endif
#define IN(k) (lo <= (k) && (k) < hi && ((PHASE_MASK >> (k)) & 1))
#define BOTH(k) (IN(k) && IN((k) + 1))
    unsigned char* ws = args.ws;
    const size_t TS1024 = (size_t)256 * 1024 * 2, TS512 = (size_t)256 * 512 * 2, TS256 = (size_t)256 * 256 * 2;

    if (IN(0)) { PHASE_BEGIN(); p0_prologue(F); if (BOTH(0)) GRID_BAR(); }
    if (IN(1)) {
        PHASE_BEGIN();
        DenseOrder S; S.init(NTOK, DIN, F.G, (int)blockIdx.x); S.A = (const char*)(ws + WS_B); S.Bt = (const char*)(ws + WS_WIN); S.tstep = TS1024;
        EpiP1 E{(bf16*)(ws + WS_C), (bf16*)(ws + WS_C + 16 * MiB), (bf16*)F.out, F.in[I_BGATE]};
        pg8::gemm_phase<EpiP1, DenseOrder>(F.lds + RING_OFF, F.tid, D, S, E);
        if (BOTH(1)) GRID_BAR();
    }
    if (IN(2)) {
        PHASE_BEGIN();
#ifndef NO_SSM
        for (int u = F.vcu; u < 8 * NGRP; u += F.G) { const int x = u / 32, idx = u % 32; ssm_unit(F, idx & 7, 4 * x + (idx >> 3)); }
#endif
#ifndef NO_CONV
        PHASE_BEGIN();
        for (int t = blockIdx.x; t < NTOK / 64; t += F.G) conv_tile(F, t);
#endif
        if (BOTH(2)) GRID_BAR();
    }
    if (IN(3)) {
        PHASE_BEGIN();
        DenseOrder S; S.init(NTOK, 2 * D, F.G, (int)blockIdx.x); S.A = (const char*)(ws + WS_B); S.Bt = (const char*)(ws + WS_WGLU); S.tstep = TS512;
        EpiGlu E{(float*)(ws + WS_E), (const bf16*)F.out};
        pg8::gemm_phase<EpiGlu, DenseOrder>(F.lds + RING_OFF, F.tid, DSSM, S, E);
        if (BOTH(3)) GRID_BAR();
    }
    if (IN(4)) {
        PHASE_BEGIN();
        DenseOrder S; S.init(NTOK, D, F.G, (int)blockIdx.x); S.A = (const char*)(ws + WS_B + 16 * MiB); S.Bt = (const char*)(ws + WS_WCO); S.tstep = TS512;
        EpiCo E{(const float*)(ws + WS_E), (const bf16*)F.out, (bf16*)(ws + WS_C)};
        pg8::gemm_phase<EpiCo, DenseOrder>(F.lds + RING_OFF, F.tid, DCONV, S, E);
        if (BOTH(4)) GRID_BAR();
    }
    if (IN(5)) {
        PHASE_BEGIN();
        DenseOrder S; S.init(NTOK, D, F.G, (int)blockIdx.x); S.A = (const char*)(ws + WS_C); S.Bt = (const char*)(ws + WS_WO); S.tstep = TS1024;
        EpiRes E{F.in[I_X], (float*)(ws + WS_E)};
        pg8::gemm_phase<EpiRes, DenseOrder>(F.lds + RING_OFF, F.tid, D, S, E);
        if (BOTH(5)) GRID_BAR();
    }
    if (IN(6)) { PHASE_BEGIN(); router_phase(F); if (BOTH(6)) GRID_BAR(); }
    if (IN(7)) {
        PHASE_BEGIN();
        moe_tables(F);
        MoeOrder S; S.tb = (const LAS int*)(F.lds + TB_OFF); S.cn = S.tb + 33; S.G = F.G; S.c = F.vcu; S.K = D; S.npn = 4;
        S.A = (const char*)(ws + WS_B); S.Bt = (const char*)(ws + WS_WGU); S.b_estride = (size_t)D * D * 2; S.ltok = (const int*)(ws + WS_LTOK); S.gather = true;
        EpiAct E{(bf16*)(ws + WS_C), (const int*)(ws + WS_LTOK), (const float*)(ws + WS_R2)};
        pg8::gemm_phase<EpiAct, MoeOrder, true>(F.lds + RING_OFF, F.tid, D, S, E);
        if (BOTH(7)) GRID_BAR();
    }
    if (IN(8)) {
        PHASE_BEGIN();
        moe_tables(F);
        MoeOrder S; S.tb = (const LAS int*)(F.lds + TB_OFF); S.cn = S.tb + 33; S.G = F.G; S.c = F.vcu; S.K = DEXP; S.npn = 4;
        S.A = (const char*)(ws + WS_C); S.Bt = (const char*)(ws + WS_WD); S.b_estride = (size_t)D * DEXP * 2; S.ltok = (const int*)(ws + WS_LTOK); S.gather = false;
        EpiDown E{(float*)(ws + WS_E), (const int*)(ws + WS_LTOK), (const float*)(ws + WS_LW)};
        pg8::gemm_phase<EpiDown, MoeOrder, false>(F.lds + RING_OFF, F.tid, DEXP, S, E);
        if (BOTH(8)) GRID_BAR();
    }
    if (IN(9)) { PHASE_BEGIN(); rows_to_bf16(F, (const float*)(ws + WS_E), (bf16*)(ws + WS_B), (float*)(ws + WS_R3)); if (BOTH(9)) GRID_BAR(); }
#ifdef DBG_SG_COPY
    if (lo <= 10 && 10 < hi) { const int gt = F.vcu * 512 + (int)threadIdx.x, NGT = F.G * 512; const bf16* sgp = (const bf16*)args.out + (size_t)DBG_SG_COPY * NTOK * D; float* dst = (float*)(args.ws + WS_E);
        for (int q = gt; q < NTOK * D; q += NGT) { const float v = bflo((unsigned)sgp[q]); const int col = q & 2047;
#ifdef DBG_SG_SEL_LO
            dst[q] = (v >= 0.f && v <= 1.f) ? 0.f : ((col >= DBG_SG_SEL_LO && col < DBG_SG_SEL_HI) ? 1000.f : 0.f);
#else
            dst[q] = v;
#endif
        } }
#endif
    if (IN(10)) {
        PHASE_BEGIN();
        DenseOrder S; S.init(NTOK, D, F.G, (int)blockIdx.x); S.A = (const char*)(ws + WS_PB); S.Bt = (const char*)(ws + WS_WPLE); S.tstep = TS256;
        EpiE E{F.out};
        pg8::gemm_phase<EpiE, DenseOrder>(F.lds + RING_OFF, F.tid, DPLE, S, E);
        if (BOTH(10)) GRID_BAR();
    }
    if (IN(11)) {
        PHASE_BEGIN();
        DenseOrder S; S.init(NTOK, D, F.G, (int)blockIdx.x); S.A = (const char*)(ws + WS_B); S.Bt = (const char*)(ws + WS_WPG); S.tstep = TS1024;
        EpiPle E{(float*)(ws + WS_E), (const float*)F.out, (const float*)(ws + WS_R3)};
        pg8::gemm_phase<EpiPle, DenseOrder>(F.lds + RING_OFF, F.tid, D, S, E);
        if (BOTH(11)) GRID_BAR();
    }
#ifdef DBG_DUMP_OFF
    if (hi == PER_PHASE) {   PHASE_BEGIN();
        const int gt = F.vcu * 512 + F.tid, NGT = F.G * 512;
#if DBG_DUMP_BF16
        const bf16* src = (const bf16*)(ws + (size_t)DBG_DUMP_OFF);
        for (int q = gt; q < NTOK * D; q += NGT) F.out[q] = bflo((unsigned)src[q]);
#else
        const float* src = (const float*)(ws + (size_t)DBG_DUMP_OFF);
        for (int q = gt; q < NTOK * D; q += NGT) F.out[q] = src[q];
#endif
    }
#else
    if (IN(12)) { PHASE_BEGIN(); final_norm(F, (const float*)(ws + WS_E), F.out, F.in[I_GFIN]); }
#endif
#undef IN
#undef BOTH
}

extern "C" void kernel_launch(void* const* d_in, const int* in_sizes, int n_in, void* d_out, int out_size, void* d_ws, size_t ws_size, hipStream_t stream) {
    static int grid = 0;
    if (grid == 0) {
        if (n_in != N_IN || in_sizes[0] != NTOK * D || out_size != NTOK * D || ws_size < WS_END) { fprintf(stderr, "kernel_launch: unexpected shapes (n_in %d, in0 %d, out %d, ws %zu; need ws >= %zu); nothing launched\n", n_in, n_in > 0 ? in_sizes[0] : -1, out_size, ws_size, (size_t)WS_END); grid = -1; return; }
        int dev = 0, cus = 0, per_cu = 0;
        if (hipGetDevice(&dev) != hipSuccess || hipDeviceGetAttribute(&cus, hipDeviceAttributeMultiprocessorCount, dev) != hipSuccess) { grid = -1; return; }
        if (hipFuncSetAttribute((const void*)mk_fwd, hipFuncAttributeMaxDynamicSharedMemorySize, LDS_BYTES) != hipSuccess) { fprintf(stderr, "kernel_launch: hipFuncSetAttribute failed\n"); grid = -1; return; }
        if (hipOccupancyMaxActiveBlocksPerMultiprocessor(&per_cu, (const void*)mk_fwd, NWAVES * 64, LDS_BYTES) != hipSuccess || per_cu < 1) { fprintf(stderr, "kernel_launch: occupancy query reports %d workgroups per CU\n", per_cu); (void)hipGetLastError(); grid = -1; return; }
        grid = cus;
    }
    if (grid < 0) return;
    if (hipMemsetAsync((char*)d_ws + WS_CTL, 0, CTL_ZERO_BYTES, stream) != hipSuccess) return;
    Args a{};
    for (int i = 0; i < N_IN; ++i) a.in[i] = (const float*)d_in[i];
    a.out = (float*)d_out; a.ws = (unsigned char*)d_ws;
    for (int li = 0; li < N_LAUNCHES; ++li) {
        a.ph_lo = (N_LAUNCHES == PER_PHASE) ? li : 0; a.ph_hi = (N_LAUNCHES == PER_PHASE) ? li + 1 : PER_PHASE;
        hipLaunchKernelGGL(mk_fwd, dim3(grid), dim3(NWAVES * 64), LDS_BYTES, stream, a);
        if (hipPeekAtLastError() != hipSuccess) { fprintf(stderr, "kernel_launch: launch %d failed\n", li); break; }
    }
}
```

```cpp
#include <hip/hip_runtime.h>
#include <cstdio>
#include <cstdint>

namespace pg8 {
#define PG8_LAS __attribute__((address_space(3)))
typedef unsigned short bf16_t;
typedef short bf16x8 __attribute__((ext_vector_type(8)));
typedef float f32x4 __attribute__((ext_vector_type(4)));
typedef unsigned u32x4 __attribute__((ext_vector_type(4)));
typedef unsigned u32x2 __attribute__((ext_vector_type(2)));
constexpr int BM = 256, BK = 64, HALF = 128, HTB = HALF * BK * 2  , STAGE_BYTES = 8 * HTB, NXCD = 8, WGM = 8;

__host__ __device__ __forceinline__ int lds_byte(int r, int c) { const int st = (r >> 4) * 2 + (c >> 5), rr = r & 15, cc = c & 31, ob = rr * 64 + cc * 2; return st * 1024 + (ob ^ (((ob >> 9) & 1) << 5)); }
__host__ __device__ __forceinline__ void stage_rc(int b, int& R, int& C) { const int st = b / 1024, sb = b % 1024, swz = sb ^ (((sb >> 9) & 1) << 5); R = (st >> 1) * 16 + swz / 64; C = (st & 1) * 32 + (swz % 64) / 2; }
__host__ __device__ __forceinline__ int perm32(int rho) { const int n = rho >> 4, i = rho & 15; return 8 * (i >> 2) + 4 * n + (i & 3); }

struct Unit { int pm, pn, e, rows, mt, cb; };

typedef float cvt_f32x2 __attribute__((ext_vector_type(2)));
typedef __bf16 cvt_bf16x2 __attribute__((ext_vector_type(2)));
__device__ __forceinline__ unsigned cvt_pk_bf16(float lo, float hi) { const cvt_f32x2 v = {lo, hi}; const cvt_bf16x2 b = __builtin_convertvector(v, cvt_bf16x2); return __builtin_bit_cast(unsigned, b); }

struct StaticOrder {
    int nM, nN, nwg, G, c;
    __host__ __device__ void init(int M, int N, int G_, int c_) { nM = M / BM; nN = N / BM; nwg = nM * nN; G = G_; c = c_; }
    __host__ __device__ bool next(int i, Unit& u) const {
        const long L = (long)i * G + c; if (L >= nwg) return false;
        int wgid = (int)L; { const int q = nwg / NXCD, r = nwg % NXCD, xcd = wgid % NXCD, off = wgid / NXCD; wgid = (xcd < r ? xcd * (q + 1) : r * (q + 1) + (xcd - r) * q) + off; }
        const int nig = WGM * nN, gid = wgid / nig, fm = gid * WGM, gsz = (nM - fm) < WGM ? (nM - fm) : WGM;
        u.pm = fm + ((wgid % nig) % gsz); u.pn = (wgid % nig) / gsz; u.e = 0; u.rows = BM; u.mt = 0; u.cb = 0; return true;
    }
};

template <class Epi, class Sched, bool GATHER = false, bool ALIGN_EPI = true>
__device__ __forceinline__ void gemm_phase(PG8_LAS unsigned char* lds, const int tid, const int K, const Sched& S, const Epi& E) {
    const int wid = __builtin_amdgcn_readfirstlane(tid >> 6), lane = tid & 63, wr = wid >> 2, wc = wid & 3, fr = lane & 15, fq = lane >> 4;
    const int nt = K / BK;
    unsigned voffA[2], voffB[2]; int rowA[2], colA[2];
#pragma unroll
    for (int i = 0; i < 2; ++i) { int R, C; stage_rc(tid * 16 + i * 8192, R, C); const int Rb = (R & ~31) + perm32(R & 31);
        voffA[i] = (unsigned)(R * K + C) * 2u; voffB[i] = (unsigned)(Rb * K + C) * 2u; rowA[i] = R; colA[i] = C * 2; }
    const size_t kstep = (size_t)(BK * 2);
    const unsigned hstep = (unsigned)HALF * (unsigned)K * 2u;
    const unsigned ldsw = (unsigned)wid * 1024u;
    const int aoff = lds_byte(wr * 64 + fr, fq * 8), boff = lds_byte(wc * 32 + fr, fq * 8);
#define PG8_SA(b, h) (((b) * 2 + (h)) * HTB)
#define PG8_SB(b, h) ((4 + (b) * 2 + (h)) * HTB)
#define PG8_STAGE(bufoff, gbase, voff) do { _Pragma("unroll") for (int _i = 0; _i < 2; ++_i) \
        __builtin_amdgcn_global_load_lds((const unsigned*)((const char*)(gbase) + (voff)[_i]), (PG8_LAS unsigned*)(lds + (bufoff) + ldsw + _i * 8192), 16, 0, 0); } while (0)
#define PG8_STAGE_A(bufoff, gbase, V, h) do { _Pragma("unroll") for (int _i = 0; _i < 2; ++_i) { const unsigned _o = GATHER ? (V)[h][_i] : (voffA[_i] + (unsigned)(h) * hstep); \
        __builtin_amdgcn_global_load_lds((const unsigned*)((const char*)(gbase) + _o), (PG8_LAS unsigned*)(lds + (bufoff) + ldsw + _i * 8192), 16, 0, 0); } } while (0)
#define PG8_LDA(dst, b, h) do { _Pragma("unroll") for (int m = 0; m < 4; ++m) _Pragma("unroll") for (int k = 0; k < 2; ++k) dst[m][k] = *(const PG8_LAS bf16x8*)(lds + PG8_SA(b, h) + aoff + m * 2048 + k * 1024); } while (0)
#define PG8_LDB(dst, b, h) do { _Pragma("unroll") for (int n = 0; n < 2; ++n) _Pragma("unroll") for (int k = 0; k < 2; ++k) dst[n][k] = *(const PG8_LAS bf16x8*)(lds + PG8_SB(b, h) + boff + n * 2048 + k * 1024); } while (0)
#define PG8_MMA(ai, bj, At, Bt) do { __builtin_amdgcn_s_setprio(1); _Pragma("unroll") for (int m = 0; m < 4; ++m) _Pragma("unroll") for (int n = 0; n < 2; ++n) _Pragma("unroll") for (int k = 0; k < 2; ++k) \
        acc[ai][bj][m][n] = __builtin_amdgcn_mfma_f32_16x16x32_bf16(Bt[n][k], At[m][k], acc[ai][bj][m][n], 0, 0, 0); __builtin_amdgcn_s_setprio(0); } while (0)
#define PG8_WAIT_V(n) asm volatile("s_waitcnt vmcnt(" #n ")" ::: "memory")
#define PG8_WAIT_L(n) asm volatile("s_waitcnt lgkmcnt(" #n ")" ::: "memory")
#define PG8_BAR __builtin_amdgcn_s_barrier()
#define PG8_SCHED __builtin_amdgcn_sched_barrier(0)
    Unit cur, nxt; int ui = 0;
    if (!S.next(0, cur)) return;
    f32x4 acc[2][2][4][2];
#pragma unroll
    for (int a = 0; a < 2; ++a)
#pragma unroll
        for (int b = 0; b < 2; ++b)
#pragma unroll
            for (int m = 0; m < 4; ++m)
#pragma unroll
                for (int n = 0; n < 2; ++n) acc[a][b][m][n] = (f32x4){0.f, 0.f, 0.f, 0.f};
    bf16x8 At[4][2], B0[2][2], B1[2][2];
    unsigned cva[2][2] = {{0u, 0u}, {0u, 0u}}, nva[2][2] = {{0u, 0u}, {0u, 0u}};
    const char* cA = S.a_base(cur); const char* cB = S.b_base(cur);
    if constexpr (GATHER) {
#pragma unroll
        for (int h = 0; h < 2; ++h)
#pragma unroll
            for (int i = 0; i < 2; ++i) cva[h][i] = S.row_off(cur, h * HALF + rowA[i]) + (unsigned)colA[i];
    }
    PG8_STAGE(PG8_SB(0, 0), cB, voffB); PG8_STAGE(PG8_SB(0, 1), cB + hstep, voffB); PG8_STAGE_A(PG8_SA(0, 0), cA, cva, 0); PG8_STAGE_A(PG8_SA(0, 1), cA, cva, 1);
    if (wr == 1) PG8_BAR;
    PG8_WAIT_V(2); PG8_BAR;
    PG8_STAGE(PG8_SB(1, 0), cB + kstep, voffB); PG8_STAGE_A(PG8_SA(1, 0), cA + kstep, cva, 0); PG8_STAGE(PG8_SB(1, 1), cB + hstep + kstep, voffB);
    PG8_WAIT_V(6); PG8_BAR;
    for (;;) {
        const bool has_next = S.next(ui + 1, nxt);
        const char* nA = has_next ? S.a_base(nxt) : cA; const char* nB = has_next ? S.b_base(nxt) : cB;
        if constexpr (GATHER) {
#pragma unroll
            for (int h = 0; h < 2; ++h)
#pragma unroll
                for (int i = 0; i < 2; ++i) nva[h][i] = has_next ? (S.row_off(nxt, h * HALF + rowA[i]) + (unsigned)colA[i]) : cva[h][i];
        }
#pragma unroll 1
        for (int t = 0; t < nt; t += 2) {
            const bool last = (t == nt - 2);
            const char* a1 = cA + (size_t)(t + 1) * kstep;
            const char* a2 = last ? nA : cA + (size_t)(t + 2) * kstep; const char* b2 = last ? nB : cB + (size_t)(t + 2) * kstep;
            const char* a3 = a2 + kstep; const char* b3 = b2 + kstep;
            PG8_LDB(B0, 0, 0); PG8_LDB(B1, 0, 1); PG8_SCHED; PG8_LDA(At, 0, 0); PG8_STAGE_A(PG8_SA(1, 1), a1, cva, 1);
            if constexpr (GATHER) { if (last) {
#pragma unroll
                for (int h = 0; h < 2; ++h)
#pragma unroll
                    for (int i = 0; i < 2; ++i) cva[h][i] = nva[h][i]; } }
            PG8_WAIT_V(8); PG8_WAIT_L(0); PG8_BAR; PG8_MMA(0, 0, At, B0); PG8_MMA(0, 1, At, B1); PG8_BAR; PG8_SCHED;
            PG8_LDA(At, 0, 1); PG8_STAGE(PG8_SB(0, 0), b2, voffB); PG8_STAGE(PG8_SB(0, 1), b2 + hstep, voffB); PG8_STAGE_A(PG8_SA(0, 0), a2, cva, 0);
            PG8_WAIT_V(8); PG8_WAIT_L(0); PG8_BAR; PG8_MMA(1, 0, At, B0); PG8_MMA(1, 1, At, B1); PG8_BAR; PG8_SCHED;
            PG8_LDB(B0, 1, 0); PG8_LDB(B1, 1, 1); PG8_SCHED; PG8_LDA(At, 1, 0); PG8_STAGE_A(PG8_SA(0, 1), a2, cva, 1);
            PG8_WAIT_V(8); PG8_WAIT_L(0); PG8_BAR; PG8_MMA(0, 0, At, B0); PG8_MMA(0, 1, At, B1); PG8_BAR; PG8_SCHED;
            PG8_LDA(At, 1, 1); PG8_STAGE(PG8_SB(1, 0), b3, voffB); PG8_STAGE(PG8_SB(1, 1), b3 + hstep, voffB); PG8_STAGE_A(PG8_SA(1, 0), a3, cva, 0);
            PG8_WAIT_V(8); PG8_WAIT_L(0); PG8_BAR; PG8_MMA(1, 0, At, B0); PG8_MMA(1, 1, At, B1); PG8_BAR; PG8_SCHED;
        }
        if constexpr (ALIGN_EPI) { if (wr == 0) PG8_BAR; }
#ifdef DBG_EPI_NOP
        asm volatile("s_nop 15\n s_nop 15\n s_nop 15\n s_nop 15" ::: "memory");
#endif
        E(acc, cur, wr, wc, fr, fq);
        if (!has_next) break;
#pragma unroll
        for (int a = 0; a < 2; ++a)
#pragma unroll
            for (int b = 0; b < 2; ++b)
#pragma unroll
                for (int m = 0; m < 4; ++m)
#pragma unroll
                    for (int n = 0; n < 2; ++n) acc[a][b][m][n] = (f32x4){0.f, 0.f, 0.f, 0.f};
        cur = nxt; cA = nA; cB = nB; ++ui;
        if constexpr (ALIGN_EPI) { if (wr == 1) PG8_BAR; }
    }
    PG8_WAIT_V(0);
    if constexpr (!ALIGN_EPI) { if (wr == 0) PG8_BAR; }
    PG8_BAR;
#undef PG8_SA
#undef PG8_SB
#undef PG8_STAGE
#undef PG8_STAGE_A
#undef PG8_LDA
#undef PG8_LDB
#undef PG8_MMA
#undef PG8_WAIT_V
#undef PG8_WAIT_L
#undef PG8_BAR
#undef PG8_SCHED
}
}

constexpr int NWAVES = 8;
#ifndef MK_N_LAUNCHES
#define MK_N_LAUNCHES 1
#endif
constexpr int PER_PHASE = 13;
constexpr int N_LAUNCHES = MK_N_LAUNCHES;

constexpr int NTOK = 16384, SEQ = 2048, D = 1024, DIN = 3584, DSSM = 512, DCONV = 512, NGRP = 32, NST = 64, GWID = 16, CONVW = 31;
constexpr int NEXP = 32, EPG = 8, DEXP = 512, DPLE = 256, LC = 32, NCH = 64;
constexpr float EPS = 1e-6f;
enum In { I_X = 0, I_P, I_GMIX, I_WIN, I_BGATE, I_ARE, I_AIM, I_LOGDT, I_BRE, I_BIM, I_CRE, I_CIM, I_SD, I_WGLU, I_CDW, I_CDWB, I_CLNG, I_CLNB, I_WCO, I_WOUT, I_GMOE, I_WRG, I_BRG, I_WRE, I_BRE2,
          I_WEG, I_WEU, I_WED, I_GPLE, I_WPG, I_WPLE, I_GFIN, N_IN };

constexpr size_t MiB = 1u << 20;
constexpr size_t WS_CTL = 0, CTL_ZERO_BYTES = 1 * MiB;
constexpr size_t WS_LTOK = 1 * MiB;
constexpr size_t WS_TINFO = 3 * MiB;
constexpr size_t WS_R2 = 5 * MiB, WS_R3 = WS_R2 + 65536, WS_LAM32 = WS_R3 + 65536, WS_WRT = WS_R2 + 262144;
constexpr size_t WS_WST = 6 * MiB;
constexpr size_t WS_BT2 = 10 * MiB;
constexpr size_t WS_WIN = 31 * MiB, WS_WGLU = 38 * MiB, WS_WCO = 40 * MiB, WS_WO = 41 * MiB, WS_WPG = 43 * MiB, WS_WPLE = 45 * MiB;
constexpr size_t WS_PB = 46 * MiB;
constexpr size_t WS_WGU = 54 * MiB;
constexpr size_t WS_WD = 118 * MiB;
constexpr size_t WS_B = 150 * MiB;
constexpr size_t WS_C = 182 * MiB;
constexpr size_t WS_E = 224 * MiB;
constexpr size_t WS_END = 288 * MiB;
constexpr int CW_TMO = 0, CW_CODE = 1, CW_BAR = 4096, CW_ECNT = 16384;
static_assert((CW_ECNT + 64 * NEXP) * 4 <= (int)CTL_ZERO_BYTES, "CTL words inside the memset region");

constexpr int RING_OFF = 0, RING_BYTES = 131072;
constexpr int LDSCTL_OFF = RING_BYTES, MISC_OFF = LDSCTL_OFF + 320;
constexpr int TB_OFF = LDSCTL_OFF + 1024;
constexpr int LDS_BYTES = 147456;
static_assert(TB_OFF + 100 * 4 <= LDS_BYTES, "LDS map");

#define GAS __attribute__((address_space(1)))
#define LAS __attribute__((address_space(3)))
typedef unsigned short bf16;
typedef unsigned v4u __attribute__((ext_vector_type(4)));
typedef unsigned v2u __attribute__((ext_vector_type(2)));
typedef float f32x4 __attribute__((ext_vector_type(4)));
typedef short bf16x8 __attribute__((ext_vector_type(8)));
typedef GAS unsigned gu32;
#define RLX_AGENT __ATOMIC_RELAXED, __HIP_MEMORY_SCOPE_AGENT
#define LDS_WAIT() asm volatile("s_waitcnt lgkmcnt(0)" ::: "memory")
#define VM_WAIT() asm volatile("s_waitcnt vmcnt(0)" ::: "memory")
__device__ __forceinline__ unsigned f2bf(float f) { unsigned u = __builtin_bit_cast(unsigned, f); return (u + 0x7fffu + ((u >> 16) & 1u)) >> 16; }
__device__ __forceinline__ unsigned pk2(float lo, float hi) { return pg8::cvt_pk_bf16(lo, hi); }
__device__ __forceinline__ float bflo(unsigned v) { return __builtin_bit_cast(float, v << 16); }
__device__ __forceinline__ float bfhi(unsigned v) { return __builtin_bit_cast(float, v & 0xffff0000u); }
__device__ __forceinline__ float sigm(float x) { return __builtin_amdgcn_rcpf(1.0f + __expf(-x)); }
__device__ __forceinline__ float gelu_tanh(float y) { const float t = 1.5957691216f * (y + 0.044715f * y * y * y); return y * sigm(t); }

#define XB_TMO      128
#define XB_XCNT(j)  (256  + 64 * (j))
#define XB_XSUB(j)  (1280 + 64 * (j))
#define XB_XGEN(j)  (2304 + 64 * (j))
#define XB_TOP      3328
#define XB_TOPGEN   3392
#define XCD_BAR_WORDS 3456
#define XB_SPIN_CAP (1u << 18)

__device__ __forceinline__ unsigned xb_ld(unsigned* p)              { return __hip_atomic_load(p, __ATOMIC_RELAXED, __HIP_MEMORY_SCOPE_AGENT); }
__device__ __forceinline__ unsigned xb_add(unsigned* p, unsigned v) { return __hip_atomic_fetch_add(p, v, __ATOMIC_RELAXED, __HIP_MEMORY_SCOPE_AGENT); }
__device__ __forceinline__ unsigned xb_xcc_id() { return (unsigned)__builtin_amdgcn_s_getreg((3 << 11) | 20) & 0xFu; }
#define XB_SPIN(cond, bar) do { unsigned _sp = 0; while (cond) { __builtin_amdgcn_s_sleep(1); \
    if ((++_sp & 255u) == 0u) { if (xb_ld(&(bar)[XB_TMO])) break; if (_sp > XB_SPIN_CAP) { atomicAdd(&(bar)[XB_TMO], 1u); break; } } } } while (0)

struct XcdBarrier {
    unsigned* bar; unsigned x;
    volatile LAS unsigned* st;
    int wv;
};

__device__ __forceinline__ XcdBarrier xcd_barrier_post(unsigned* bar, volatile LAS unsigned* st) {
    XcdBarrier b; b.bar = bar; b.x = xb_xcc_id(); b.st = st; b.wv = 0;
    if (threadIdx.x == 0) (void)xb_add(&bar[XB_XCNT(b.x)], 1u);
    return b;
}
__device__ __forceinline__ void xcd_barrier_complete(unsigned* bar, unsigned x, unsigned& nloc, unsigned& nx) {
    const unsigned G = gridDim.x * gridDim.y * gridDim.z;
    unsigned sum, cnt, mine, sp = 0u;
    for (;;) {
        sum = 0u; cnt = 0u; mine = 0u;
#pragma unroll
        for (unsigned j = 0; j < 16; ++j) { const unsigned c = xb_ld(&bar[XB_XCNT(j)]); sum += c; cnt += (c > 0u) ? 1u : 0u; mine = (j == x) ? c : mine; }
        if (sum == G) break;
        __builtin_amdgcn_s_sleep(1);
        if ((++sp & 255u) == 0u) { if (xb_ld(&bar[XB_TMO])) break; if (sp > XB_SPIN_CAP) { atomicAdd(&bar[XB_TMO], 1u); break; } }
    }
    nloc = mine > 0u ? mine : 1u; nx = cnt > 0u ? cnt : 1u;
}

__device__ __forceinline__ void xcd_barrier(const XcdBarrier& b) {
    asm volatile("s_waitcnt vmcnt(0)" ::: "memory");
    __syncthreads();
    if (b.wv == 0 && __builtin_amdgcn_mbcnt_hi(~0u, __builtin_amdgcn_mbcnt_lo(~0u, 0u)) == 0u) {
        unsigned* bar = b.bar;
        __builtin_amdgcn_s_waitcnt(0);
        unsigned nloc = b.st[0], nx = b.st[1];
        if (nloc == 0u) { xcd_barrier_complete(bar, b.x, nloc, nx); b.st[0] = nloc; b.st[1] = nx; }
        const unsigned old = xb_add(&bar[XB_XSUB(b.x)], 1u);
        const unsigned gen = old / nloc;
        if (old + 1u == (gen + 1u) * nloc) {
            __builtin_amdgcn_fence(__ATOMIC_RELEASE, "agent");
            asm volatile("s_waitcnt vmcnt(0)" ::: "memory");
            const unsigned og = xb_add(&bar[XB_TOP], 1u);
            const unsigned tg = og / nx;
            if (og + 1u == (tg + 1u) * nx) xb_add(&bar[XB_TOPGEN], 1u);
            else XB_SPIN(xb_ld(&bar[XB_TOPGEN]) == tg, bar);
            __builtin_amdgcn_fence(__ATOMIC_ACQUIRE, "agent");
            xb_add(&bar[XB_XGEN(b.x)], 1u);
            asm volatile("s_waitcnt vmcnt(0)" ::: "memory");
        } else {
            XB_SPIN(xb_ld(&bar[XB_XGEN(b.x)]) == gen, bar);
            __builtin_amdgcn_fence(__ATOMIC_ACQUIRE, "agent");
            asm volatile("s_waitcnt vmcnt(0)" ::: "memory");
        }
    }
    __syncthreads();
}

struct Frame {
    LAS unsigned char* lds;
    volatile LAS unsigned* MISC;
    gu32* ctl;
    int tid, lane, wave;
    int vcu, G;
    const float* const* in;
    float* out; unsigned char* ws;
};
__device__ __forceinline__ float wave_sum(float v) {
#pragma unroll
    for (int o = 1; o < 64; o <<= 1) v += __shfl_xor(v, o);
    return v;
}

__device__ __forceinline__ int map_glu(int base, int o, int gate) { return base + 8 * (o >> 2) + 4 * gate + (o & 3); }
__device__ __forceinline__ int dest_row(int mode, int n, int half) {
    if (mode == 0) return n;
    if (mode == 1) { if (n < 512) return n; if (n < 1024) return map_glu(512, n - 512, 0); if (n < 1536) return map_glu(512, n - 1024, 1); return n; }
    if (mode == 2) return n < half ? map_glu(0, n, 0) : map_glu(0, n - half, 1);
    if (mode == 3) return map_glu(0, n, 0);
    return map_glu(0, n, 1);
}
__device__ __forceinline__ void tr_item(const float* W, int K, int N, bf16* WT, int mode, int half, const float* ks, LAS float* scr, int item, int lane) {
    const int nblk = N / 32, kb = item / nblk, nb = item % nblk, k0 = 64 * kb, n0 = 32 * nb;
#pragma unroll 8
    for (int i = 0; i < 32; ++i) { const int kk = 2 * i + (lane >> 5); float v = W[(size_t)(k0 + kk) * N + n0 + (lane & 31)]; if (ks) v *= ks[k0 + kk]; scr[kk * 33 + (lane & 31)] = v; }
    LDS_WAIT(); asm volatile("" ::: "memory");
    const int c = lane & 7;
#pragma unroll
    for (int j = 0; j < 4; ++j) { const int n = (lane >> 3) + 8 * j; const LAS float* s = scr + (8 * c) * 33 + n;
        v4u o; o.x = pk2(s[0 * 33], s[1 * 33]); o.y = pk2(s[2 * 33], s[3 * 33]); o.z = pk2(s[4 * 33], s[5 * 33]); o.w = pk2(s[6 * 33], s[7 * 33]);
        *(GAS v4u*)(WT + (size_t)dest_row(mode, n0 + n, half) * K + k0 + 8 * c) = o; }
    LDS_WAIT(); asm volatile("" ::: "memory");
}
__device__ __forceinline__ void ssm_tables(Frame& F, int g) {
    LAS float* LP = (LAS float*)F.lds;
    LAS float* BB = LP + 33 * 64 * 2;
    LAS float* CC = BB + 2048;
    LAS float* KT = CC + 2048;
    const float* a_re = F.in[I_ARE]; const float* a_im = F.in[I_AIM]; const float* b_re = F.in[I_BRE]; const float* b_im = F.in[I_BIM];
    const float* c_re = F.in[I_CRE]; const float* c_im = F.in[I_CIM]; const float* sd = F.in[I_SD];
    if (F.tid < 64) {
        const int n = F.tid; const float dt = expf(F.in[I_LOGDT][g]); const float ar = a_re[g * 64 + n], ai = a_im[g * 64 + n];
        const float bm = ar * dt, ba = ai * dt;
        for (int tau = 0; tau <= 32; ++tau) { const float mag = expf(bm * (float)tau); float s, c; sincosf(ba * (float)tau, &s, &c); LP[(tau * 64 + n) * 2] = mag * c; LP[(tau * 64 + n) * 2 + 1] = mag * s; }
        const float lr = LP[(64 + n) * 2], li = LP[(64 + n) * 2 + 1];
        const float den = ar * ar + ai * ai, nr = lr - 1.0f, ni = li;
        const float zr = (nr * ar + ni * ai) / den, zi = (ni * ar - nr * ai) / den;
        for (int ch = 0; ch < 16; ++ch) { const float br = b_re[(g * 64 + n) * 16 + ch], bi = b_im[(g * 64 + n) * 16 + ch];
            BB[(n * 16 + ch) * 2] = zr * br - zi * bi; BB[(n * 16 + ch) * 2 + 1] = zr * bi + zi * br; }
        float* l32 = (float*)(F.ws + WS_LAM32);
        l32[(g * 64 + n) * 2] = LP[(32 * 64 + n) * 2]; l32[(g * 64 + n) * 2 + 1] = LP[(32 * 64 + n) * 2 + 1];
    }
    for (int e = F.tid; e < 1024; e += 512) { CC[e * 2] = c_re[g * 1024 + e]; CC[e * 2 + 1] = c_im[g * 1024 + e]; }
    __syncthreads();
    for (int e = F.tid; e < 8192; e += 512) {
        const int tau = e >> 8, cp = (e >> 4) & 15, ch = e & 15; float sum = 0.f;
        for (int n = 0; n < 64; ++n) { const float cr = CC[(cp * 64 + n) * 2], ci = CC[(cp * 64 + n) * 2 + 1], lr = LP[(tau * 64 + n) * 2], li = LP[(tau * 64 + n) * 2 + 1];
            const float pr = cr * lr - ci * li, pi = cr * li + ci * lr; sum += pr * BB[(n * 16 + ch) * 2] - pi * BB[(n * 16 + ch) * 2 + 1]; }
        KT[e] = sum;
    }
    __syncthreads();
    bf16* Bt2 = (bf16*)(F.ws + WS_BT2) + (size_t)g * 512 * 640;
    for (int q = F.tid; q < 512 * 80; q += 512) {
        const int R = q / 80, cc = q % 80, t = R >> 4, cp = R & 15; float v[8];
        if (cc < 64) { const int j = cc >> 1, chb = (cc & 1) * 8;
#pragma unroll
            for (int i = 0; i < 8; ++i) { const int ch = chb + i; float x = (t >= j) ? KT[((t - j) << 8) + cp * 16 + ch] : 0.f; if (t == j && ch == cp) x += sd[g * 16 + ch]; v[i] = x; }
        } else { const int nb = (cc - 64) * 4;
#pragma unroll
            for (int i = 0; i < 4; ++i) { const int n = nb + i; const float cr = CC[(cp * 64 + n) * 2], ci = CC[(cp * 64 + n) * 2 + 1], lr = LP[((t + 1) * 64 + n) * 2], li = LP[((t + 1) * 64 + n) * 2 + 1];
                v[2 * i] = cr * lr - ci * li; v[2 * i + 1] = -(cr * li + ci * lr); }
        }
        v4u o; o.x = pk2(v[0], v[1]); o.y = pk2(v[2], v[3]); o.z = pk2(v[4], v[5]); o.w = pk2(v[6], v[7]);
        *(GAS v4u*)(Bt2 + (size_t)R * 640 + cc * 8) = o;
    }
    bf16* WsT = (bf16*)(F.ws + WS_WST) + (size_t)g * 128 * 512;
    for (int q = F.tid; q < 128 * 64; q += 512) {
        const int R = q >> 6, cc = q & 63, n = R >> 1, ri = R & 1, j = cc >> 1, chb = (cc & 1) * 8; float v[8];
        const float lr = LP[((31 - j) * 64 + n) * 2], li = LP[((31 - j) * 64 + n) * 2 + 1];
#pragma unroll
        for (int i = 0; i < 8; ++i) { const float br = BB[(n * 16 + chb + i) * 2], bi = BB[(n * 16 + chb + i) * 2 + 1]; v[i] = ri == 0 ? (lr * br - li * bi) : (lr * bi + li * br); }
        v4u o; o.x = pk2(v[0], v[1]); o.y = pk2(v[2], v[3]); o.z = pk2(v[4], v[5]); o.w = pk2(v[6], v[7]);
        *(GAS v4u*)(WsT + (size_t)R * 512 + cc * 8) = o;
    }
    __syncthreads();
}
__device__ __forceinline__ void p0_prologue(Frame& F) {
    for (int g = blockIdx.x; g < NGRP; g += F.G) ssm_tables(F, g);
    LAS float* scr = (LAS float*)(F.lds + RING_OFF + F.wave * 16384);
    const int gw = F.vcu * NWAVES + F.wave, NGW = F.G * NWAVES;
    constexpr int I_IN = 16 * 112, I_GLU = 8 * 64, I_CO = 8 * 32, I_O = 16 * 32, I_PG = 16 * 32, I_PLE = 4 * 32, I_EG = 16 * 16, I_ED = 8 * 32;
    constexpr int NITEMS = I_IN + I_GLU + I_CO + I_O + I_PG + I_PLE + NEXP * (2 * I_EG + I_ED);
    for (int it = gw; it < NITEMS; it += NGW) {
        int r = it;
        if (r < I_IN) { tr_item(F.in[I_WIN], D, DIN, (bf16*)(F.ws + WS_WIN), 1, 0, nullptr, scr, r, F.lane); continue; } r -= I_IN;
        if (r < I_GLU) { tr_item(F.in[I_WGLU], DSSM, 2 * D, (bf16*)(F.ws + WS_WGLU), 2, D, nullptr, scr, r, F.lane); continue; } r -= I_GLU;
        if (r < I_CO) { tr_item(F.in[I_WCO], DCONV, D, (bf16*)(F.ws + WS_WCO), 0, 0, nullptr, scr, r, F.lane); continue; } r -= I_CO;
        if (r < I_O) { tr_item(F.in[I_WOUT], D, D, (bf16*)(F.ws + WS_WO), 0, 0, nullptr, scr, r, F.lane); continue; } r -= I_O;
        if (r < I_PG) { tr_item(F.in[I_WPG], D, D, (bf16*)(F.ws + WS_WPG), 0, 0, F.in[I_GPLE], scr, r, F.lane); continue; } r -= I_PG;
        if (r < I_PLE) { tr_item(F.in[I_WPLE], DPLE, D, (bf16*)(F.ws + WS_WPLE), 0, 0, nullptr, scr, r, F.lane); continue; } r -= I_PLE;
        const int e = r / (2 * I_EG + I_ED); r -= e * (2 * I_EG + I_ED);
        if (r < I_EG) { tr_item(F.in[I_WEG] + (size_t)e * D * DEXP, D, DEXP, (bf16*)(F.ws + WS_WGU) + (size_t)e * D * D, 3, 0, F.in[I_GMOE], scr, r, F.lane); continue; } r -= I_EG;
        if (r < I_EG) { tr_item(F.in[I_WEU] + (size_t)e * D * DEXP, D, DEXP, (bf16*)(F.ws + WS_WGU) + (size_t)e * D * D, 4, 0, F.in[I_GMOE], scr, r, F.lane); continue; } r -= I_EG;
        tr_item(F.in[I_WED] + (size_t)e * DEXP * D, DEXP, D, (bf16*)(F.ws + WS_WD) + (size_t)e * D * DEXP, 0, 0, nullptr, scr, r, F.lane);
    }
    { const float* x = F.in[I_X]; const float* gm = F.in[I_GMIX]; bf16* XN = (bf16*)(F.ws + WS_B);
      f32x4 gv[4];
#pragma unroll
      for (int j = 0; j < 4; ++j) gv[j] = *(const f32x4*)(gm + 4 * F.lane + 256 * j);
      for (int m = gw; m < NTOK; m += NGW) {
        const GAS f32x4* xr = (const GAS f32x4*)(x + (size_t)m * D) + F.lane; f32x4 v[4]; float s = 0.f;
#pragma unroll
        for (int j = 0; j < 4; ++j) { v[j] = xr[64 * j]; s += (v[j].x * v[j].x + v[j].y * v[j].y) + (v[j].z * v[j].z + v[j].w * v[j].w); }
        const float r = 1.0f / sqrtf(wave_sum(s) * (1.f / D) + EPS);
        GAS v2u* o8 = (GAS v2u*)(XN + (size_t)m * D) + F.lane;
#pragma unroll
        for (int j = 0; j < 4; ++j) { v2u o; o.x = pk2(v[j].x * r * gv[j].x, v[j].y * r * gv[j].y); o.y = pk2(v[j].z * r * gv[j].z, v[j].w * r * gv[j].w); o8[64 * j] = o; }
      } }
    { const float* p = F.in[I_P]; bf16* PB = (bf16*)(F.ws + WS_PB); const int gt = F.vcu * 512 + F.tid, NGT = F.G * 512;
      for (int q = gt; q < NTOK * DPLE / 8; q += NGT) { const f32x4 a = *(const f32x4*)(p + (size_t)q * 8), b = *(const f32x4*)(p + (size_t)q * 8 + 4);
        v4u o; o.x = pk2(a.x, a.y); o.y = pk2(a.z, a.w); o.z = pk2(b.x, b.y); o.w = pk2(b.z, b.w); *(GAS v4u*)(PB + (size_t)q * 8) = o; }
      bf16* WRT = (bf16*)(F.ws + WS_WRT); const float* gmoe = F.in[I_GMOE];
      for (int q = gt; q < 48 * 1024; q += NGT) { const int o = q >> 10, k = q & 1023; float v = 0.f;
        if (o < 4) v = F.in[I_WRG][k * 4 + o] * gmoe[k]; else if (o < 36) v = F.in[I_WRE][k * 32 + (o - 4)] * gmoe[k];
        const unsigned h = f2bf(v); const float lo = v - __builtin_bit_cast(float, h << 16); WRT[q] = (bf16)h; WRT[48 * 1024 + q] = (bf16)f2bf(lo); } }
}

using pg8::Unit;
typedef const f32x4 (&AccRef)[2][2][4][2];
struct EpiP1 {
    bf16* U; bf16* Z; bf16* SG; const float* bg;
    __device__ __forceinline__ void operator()(AccRef acc, const Unit& u, int wr, int wc, int fr, int fq) const {
        const int r0 = u.pm * 256 + wr * 64 + fr;
        if (u.pn < 2) {
#pragma unroll
            for (int ai = 0; ai < 2; ++ai)
#pragma unroll
                for (int m = 0; m < 4; ++m) { const int r = r0 + ai * 128 + m * 16, b = r >> 11, t = r & 2047;
#pragma unroll
                    for (int bj = 0; bj < 2; ++bj) { const int c0 = u.pn * 256 + bj * 128 + wc * 32 + fq * 8, g = c0 >> 4, ch0 = c0 & 15;
                        const f32x4 v0 = acc[ai][bj][m][0], v1 = acc[ai][bj][m][1];
                        v4u w; w.x = pk2(v0[0], v0[1]); w.y = pk2(v0[2], v0[3]); w.z = pk2(v1[0], v1[1]); w.w = pk2(v1[2], v1[3]);
                        *(GAS v4u*)(U + (((size_t)(b * 32 + g) * 2048 + t) * 16 + ch0)) = w; } }
        } else if (u.pn < 6) {
#pragma unroll
            for (int ai = 0; ai < 2; ++ai)
#pragma unroll
                for (int m = 0; m < 4; ++m) { const int r = r0 + ai * 128 + m * 16;
#pragma unroll
                    for (int bj = 0; bj < 2; ++bj) { const int o0 = (u.pn - 2) * 128 + bj * 64 + wc * 16 + fq * 4;
                        const f32x4 va = acc[ai][bj][m][0], ga = acc[ai][bj][m][1];
                        v2u w; w.x = pk2(va[0] * sigm(ga[0]), va[1] * sigm(ga[1])); w.y = pk2(va[2] * sigm(ga[2]), va[3] * sigm(ga[3]));
                        *(GAS v2u*)(Z + (size_t)r * 512 + o0) = w; } }
        } else {
#pragma unroll
            for (int bj = 0; bj < 2; ++bj) { const int s0 = (u.pn - 6) * 256 + bj * 128 + wc * 32 + fq * 8;
#ifdef DBG_NO_BIAS
                const f32x4 b0 = (f32x4){0.f, 0.f, 0.f, 0.f}, b1 = b0;
#else
                const f32x4 b0 = *(const f32x4*)(bg + s0), b1 = *(const f32x4*)(bg + s0 + 4);
#endif
#pragma unroll
                for (int ai = 0; ai < 2; ++ai)
#pragma unroll
                    for (int m = 0; m < 4; ++m) { const int r = r0 + ai * 128 + m * 16;
#ifdef DBG_BIAS_ONLY
                        const f32x4 v0 = b0, v1 = b1;
#else
                        const f32x4 v0 = acc[ai][bj][m][0] + b0, v1 = acc[ai][bj][m][1] + b1;
#endif
                        v4u w; w.x = pk2(sigm(v0[0]), sigm(v0[1])); w.y = pk2(sigm(v0[2]), sigm(v0[3])); w.z = pk2(sigm(v1[0]), sigm(v1[1])); w.w = pk2(sigm(v1[2]), sigm(v1[3]));
#ifdef DBG_SG_CONST
                        w.x = w.y = w.z = w.w = 0x3f003f00u;
#endif
                        *(GAS v4u*)(SG + (size_t)r * 2048 + s0) = w; } }
        }
    }
};
struct EpiGlu {
    float* MS; const bf16* SG;
    static __device__ __forceinline__ void run(AccRef acc, const Unit& u, int wr, int wc, int fr, int fq, float* __restrict__ MS, const bf16* __restrict__ SG) {
        const int r0 = u.pm * 256 + wr * 64 + fr;
#pragma unroll
        for (int ai = 0; ai < 2; ++ai)
#pragma unroll
            for (int m = 0; m < 4; ++m) { const int r = r0 + ai * 128 + m * 16;
#pragma unroll
                for (int bj = 0; bj < 2; ++bj) { const int o0 = u.pn * 128 + bj * 64 + wc * 16 + fq * 4;
                    const v2u sg = *(const GAS v2u*)(SG + (size_t)r * 2048 + o0);
                    const f32x4 va = acc[ai][bj][m][0], ga = acc[ai][bj][m][1];
                    f32x4 o; o[0] = va[0] * sigm(ga[0]) * bflo(sg.x); o[1] = va[1] * sigm(ga[1]) * bfhi(sg.x); o[2] = va[2] * sigm(ga[2]) * bflo(sg.y); o[3] = va[3] * sigm(ga[3]) * bfhi(sg.y);
                    *(GAS f32x4*)(MS + (size_t)r * 1024 + o0) = o; } }
    }
    __device__ __forceinline__ void operator()(AccRef acc, const Unit& u, int wr, int wc, int fr, int fq) const { run(acc, u, wr, wc, fr, fq, MS, SG); }
};
struct EpiCo {
    const float* MS; const bf16* SG; bf16* MG;
    static __device__ __forceinline__ void run(AccRef acc, const Unit& u, int wr, int wc, int fr, int fq, const float* __restrict__ MS, const bf16* __restrict__ SG, bf16* __restrict__ MG) {
        const int r0 = u.pm * 256 + wr * 64 + fr;
#pragma unroll
        for (int ai = 0; ai < 2; ++ai)
#pragma unroll
            for (int m = 0; m < 4; ++m) { const int r = r0 + ai * 128 + m * 16;
#pragma unroll
                for (int bj = 0; bj < 2; ++bj) { const int c0 = u.pn * 256 + bj * 128 + wc * 32 + fq * 8;
                    const f32x4 m0 = *(const GAS f32x4*)(MS + (size_t)r * 1024 + c0), m1 = *(const GAS f32x4*)(MS + (size_t)r * 1024 + c0 + 4);
                    const v4u sg = *(const GAS v4u*)(SG + (size_t)r * 2048 + 1024 + c0);
                    const f32x4 v0 = acc[ai][bj][m][0], v1 = acc[ai][bj][m][1];
                    v4u w; w.x = pk2(m0[0] + bflo(sg.x) * v0[0], m0[1] + bfhi(sg.x) * v0[1]); w.y = pk2(m0[2] + bflo(sg.y) * v0[2], m0[3] + bfhi(sg.y) * v0[3]);
                    w.z = pk2(m1[0] + bflo(sg.z) * v1[0], m1[1] + bfhi(sg.z) * v1[1]); w.w = pk2(m1[2] + bflo(sg.w) * v1[2], m1[3] + bfhi(sg.w) * v1[3]);
                    *(GAS v4u*)(MG + (size_t)r * 1024 + c0) = w; } }
    }
    __device__ __forceinline__ void operator()(AccRef acc, const Unit& u, int wr, int wc, int fr, int fq) const { run(acc, u, wr, wc, fr, fq, MS, SG, MG); }
};
struct EpiRes {
    const float* X; float* X1;
    static __device__ __forceinline__ void run(AccRef acc, const Unit& u, int wr, int wc, int fr, int fq, const float* __restrict__ X, float* __restrict__ X1) {
        const int r0 = u.pm * 256 + wr * 64 + fr;
#pragma unroll
        for (int ai = 0; ai < 2; ++ai)
#pragma unroll
            for (int m = 0; m < 4; ++m) { const int r = r0 + ai * 128 + m * 16;
#pragma unroll
                for (int bj = 0; bj < 2; ++bj) { const size_t o = (size_t)r * 1024 + u.pn * 256 + bj * 128 + wc * 32 + fq * 8;
                    const f32x4 x0 = *(const GAS f32x4*)(X + o), x1 = *(const GAS f32x4*)(X + o + 4);
                    *(GAS f32x4*)(X1 + o) = x0 + acc[ai][bj][m][0]; *(GAS f32x4*)(X1 + o + 4) = x1 + acc[ai][bj][m][1]; } }
    }
    __device__ __forceinline__ void operator()(AccRef acc, const Unit& u, int wr, int wc, int fr, int fq) const { run(acc, u, wr, wc, fr, fq, X, X1); }
};
struct EpiAct {
    bf16* ACT; const int* ltok; const float* R2;
    static __device__ __forceinline__ void run(AccRef acc, const Unit& u, int wr, int wc, int fr, int fq, bf16* __restrict__ ACT, const int* __restrict__ ltok, const float* __restrict__ R2) {
        float rr[2][4];
#pragma unroll
        for (int ai = 0; ai < 2; ++ai)
#pragma unroll
            for (int m = 0; m < 4; ++m) { const int rl = ai * 128 + wr * 64 + m * 16 + fr; const int tok = (rl < u.rows) ? ltok[u.e * NTOK + u.mt * 256 + rl] : 0; rr[ai][m] = R2[tok]; }
#pragma unroll
        for (int ai = 0; ai < 2; ++ai)
#pragma unroll
            for (int m = 0; m < 4; ++m) { const int rl = ai * 128 + wr * 64 + m * 16 + fr;
                if (rl < u.rows) {
#pragma unroll
                    for (int bj = 0; bj < 2; ++bj) { const int o0 = u.pn * 128 + bj * 64 + wc * 16 + fq * 4;
                        const f32x4 ga = acc[ai][bj][m][0] * rr[ai][m], ua = acc[ai][bj][m][1] * rr[ai][m];
                        v2u w; w.x = pk2(ga[0] * sigm(ga[0]) * ua[0], ga[1] * sigm(ga[1]) * ua[1]); w.y = pk2(ga[2] * sigm(ga[2]) * ua[2], ga[3] * sigm(ga[3]) * ua[3]);
                        *(GAS v2u*)(ACT + (size_t)(u.pm * 256 + rl) * 512 + o0) = w; } } }
    }
    __device__ __forceinline__ void operator()(AccRef acc, const Unit& u, int wr, int wc, int fr, int fq) const { run(acc, u, wr, wc, fr, fq, ACT, ltok, R2); }
};
struct EpiY {
    bf16* Y;
    __device__ __forceinline__ void operator()(AccRef acc, const Unit& u, int wr, int wc, int fr, int fq) const {
#pragma unroll
        for (int ai = 0; ai < 2; ++ai)
#pragma unroll
            for (int m = 0; m < 4; ++m) { const int rl = ai * 128 + wr * 64 + m * 16 + fr;
                if (rl < u.rows) {
#pragma unroll
                    for (int bj = 0; bj < 2; ++bj) { const f32x4 v0 = acc[ai][bj][m][0], v1 = acc[ai][bj][m][1];
                        v4u w; w.x = pk2(v0[0], v0[1]); w.y = pk2(v0[2], v0[3]); w.z = pk2(v1[0], v1[1]); w.w = pk2(v1[2], v1[3]);
                        *(GAS v4u*)(Y + (size_t)(u.cb + rl) * 1024 + u.pn * 256 + bj * 128 + wc * 32 + fq * 8) = w; } } }
    }
};
struct EpiE {
    float* EO;
    __device__ __forceinline__ void operator()(AccRef acc, const Unit& u, int wr, int wc, int fr, int fq) const {
        const int r0 = u.pm * 256 + wr * 64 + fr;
#pragma unroll
        for (int ai = 0; ai < 2; ++ai)
#pragma unroll
            for (int m = 0; m < 4; ++m) { const int r = r0 + ai * 128 + m * 16;
#pragma unroll
                for (int bj = 0; bj < 2; ++bj) { const size_t o = (size_t)r * 1024 + u.pn * 256 + bj * 128 + wc * 32 + fq * 8;
                    *(GAS f32x4*)(EO + o) = acc[ai][bj][m][0]; *(GAS f32x4*)(EO + o + 4) = acc[ai][bj][m][1]; } }
    }
};
struct EpiPle {
    const float* X2; const float* EO; const float* R3; float* X3;
    static __device__ __forceinline__ void run(AccRef acc, const Unit& u, int wr, int wc, int fr, int fq, const float* __restrict__ X2, const float* __restrict__ EO, const float* __restrict__ R3, float* __restrict__ X3) {
        const int r0 = u.pm * 256 + wr * 64 + fr;
#pragma unroll
        for (int ai = 0; ai < 2; ++ai)
#pragma unroll
            for (int m = 0; m < 4; ++m) { const int r = r0 + ai * 128 + m * 16; const float r3 = R3[r];
#pragma unroll
                for (int bj = 0; bj < 2; ++bj) { const size_t o = (size_t)r * 1024 + u.pn * 256 + bj * 128 + wc * 32 + fq * 8;
                    const f32x4 x0 = *(const GAS f32x4*)(X2 + o), x1 = *(const GAS f32x4*)(X2 + o + 4), e0 = *(const GAS f32x4*)(EO + o), e1 = *(const GAS f32x4*)(EO + o + 4);
                    const f32x4 a0 = acc[ai][bj][m][0] * r3, a1 = acc[ai][bj][m][1] * r3; f32x4 y0, y1;
#pragma unroll
                    for (int j = 0; j < 4; ++j) { y0[j] = x0[j] + sigm(a0[j]) * e0[j]; y1[j] = x1[j] + sigm(a1[j]) * e1[j]; }
                    *(GAS f32x4*)(X3 + o) = y0; *(GAS f32x4*)(X3 + o + 4) = y1; } }
    }
    __device__ __forceinline__ void operator()(AccRef acc, const Unit& u, int wr, int wc, int fr, int fq) const { run(acc, u, wr, wc, fr, fq, X2, EO, R3, X3); }
};
struct DenseOrder : pg8::StaticOrder {
    const char* A; const char* Bt; size_t tstep;
    __device__ __forceinline__ const char* a_base(const Unit& u) const { return A + (size_t)u.pm * tstep; }
    __device__ __forceinline__ const char* b_base(const Unit& u) const { return Bt + (size_t)u.pn * tstep; }
    __device__ __forceinline__ unsigned row_off(const Unit&, int) const { return 0u; }
};
struct MoeOrder {
    const LAS int* tb; const LAS int* cn; int G, c, K, npn;
    const char* A; const char* Bt; size_t b_estride; const int* ltok; bool gather;
    __device__ __forceinline__ bool next(int i, Unit& u) const {
        const int L = i * G + c, total = tb[NEXP] * npn; if (L >= total) return false;
        const int tile = L / npn; int e = 0;
        for (int k = 1; k < NEXP; ++k) e += (tb[k] <= tile) ? 1 : 0;
        u.e = e; u.pm = tile; u.pn = L % npn; u.mt = tile - tb[e]; const int left = cn[e] - u.mt * 256; u.rows = left < 256 ? left : 256; u.cb = cn[33 + e] + u.mt * 256; return true;
    }
    __device__ __forceinline__ const char* a_base(const Unit& u) const { return gather ? A : A + (size_t)u.pm * 256 * K * 2; }
    __device__ __forceinline__ const char* b_base(const Unit& u) const { return Bt + (size_t)u.e * b_estride + (size_t)u.pn * 256 * K * 2; }
    __device__ __forceinline__ unsigned row_off(const Unit& u, int r) const { const int tok = (r < u.rows) ? ltok[u.e * NTOK + u.mt * 256 + r] : 0; return (unsigned)tok * (unsigned)(K * 2); }
};

constexpr int SSM_AP = 1296;
__device__ __forceinline__ void ssm_unit(Frame& F, int b, int g) {
    LAS unsigned char* Al = F.lds;
    LAS float* SL = (LAS float*)(F.lds + 64 * SSM_AP);
    const int fr = F.lane & 15, fq = F.lane >> 4, w = F.wave;
    const bf16* Ug = (const bf16*)(F.ws + WS_C) + (size_t)(b * 32 + g) * 2048 * 16;
#pragma unroll 4
    for (int q = F.tid; q < 4096; q += 512) { const int row = q >> 6, cc = q & 63; const v4u v = *(const GAS v4u*)(Ug + row * 512 + cc * 8); *(LAS v4u*)(Al + row * SSM_AP + cc * 16) = v; }
    __syncthreads();
    {
        const bf16* WS = (const bf16*)(F.ws + WS_WST) + ((size_t)g * 128 + 16 * w + fr) * 512 + 8 * fq;
        f32x4 acc[4];
#pragma unroll
        for (int m = 0; m < 4; ++m) acc[m] = (f32x4){0.f, 0.f, 0.f, 0.f};
#pragma unroll 4
        for (int s = 0; s < 16; ++s) { const bf16x8 bw = *(const GAS bf16x8*)(WS + 32 * s);
#pragma unroll
            for (int m = 0; m < 4; ++m) { const bf16x8 a = *(const LAS bf16x8*)(Al + (16 * m + fr) * SSM_AP + (32 * s + 8 * fq) * 2); acc[m] = __builtin_amdgcn_mfma_f32_16x16x32_bf16(bw, a, acc[m], 0, 0, 0); } }
#pragma unroll
        for (int m = 0; m < 4; ++m) *(LAS f32x4*)(SL + (16 * m + fr) * 132 + 16 * w + 4 * fq) = acc[m];
    }
    __syncthreads();
    if (w == 0) {
        const int n = F.lane; const float* l32 = (const float*)(F.ws + WS_LAM32) + (g * 64 + n) * 2; const float lr = l32[0], li = l32[1]; float sr = 0.f, si = 0.f;
        for (int c = 0; c < NCH; ++c) { *(LAS unsigned*)(Al + c * SSM_AP + 1024 + 4 * n) = pk2(sr, si);
            const float ur = SL[c * 132 + 2 * n], ui = SL[c * 132 + 2 * n + 1]; const float nr = lr * sr - li * si + ur, ni = lr * si + li * sr + ui; sr = nr; si = ni; }
    }
    __syncthreads();
    {
        const bf16* BT = (const bf16*)(F.ws + WS_BT2) + ((size_t)g * 512 + 64 * w + fr) * 640 + 8 * fq;
        f32x4 acc[4][4];
#pragma unroll
        for (int m = 0; m < 4; ++m)
#pragma unroll
            for (int n = 0; n < 4; ++n) acc[m][n] = (f32x4){0.f, 0.f, 0.f, 0.f};
#pragma unroll 2
        for (int s = 0; s < 20; ++s) { bf16x8 bf[4], af[4];
#pragma unroll
            for (int n = 0; n < 4; ++n) bf[n] = *(const GAS bf16x8*)(BT + (size_t)n * 16 * 640 + 32 * s);
#pragma unroll
            for (int m = 0; m < 4; ++m) af[m] = *(const LAS bf16x8*)(Al + (16 * m + fr) * SSM_AP + (32 * s + 8 * fq) * 2);
#pragma unroll
            for (int m = 0; m < 4; ++m)
#pragma unroll
                for (int n = 0; n < 4; ++n) acc[m][n] = __builtin_amdgcn_mfma_f32_16x16x32_bf16(bf[n], af[m], acc[m][n], 0, 0, 0); }
        bf16* GY = (bf16*)(F.ws + WS_B);
#pragma unroll
        for (int m = 0; m < 4; ++m)
#pragma unroll
            for (int n = 0; n < 4; ++n) { const int tok = b * SEQ + LC * (16 * m + fr) + 4 * w + n; const f32x4 y = acc[m][n];
                v2u o; o.x = pk2(gelu_tanh(y[0]), gelu_tanh(y[1])); o.y = pk2(gelu_tanh(y[2]), gelu_tanh(y[3]));
                *(GAS v2u*)(GY + (size_t)tok * 512 + 16 * g + 4 * fq) = o; }
    }
    __syncthreads();
}
__device__ __forceinline__ void conv_tile(Frame& F, int tile) {
    const int tok0 = tile * 64, b = tok0 >> 11, t0 = tok0 & 2047;
    LAS unsigned* zl = (LAS unsigned*)F.lds;
    LAS float* red = (LAS float*)(F.lds + 98304);
    const bf16* Z = (const bf16*)(F.ws + WS_C + 16 * MiB);
#pragma unroll 2
    for (int q = F.tid; q < 94 * 64; q += 512) { const int rr = q >> 6, cc = q & 63, t = t0 - 30 + rr; v4u v = (v4u){0u, 0u, 0u, 0u};
        if (t >= 0) v = *(const GAS v4u*)(Z + (size_t)(b * SEQ + t) * 512 + cc * 8); *(LAS v4u*)(zl + rr * 256 + cc * 4) = v; }
    __syncthreads();
    const int wq = F.wave & 3, th = F.wave >> 2, cp = wq * 64 + F.lane;
    float dw0[31], dw1[31];
    {   const float* pw = F.in[I_CDW] + 2 * cp;
        typedef float f32x2 __attribute__((ext_vector_type(2)));
#pragma unroll
        for (int k = 0; k < 31; ++k) { const f32x2 v = *(const GAS f32x2*)pw; dw0[k] = v.x; dw1[k] = v.y; pw += 512; asm volatile("" : "+v"(pw)); } }
    const float cb0 = F.in[I_CDWB][2 * cp], cb1 = F.in[I_CDWB][2 * cp + 1], lg0 = F.in[I_CLNG][2 * cp], lg1 = F.in[I_CLNG][2 * cp + 1], lb0 = F.in[I_CLNB][2 * cp], lb1 = F.in[I_CLNB][2 * cp + 1];
    bf16* CA = (bf16*)(F.ws + WS_B + 16 * MiB);
#pragma unroll 1
    for (int ch = 0; ch < 4; ++ch) {
        float a0[8], a1[8];
#pragma unroll
        for (int o = 0; o < 8; ++o) { a0[o] = cb0; a1[o] = cb1; }
        const int rbase = th * 32 + ch * 8;
#pragma unroll
        for (int r = 0; r < 38; ++r) { const unsigned v = zl[(rbase + r) * 256 + cp]; const float x0 = bflo(v), x1 = bfhi(v);
#pragma unroll
            for (int o = 0; o < 8; ++o) { const int k = r - o; if (k >= 0 && k <= 30) { a0[o] += dw0[k] * x0; a1[o] += dw1[k] * x1; } }
            __builtin_amdgcn_sched_barrier(0); }
        LAS float* rp = red + ((ch & 1) * 2 + th) * 64;
#pragma unroll
        for (int o = 0; o < 8; ++o) { const float s = wave_sum(a0[o] + a1[o]), q = wave_sum(a0[o] * a0[o] + a1[o] * a1[o]); if (F.lane == 0) { rp[(o * 4 + wq) * 2] = s; rp[(o * 4 + wq) * 2 + 1] = q; } }
        __syncthreads();
#pragma unroll
        for (int o = 0; o < 8; ++o) { float s = 0.f, q = 0.f;
#pragma unroll
            for (int k = 0; k < 4; ++k) { s += rp[(o * 4 + k) * 2]; q += rp[(o * 4 + k) * 2 + 1]; }
            const float mean = s * (1.f / 512.f), var = q * (1.f / 512.f) - mean * mean, rstd = 1.0f / sqrtf(var + EPS);
            const float y0 = (a0[o] - mean) * rstd * lg0 + lb0, y1 = (a1[o] - mean) * rstd * lg1 + lb1;
            *(GAS unsigned*)(CA + (size_t)(tok0 + rbase + o) * 512 + 2 * cp) = pk2(y0 * sigm(y0), y1 * sigm(y1)); }
    }
    __syncthreads();
}
__device__ __forceinline__ void router_phase(Frame& F) {
    const int fr = F.lane & 15, fq = F.lane >> 4;
    const float* X1 = (const float*)(F.ws + WS_E); bf16* XB = (bf16*)(F.ws + WS_B); float* R2 = (float*)(F.ws + WS_R2);
    const bf16* WRT = (const bf16*)(F.ws + WS_WRT); int* ltok = (int*)(F.ws + WS_LTOK); int* tinfo = (int*)(F.ws + WS_TINFO);
    LAS float* lg = (LAS float*)(F.lds + F.wave * 4096);
    for (int tile = F.wave * F.G + F.vcu; tile < NTOK / 16; tile += NWAVES * F.G) {
        const int tok = tile * 16 + fr;
        const float* xr = X1 + (size_t)tok * D + 8 * fq; bf16* xb = XB + (size_t)tok * D + 8 * fq; const bf16* wh = WRT + (size_t)fr * D + 8 * fq;
        f32x4 acc[3]; float ss = 0.f;
#pragma unroll
        for (int n = 0; n < 3; ++n) acc[n] = (f32x4){0.f, 0.f, 0.f, 0.f};
#pragma unroll 2
        for (int s = 0; s < 32; ++s) {
            const f32x4 v0 = *(const GAS f32x4*)(xr + 32 * s), v1 = *(const GAS f32x4*)(xr + 32 * s + 4);
            ss += (v0[0] * v0[0] + v0[1] * v0[1]) + (v0[2] * v0[2] + v0[3] * v0[3]) + (v1[0] * v1[0] + v1[1] * v1[1]) + (v1[2] * v1[2] + v1[3] * v1[3]);
            v4u h; h.x = pk2(v0[0], v0[1]); h.y = pk2(v0[2], v0[3]); h.z = pk2(v1[0], v1[1]); h.w = pk2(v1[2], v1[3]);
            *(GAS v4u*)(xb + 32 * s) = h;
            v4u l; l.x = pk2(v0[0] - bflo(h.x), v0[1] - bfhi(h.x)); l.y = pk2(v0[2] - bflo(h.y), v0[3] - bfhi(h.y)); l.z = pk2(v1[0] - bflo(h.z), v1[1] - bfhi(h.z)); l.w = pk2(v1[2] - bflo(h.w), v1[3] - bfhi(h.w));
            const bf16x8 xh = __builtin_bit_cast(bf16x8, h), xl = __builtin_bit_cast(bf16x8, l);
#pragma unroll
            for (int n = 0; n < 3; ++n) { const bf16x8 whi = *(const GAS bf16x8*)(wh + (size_t)n * 16 * D + 32 * s), wlo = *(const GAS bf16x8*)(wh + (size_t)(48 + n * 16) * D + 32 * s);
                acc[n] = __builtin_amdgcn_mfma_f32_16x16x32_bf16(whi, xh, acc[n], 0, 0, 0); acc[n] = __builtin_amdgcn_mfma_f32_16x16x32_bf16(whi, xl, acc[n], 0, 0, 0);
                acc[n] = __builtin_amdgcn_mfma_f32_16x16x32_bf16(wlo, xh, acc[n], 0, 0, 0); }
        }
        ss += __shfl_xor(ss, 16); ss += __shfl_xor(ss, 32);
        const float r = 1.0f / sqrtf(ss * (1.f / D) + EPS);
        if (fq == 0) R2[tok] = r;
#pragma unroll
        for (int n = 0; n < 3; ++n)
#pragma unroll
            for (int j = 0; j < 4; ++j) { const int o = 16 * n + 4 * fq + j; if (o < 36) { const float bias = o < 4 ? F.in[I_BRG][o] : F.in[I_BRE2][o - 4]; lg[fr * 49 + o] = acc[n][j] * r + bias; } }
        LDS_WAIT(); asm volatile("" ::: "memory");
        if (F.lane < 16) {
            const LAS float* l = lg + F.lane * 49; const int token = tile * 16 + F.lane;
            float gm = l[0]; int gs = 0;
#pragma unroll
            for (int i = 1; i < 4; ++i) if (l[i] > gm) { gm = l[i]; gs = i; }
            float den = 0.f;
#pragma unroll
            for (int i = 0; i < 4; ++i) den += __expf(l[i] - gm);
            const float pg = 1.0f / den;
            const LAS float* el = l + 4 + 8 * gs;
            float v1 = el[0]; int j1 = 0;
#pragma unroll
            for (int i = 1; i < 8; ++i) if (el[i] > v1) { v1 = el[i]; j1 = i; }
            float v2 = -3.0e38f; int j2 = 0;
#pragma unroll
            for (int i = 0; i < 8; ++i) if (i != j1 && el[i] > v2) { v2 = el[i]; j2 = i; }
            const float w1 = pg / (1.0f + __expf(v2 - v1)), w2 = pg - w1;
            const int e1 = gs * 8 + j1, e2 = gs * 8 + j2;
            const unsigned s1 = __hip_atomic_fetch_add((unsigned*)(F.ctl + CW_ECNT + 64 * e1), 1u, RLX_AGENT);
            const unsigned s2 = __hip_atomic_fetch_add((unsigned*)(F.ctl + CW_ECNT + 64 * e2), 1u, RLX_AGENT);
            ltok[e1 * NTOK + s1] = token; ltok[e2 * NTOK + s2] = token;
            typedef int i32x4 __attribute__((ext_vector_type(4))); *(GAS i32x4*)(tinfo + 4 * token) = (i32x4){e1 * NTOK + (int)s1, e2 * NTOK + (int)s2, __builtin_bit_cast(int, w1), __builtin_bit_cast(int, w2)};
        }
        LDS_WAIT(); asm volatile("" ::: "memory");
    }
}
__device__ __forceinline__ void rows_to_bf16(Frame& F, const float* X, bf16* XB, float* RR) {
    const int gw = F.vcu * NWAVES + F.wave, NGW = F.G * NWAVES;
    for (int m = gw; m < NTOK; m += NGW) {
        const GAS f32x4* xr = (const GAS f32x4*)(X + (size_t)m * D) + F.lane; f32x4 v[4]; float s = 0.f;
#pragma unroll
        for (int j = 0; j < 4; ++j) { v[j] = xr[64 * j]; s += (v[j].x * v[j].x + v[j].y * v[j].y) + (v[j].z * v[j].z + v[j].w * v[j].w); }
        const float r = 1.0f / sqrtf(wave_sum(s) * (1.f / D) + EPS);
        if (F.lane == 0) RR[m] = r;
        GAS v2u* o8 = (GAS v2u*)(XB + (size_t)m * D) + F.lane;
#pragma unroll
        for (int j = 0; j < 4; ++j) { v2u o; o.x = pk2(v[j].x, v[j].y); o.y = pk2(v[j].z, v[j].w); o8[64 * j] = o; }
    }
}
__device__ __forceinline__ void moe_combine_rows(Frame& F, float* X, const bf16* Y, bf16* XB, float* RR) {
    const int gw = F.vcu * NWAVES + F.wave, NGW = F.G * NWAVES; const LAS int* cs = (const LAS int*)(F.lds + TB_OFF) + 66; const int* tinfo = (const int*)(F.ws + WS_TINFO);
    for (int m = gw; m < NTOK; m += NGW) {
        typedef int i32x4 __attribute__((ext_vector_type(4))); const i32x4 ti = *(const GAS i32x4*)(tinfo + 4 * m);
        const int r1 = cs[ti.x >> 14] + (ti.x & (NTOK - 1)), r2 = cs[ti.y >> 14] + (ti.y & (NTOK - 1)); const int wz = ti.z, ww = ti.w; const float w1 = __builtin_bit_cast(float, wz), w2 = __builtin_bit_cast(float, ww);
        GAS f32x4* xr = (GAS f32x4*)(X + (size_t)m * D) + F.lane; const GAS v2u* y1 = (const GAS v2u*)(Y + (size_t)r1 * D) + F.lane; const GAS v2u* y2 = (const GAS v2u*)(Y + (size_t)r2 * D) + F.lane;
        f32x4 v[4]; float s = 0.f;
#pragma unroll
        for (int j = 0; j < 4; ++j) { const f32x4 x = xr[64 * j]; const v2u a = y1[64 * j], b = y2[64 * j];
#ifdef DBG_P9_W
            v[j].x = x.x + 100.f * w1 + 0.f * bflo(a.x) + 0.f * bflo(b.x);
#else
            v[j].x = x.x + w1 * bflo(a.x) + w2 * bflo(b.x);
#endif
            v[j].y = x.y + w1 * bfhi(a.x) + w2 * bfhi(b.x); v[j].z = x.z + w1 * bflo(a.y) + w2 * bflo(b.y); v[j].w = x.w + w1 * bfhi(a.y) + w2 * bfhi(b.y);
            s += (v[j].x * v[j].x + v[j].y * v[j].y) + (v[j].z * v[j].z + v[j].w * v[j].w); }
        const float r = 1.0f / sqrtf(wave_sum(s) * (1.f / D) + EPS);
        if (F.lane == 0) RR[m] = r;
        GAS v2u* o8 = (GAS v2u*)(XB + (size_t)m * D) + F.lane;
#pragma unroll
        for (int j = 0; j < 4; ++j) { xr[64 * j] = v[j]; v2u o; o.x = pk2(v[j].x, v[j].y); o.y = pk2(v[j].z, v[j].w); o8[64 * j] = o; }
    }
}
__device__ __forceinline__ void final_norm(Frame& F, const float* X, float* out, const float* gf) {
    const int gw = F.vcu * NWAVES + F.wave, NGW = F.G * NWAVES;
    f32x4 gv[4];
#pragma unroll
    for (int j = 0; j < 4; ++j) gv[j] = *(const f32x4*)(gf + 4 * F.lane + 256 * j);
    for (int m = gw; m < NTOK; m += NGW) {
        const GAS f32x4* xr = (const GAS f32x4*)(X + (size_t)m * D) + F.lane; f32x4 v[4]; float s = 0.f;
#pragma unroll
        for (int j = 0; j < 4; ++j) { v[j] = xr[64 * j]; s += (v[j].x * v[j].x + v[j].y * v[j].y) + (v[j].z * v[j].z + v[j].w * v[j].w); }
        const float r = 1.0f / sqrtf(wave_sum(s) * (1.f / D) + EPS);
        GAS f32x4* o = (GAS f32x4*)(out + (size_t)m * D) + F.lane;
#pragma unroll
        for (int j = 0; j < 4; ++j) o[64 * j] = v[j] * r * gv[j];
    }
}
__device__ __forceinline__ void moe_tables(Frame& F) {
    LAS int* tb = (LAS int*)(F.lds + TB_OFF); LAS int* cn = tb + 33; LAS int* cs = cn + 33;
    if (F.tid == 0) { int t = 0, r = 0; for (int e = 0; e < NEXP; ++e) { const int c = (int)__hip_atomic_load((unsigned*)(F.ctl + CW_ECNT + 64 * e), RLX_AGENT); cn[e] = c; tb[e] = t; cs[e] = r; t += (c + 255) >> 8; r += c; } tb[NEXP] = t; cs[NEXP] = r; }
    __syncthreads();
}

struct Args { const float* in[N_IN]; float* out; unsigned char* ws; int ph_lo, ph_hi; };
__global__ void __launch_bounds__(NWAVES * 64, 2) mk_fwd(Args args) {
    extern __shared__ __attribute__((aligned(16))) unsigned char lds[];
    Frame F;
    F.lds = (LAS unsigned char*)lds;
    F.MISC = (volatile LAS unsigned*)(F.lds + MISC_OFF);
    F.tid = threadIdx.x; F.lane = F.tid & 63; F.wave = __builtin_amdgcn_readfirstlane(F.tid >> 6);
    const int wave_s = F.wave;
    F.G = gridDim.x; { const int bx = blockIdx.x; F.vcu = (F.G % 8 == 0) ? (bx % 8) * (F.G / 8) + bx / 8 : bx; }
    F.in = args.in; F.out = args.out; F.ws = args.ws; F.ctl = (gu32*)(args.ws + WS_CTL);
    for (int u = F.tid; u < (LDS_BYTES - LDSCTL_OFF) / 4; u += NWAVES * 64) ((LAS unsigned*)(F.lds + LDSCTL_OFF))[u] = 0u;
    __syncthreads();
    if (N_LAUNCHES != PER_PHASE) (void)xcd_barrier_post((unsigned*)(F.ctl + CW_BAR), F.MISC + 8);
#define GRID_BAR() do { if (N_LAUNCHES == PER_PHASE) { if (F.tid == 0) __hip_atomic_store(F.ctl + CW_TMO, 0xBADBA0u, RLX_AGENT); } else { \
        XcdBarrier bb_; bb_.bar = (unsigned*)(F.ctl + CW_BAR); bb_.x = xb_xcc_id(); bb_.st = (volatile LAS unsigned*)(F.lds + MISC_OFF) + 8; bb_.wv = wave_s; xcd_barrier(bb_); } } while (0)
#define PHASE_BEGIN() do { int l_ = (int)__builtin_amdgcn_mbcnt_hi(~0u, __builtin_amdgcn_mbcnt_lo(~0u, 0u)); asm volatile("" : "+v"(l_)); F.lane = l_; F.wave = wave_s; F.tid = wave_s * 64 + l_; \
        unsigned long long w_ = (unsigned long long)args.ws; asm volatile("" : "+s"(w_)); ws = (unsigned char*)(GAS unsigned char*)w_; F.ws = ws; F.ctl = (gu32*)(ws + WS_CTL); } while (0)
    const int lo = args.ph_lo, hi = args.ph_hi;
#ifndef PHASE_MASK
#define PHASE_MASK 0x1FFF
#endif
#define IN(k) (lo <= (k) && (k) < hi && ((PHASE_MASK >> (k)) & 1))
#define BOTH(k) (IN(k) && IN((k) + 1))
#ifndef REP_MASK
#define REP_MASK 0
#endif
#define REPS(k) (((REP_MASK >> (k)) & 1) ? 2 : 1)
    unsigned char* ws = args.ws;
    const size_t TS1024 = (size_t)256 * 1024 * 2, TS512 = (size_t)256 * 512 * 2, TS256 = (size_t)256 * 256 * 2;

    if (IN(0)) for (int rep_ = 0; rep_ < REPS(0); ++rep_) { PHASE_BEGIN(); p0_prologue(F); if (BOTH(0)) GRID_BAR(); }
    if (IN(1)) for (int rep_ = 0; rep_ < REPS(1); ++rep_) {
        PHASE_BEGIN();
        DenseOrder S; S.init(NTOK, DIN, F.G, (int)blockIdx.x); S.A = (const char*)(ws + WS_B); S.Bt = (const char*)(ws + WS_WIN); S.tstep = TS1024;
        EpiP1 E{(bf16*)(ws + WS_C), (bf16*)(ws + WS_C + 16 * MiB), (bf16*)F.out, F.in[I_BGATE]};
        pg8::gemm_phase<EpiP1, DenseOrder>(F.lds + RING_OFF, F.tid, D, S, E);
        if (BOTH(1)) GRID_BAR();
    }
    if (IN(2)) for (int rep_ = 0; rep_ < REPS(2); ++rep_) {
        PHASE_BEGIN();
#ifndef NO_SSM
        for (int u = F.vcu; u < 8 * NGRP; u += F.G) { const int x = u / 32, idx = u % 32; ssm_unit(F, idx & 7, 4 * x + (idx >> 3)); }
#endif
#ifndef NO_CONV
        PHASE_BEGIN();
        for (int t = blockIdx.x; t < NTOK / 64; t += F.G) conv_tile(F, t);
#endif
        if (BOTH(2)) GRID_BAR();
    }
    if (IN(3)) for (int rep_ = 0; rep_ < REPS(3); ++rep_) {
        PHASE_BEGIN();
        DenseOrder S; S.init(NTOK, 2 * D, F.G, (int)blockIdx.x); S.A = (const char*)(ws + WS_B); S.Bt = (const char*)(ws + WS_WGLU); S.tstep = TS512;
        EpiGlu E{(float*)(ws + WS_E), (const bf16*)F.out};
        pg8::gemm_phase<EpiGlu, DenseOrder>(F.lds + RING_OFF, F.tid, DSSM, S, E);
        if (BOTH(3)) GRID_BAR();
    }
    if (IN(4)) for (int rep_ = 0; rep_ < REPS(4); ++rep_) {
        PHASE_BEGIN();
        DenseOrder S; S.init(NTOK, D, F.G, (int)blockIdx.x); S.A = (const char*)(ws + WS_B + 16 * MiB); S.Bt = (const char*)(ws + WS_WCO); S.tstep = TS512;
        EpiCo E{(const float*)(ws + WS_E), (const bf16*)F.out, (bf16*)(ws + WS_C)};
        pg8::gemm_phase<EpiCo, DenseOrder>(F.lds + RING_OFF, F.tid, DCONV, S, E);
        if (BOTH(4)) GRID_BAR();
    }
    if (IN(5)) for (int rep_ = 0; rep_ < REPS(5); ++rep_) {
        PHASE_BEGIN();
        DenseOrder S; S.init(NTOK, D, F.G, (int)blockIdx.x); S.A = (const char*)(ws + WS_C); S.Bt = (const char*)(ws + WS_WO); S.tstep = TS1024;
        EpiRes E{F.in[I_X], (float*)(ws + WS_E)};
        pg8::gemm_phase<EpiRes, DenseOrder>(F.lds + RING_OFF, F.tid, D, S, E);
        if (BOTH(5)) GRID_BAR();
    }
    if (IN(6)) for (int rep_ = 0; rep_ < REPS(6); ++rep_) { PHASE_BEGIN(); router_phase(F); if (BOTH(6)) GRID_BAR(); }
    if (IN(7)) for (int rep_ = 0; rep_ < REPS(7); ++rep_) {
        PHASE_BEGIN();
        moe_tables(F);
        MoeOrder S; S.tb = (const LAS int*)(F.lds + TB_OFF); S.cn = S.tb + 33; S.G = F.G; S.c = F.vcu; S.K = D; S.npn = 4;
        S.A = (const char*)(ws + WS_B); S.Bt = (const char*)(ws + WS_WGU); S.b_estride = (size_t)D * D * 2; S.ltok = (const int*)(ws + WS_LTOK); S.gather = true;
        EpiAct E{(bf16*)(ws + WS_C), (const int*)(ws + WS_LTOK), (const float*)(ws + WS_R2)};
        pg8::gemm_phase<EpiAct, MoeOrder, true>(F.lds + RING_OFF, F.tid, D, S, E);
        if (BOTH(7)) GRID_BAR();
    }
    if (IN(8)) for (int rep_ = 0; rep_ < REPS(8); ++rep_) {
        PHASE_BEGIN();
        moe_tables(F);
        MoeOrder S; S.tb = (const LAS int*)(F.lds + TB_OFF); S.cn = S.tb + 33; S.G = F.G; S.c = F.vcu; S.K = DEXP; S.npn = 4;
        S.A = (const char*)(ws + WS_C); S.Bt = (const char*)(ws + WS_WD); S.b_estride = (size_t)D * DEXP * 2; S.ltok = (const int*)(ws + WS_LTOK); S.gather = false;
        EpiY E{(bf16*)F.out};
        pg8::gemm_phase<EpiY, MoeOrder, false>(F.lds + RING_OFF, F.tid, DEXP, S, E);
        if (BOTH(8)) GRID_BAR();
    }
    if (IN(9)) for (int rep_ = 0; rep_ < REPS(9); ++rep_) { PHASE_BEGIN(); moe_tables(F); moe_combine_rows(F, (float*)(ws + WS_E), (const bf16*)F.out, (bf16*)(ws + WS_B), (float*)(ws + WS_R3)); if (BOTH(9)) GRID_BAR(); }
#ifdef DBG_SG_COPY
    if (lo <= 10 && 10 < hi) { const int gt = F.vcu * 512 + (int)threadIdx.x, NGT = F.G * 512; const bf16* sgp = (const bf16*)args.out + (size_t)DBG_SG_COPY * NTOK * D; float* dst = (float*)(args.ws + WS_E);
        for (int q = gt; q < NTOK * D; q += NGT) { const float v = bflo((unsigned)sgp[q]); const int col = q & 2047;
#ifdef DBG_SG_SEL_LO
            dst[q] = (v >= 0.f && v <= 1.f) ? 0.f : ((col >= DBG_SG_SEL_LO && col < DBG_SG_SEL_HI) ? 1000.f : 0.f);
#else
            dst[q] = v;
#endif
        } }
#endif
    if (IN(10)) for (int rep_ = 0; rep_ < REPS(10); ++rep_) {
        PHASE_BEGIN();
        DenseOrder S; S.init(NTOK, D, F.G, (int)blockIdx.x); S.A = (const char*)(ws + WS_PB); S.Bt = (const char*)(ws + WS_WPLE); S.tstep = TS256;
        EpiE E{F.out};
        pg8::gemm_phase<EpiE, DenseOrder>(F.lds + RING_OFF, F.tid, DPLE, S, E);
        if (BOTH(10)) GRID_BAR();
    }
    if (IN(11)) for (int rep_ = 0; rep_ < REPS(11); ++rep_) {
        PHASE_BEGIN();
        DenseOrder S; S.init(NTOK, D, F.G, (int)blockIdx.x); S.A = (const char*)(ws + WS_B); S.Bt = (const char*)(ws + WS_WPG); S.tstep = TS1024;
        EpiPle E{(const float*)(ws + WS_E), (const float*)F.out, (const float*)(ws + WS_R3), (float*)(ws + WS_WGU)};
        pg8::gemm_phase<EpiPle, DenseOrder>(F.lds + RING_OFF, F.tid, D, S, E);
        if (BOTH(11)) GRID_BAR();
    }
#ifdef DBG_DUMP_OFF
    if (hi == PER_PHASE) {   PHASE_BEGIN();
        const int gt = F.vcu * 512 + F.tid, NGT = F.G * 512;
#if DBG_DUMP_BF16
        const bf16* src = (const bf16*)(ws + (size_t)DBG_DUMP_OFF);
        for (int q = gt; q < NTOK * D; q += NGT) F.out[q] = bflo((unsigned)src[q]);
#else
        const float* src = (const float*)(ws + (size_t)DBG_DUMP_OFF);
        for (int q = gt; q < NTOK * D; q += NGT) F.out[q] = src[q];
#endif
    }
#else
    if (IN(12)) for (int rep_ = 0; rep_ < REPS(12); ++rep_) { PHASE_BEGIN(); final_norm(F, (const float*)(ws + WS_WGU), F.out, F.in[I_GFIN]); }
#endif
#undef IN
#undef BOTH
}

extern "C" void kernel_launch(void* const* d_in, const int* in_sizes, int n_in, void* d_out, int out_size, void* d_ws, size_t ws_size, hipStream_t stream) {
    static int grid = 0;
    if (grid == 0) {
        if (n_in != N_IN || in_sizes[0] != NTOK * D || out_size != NTOK * D || ws_size < WS_END) { fprintf(stderr, "kernel_launch: unexpected shapes (n_in %d, in0 %d, out %d, ws %zu; need ws >= %zu); nothing launched\n", n_in, n_in > 0 ? in_sizes[0] : -1, out_size, ws_size, (size_t)WS_END); grid = -1; return; }
        int dev = 0, cus = 0, per_cu = 0;
        if (hipGetDevice(&dev) != hipSuccess || hipDeviceGetAttribute(&cus, hipDeviceAttributeMultiprocessorCount, dev) != hipSuccess) { grid = -1; return; }
        if (hipFuncSetAttribute((const void*)mk_fwd, hipFuncAttributeMaxDynamicSharedMemorySize, LDS_BYTES) != hipSuccess) { fprintf(stderr, "kernel_launch: hipFuncSetAttribute failed\n"); grid = -1; return; }
        if (hipOccupancyMaxActiveBlocksPerMultiprocessor(&per_cu, (const void*)mk_fwd, NWAVES * 64, LDS_BYTES) != hipSuccess || per_cu < 1) { fprintf(stderr, "kernel_launch: occupancy query reports %d workgroups per CU\n", per_cu); (void)hipGetLastError(); grid = -1; return; }
        grid = cus;
    }
    if (grid < 0) return;
    if (hipMemsetAsync((char*)d_ws + WS_CTL, 0, CTL_ZERO_BYTES, stream) != hipSuccess) return;
    Args a{};
    for (int i = 0; i < N_IN; ++i) a.in[i] = (const float*)d_in[i];
    a.out = (float*)d_out; a.ws = (unsigned char*)d_ws;
    for (int li = 0; li < N_LAUNCHES; ++li) {
        a.ph_lo = (N_LAUNCHES == PER_PHASE) ? li : 0; a.ph_hi = (N_LAUNCHES == PER_PHASE) ? li + 1 : PER_PHASE;
        hipLaunchKernelGGL(mk_fwd, dim3(grid), dim3(NWAVES * 64), LDS_BYTES, stream, a);
        if (hipPeekAtLastError() != hipSuccess) { fprintf(stderr, "kernel_launch: launch %d failed\n", li); break; }
    }
}
```

```cpp
#include <hip/hip_runtime.h>
#include <cstdio>
#include <cstdint>

namespace pg8 {
#define PG8_LAS __attribute__((address_space(3)))
typedef unsigned short bf16_t;
typedef short bf16x8 __attribute__((ext_vector_type(8)));
typedef float f32x4 __attribute__((ext_vector_type(4)));
typedef unsigned u32x4 __attribute__((ext_vector_type(4)));
typedef unsigned u32x2 __attribute__((ext_vector_type(2)));
constexpr int BM = 256, BK = 64, HALF = 128, HTB = HALF * BK * 2  , STAGE_BYTES = 8 * HTB, NXCD = 8, WGM = 8;

__host__ __device__ __forceinline__ int lds_byte(int r, int c) { const int st = (r >> 4) * 2 + (c >> 5), rr = r & 15, cc = c & 31, ob = rr * 64 + cc * 2; return st * 1024 + (ob ^ (((ob >> 9) & 1) << 5)); }
__host__ __device__ __forceinline__ void stage_rc(int b, int& R, int& C) { const int st = b / 1024, sb = b % 1024, swz = sb ^ (((sb >> 9) & 1) << 5); R = (st >> 1) * 16 + swz / 64; C = (st & 1) * 32 + (swz % 64) / 2; }
__host__ __device__ __forceinline__ int perm32(int rho) { const int n = rho >> 4, i = rho & 15; return 8 * (i >> 2) + 4 * n + (i & 3); }

struct Unit { int pm, pn, e, rows, mt, cb; };

typedef float cvt_f32x2 __attribute__((ext_vector_type(2)));
typedef __bf16 cvt_bf16x2 __attribute__((ext_vector_type(2)));
__device__ __forceinline__ unsigned cvt_pk_bf16(float lo, float hi) { const cvt_f32x2 v = {lo, hi}; const cvt_bf16x2 b = __builtin_convertvector(v, cvt_bf16x2); return __builtin_bit_cast(unsigned, b); }

struct StaticOrder {
    int nM, nN, nwg, G, c;
    __host__ __device__ void init(int M, int N, int G_, int c_) { nM = M / BM; nN = N / BM; nwg = nM * nN; G = G_; c = c_; }
    __host__ __device__ bool next(int i, Unit& u) const {
        const long L = (long)i * G + c; if (L >= nwg) return false;
        int wgid = (int)L; { const int q = nwg / NXCD, r = nwg % NXCD, xcd = wgid % NXCD, off = wgid / NXCD; wgid = (xcd < r ? xcd * (q + 1) : r * (q + 1) + (xcd - r) * q) + off; }
        const int nig = WGM * nN, gid = wgid / nig, fm = gid * WGM, gsz = (nM - fm) < WGM ? (nM - fm) : WGM;
        u.pm = fm + ((wgid % nig) % gsz); u.pn = (wgid % nig) / gsz; u.e = 0; u.rows = BM; u.mt = 0; u.cb = 0; return true;
    }
};

template <class Epi, class Sched, bool GATHER = false, bool ALIGN_EPI = true>
__device__ __forceinline__ void gemm_phase(PG8_LAS unsigned char* lds, const int tid, const int K, const Sched& S, const Epi& E) {
    const int wid = __builtin_amdgcn_readfirstlane(tid >> 6), lane = tid & 63, wr = wid >> 2, wc = wid & 3, fr = lane & 15, fq = lane >> 4;
    const int nt = K / BK;
    unsigned voffA[2], voffB[2]; int rowA[2], colA[2];
#pragma unroll
    for (int i = 0; i < 2; ++i) { int R, C; stage_rc(tid * 16 + i * 8192, R, C); const int Rb = (R & ~31) + perm32(R & 31);
        voffA[i] = (unsigned)(R * K + C) * 2u; voffB[i] = (unsigned)(Rb * K + C) * 2u; rowA[i] = R; colA[i] = C * 2; }
    const size_t kstep = (size_t)(BK * 2);
    const unsigned hstep = (unsigned)HALF * (unsigned)K * 2u;
    const unsigned ldsw = (unsigned)wid * 1024u;
    const int aoff = lds_byte(wr * 64 + fr, fq * 8), boff = lds_byte(wc * 32 + fr, fq * 8);
#define PG8_SA(b, h) (((b) * 2 + (h)) * HTB)
#define PG8_SB(b, h) ((4 + (b) * 2 + (h)) * HTB)
#define PG8_STAGE(bufoff, gbase, voff) do { _Pragma("unroll") for (int _i = 0; _i < 2; ++_i) \
        __builtin_amdgcn_global_load_lds((const unsigned*)((const char*)(gbase) + (voff)[_i]), (PG8_LAS unsigned*)(lds + (bufoff) + ldsw + _i * 8192), 16, 0, 0); } while (0)
#define PG8_STAGE_A(bufoff, gbase, V, h) do { _Pragma("unroll") for (int _i = 0; _i < 2; ++_i) { const unsigned _o = GATHER ? (V)[h][_i] : (voffA[_i] + (unsigned)(h) * hstep); \
        __builtin_amdgcn_global_load_lds((const unsigned*)((const char*)(gbase) + _o), (PG8_LAS unsigned*)(lds + (bufoff) + ldsw + _i * 8192), 16, 0, 0); } } while (0)
#define PG8_LDA(dst, b, h) do { _Pragma("unroll") for (int m = 0; m < 4; ++m) _Pragma("unroll") for (int k = 0; k < 2; ++k) dst[m][k] = *(const PG8_LAS bf16x8*)(lds + PG8_SA(b, h) + aoff + m * 2048 + k * 1024); } while (0)
#define PG8_LDB(dst, b, h) do { _Pragma("unroll") for (int n = 0; n < 2; ++n) _Pragma("unroll") for (int k = 0; k < 2; ++k) dst[n][k] = *(const PG8_LAS bf16x8*)(lds + PG8_SB(b, h) + boff + n * 2048 + k * 1024); } while (0)
#define PG8_MMA(ai, bj, At, Bt) do { __builtin_amdgcn_s_setprio(1); _Pragma("unroll") for (int m = 0; m < 4; ++m) _Pragma("unroll") for (int n = 0; n < 2; ++n) _Pragma("unroll") for (int k = 0; k < 2; ++k) \
        acc[ai][bj][m][n] = __builtin_amdgcn_mfma_f32_16x16x32_bf16(Bt[n][k], At[m][k], acc[ai][bj][m][n], 0, 0, 0); __builtin_amdgcn_s_setprio(0); } while (0)
#define PG8_WAIT_V(n) asm volatile("s_waitcnt vmcnt(" #n ")" ::: "memory")
#define PG8_WAIT_L(n) asm volatile("s_waitcnt lgkmcnt(" #n ")" ::: "memory")
#define PG8_BAR __builtin_amdgcn_s_barrier()
#define PG8_SCHED __builtin_amdgcn_sched_barrier(0)
    Unit cur, nxt; int ui = 0;
    if (!S.next(0, cur)) return;
    f32x4 acc[2][2][4][2];
#pragma unroll
    for (int a = 0; a < 2; ++a)
#pragma unroll
        for (int b = 0; b < 2; ++b)
#pragma unroll
            for (int m = 0; m < 4; ++m)
#pragma unroll
                for (int n = 0; n < 2; ++n) acc[a][b][m][n] = (f32x4){0.f, 0.f, 0.f, 0.f};
    bf16x8 At[4][2], B0[2][2], B1[2][2];
    unsigned cva[2][2] = {{0u, 0u}, {0u, 0u}}, nva[2][2] = {{0u, 0u}, {0u, 0u}};
    const char* cA = S.a_base(cur); const char* cB = S.b_base(cur);
    if constexpr (GATHER) {
#pragma unroll
        for (int h = 0; h < 2; ++h)
#pragma unroll
            for (int i = 0; i < 2; ++i) cva[h][i] = S.row_off(cur, h * HALF + rowA[i]) + (unsigned)colA[i];
    }
    PG8_STAGE(PG8_SB(0, 0), cB, voffB); PG8_STAGE(PG8_SB(0, 1), cB + hstep, voffB); PG8_STAGE_A(PG8_SA(0, 0), cA, cva, 0); PG8_STAGE_A(PG8_SA(0, 1), cA, cva, 1);
    if (wr == 1) PG8_BAR;
    PG8_WAIT_V(2); PG8_BAR;
    PG8_STAGE(PG8_SB(1, 0), cB + kstep, voffB); PG8_STAGE_A(PG8_SA(1, 0), cA + kstep, cva, 0); PG8_STAGE(PG8_SB(1, 1), cB + hstep + kstep, voffB);
    PG8_WAIT_V(6); PG8_BAR;
    for (;;) {
        const bool has_next = S.next(ui + 1, nxt);
        const char* nA = has_next ? S.a_base(nxt) : cA; const char* nB = has_next ? S.b_base(nxt) : cB;
        if constexpr (GATHER) {
#pragma unroll
            for (int h = 0; h < 2; ++h)
#pragma unroll
                for (int i = 0; i < 2; ++i) nva[h][i] = has_next ? (S.row_off(nxt, h * HALF + rowA[i]) + (unsigned)colA[i]) : cva[h][i];
        }
#pragma unroll 1
        for (int t = 0; t < nt; t += 2) {
            const bool last = (t == nt - 2);
            const char* a1 = cA + (size_t)(t + 1) * kstep;
            const char* a2 = last ? nA : cA + (size_t)(t + 2) * kstep; const char* b2 = last ? nB : cB + (size_t)(t + 2) * kstep;
            const char* a3 = a2 + kstep; const char* b3 = b2 + kstep;
            PG8_LDB(B0, 0, 0); PG8_LDB(B1, 0, 1); PG8_SCHED; PG8_LDA(At, 0, 0); PG8_STAGE_A(PG8_SA(1, 1), a1, cva, 1);
            if constexpr (GATHER) { if (last) {
#pragma unroll
                for (int h = 0; h < 2; ++h)
#pragma unroll
                    for (int i = 0; i < 2; ++i) cva[h][i] = nva[h][i]; } }
            PG8_WAIT_V(8); PG8_WAIT_L(0); PG8_BAR; PG8_MMA(0, 0, At, B0); PG8_MMA(0, 1, At, B1); PG8_BAR; PG8_SCHED;
            PG8_LDA(At, 0, 1); PG8_STAGE(PG8_SB(0, 0), b2, voffB); PG8_STAGE(PG8_SB(0, 1), b2 + hstep, voffB); PG8_STAGE_A(PG8_SA(0, 0), a2, cva, 0);
            PG8_WAIT_V(8); PG8_WAIT_L(0); PG8_BAR; PG8_MMA(1, 0, At, B0); PG8_MMA(1, 1, At, B1); PG8_BAR; PG8_SCHED;
            PG8_LDB(B0, 1, 0); PG8_LDB(B1, 1, 1); PG8_SCHED; PG8_LDA(At, 1, 0); PG8_STAGE_A(PG8_SA(0, 1), a2, cva, 1);
            PG8_WAIT_V(8); PG8_WAIT_L(0); PG8_BAR; PG8_MMA(0, 0, At, B0); PG8_MMA(0, 1, At, B1); PG8_BAR; PG8_SCHED;
            PG8_LDA(At, 1, 1); PG8_STAGE(PG8_SB(1, 0), b3, voffB); PG8_STAGE(PG8_SB(1, 1), b3 + hstep, voffB); PG8_STAGE_A(PG8_SA(1, 0), a3, cva, 0);
            PG8_WAIT_V(8); PG8_WAIT_L(0); PG8_BAR; PG8_MMA(1, 0, At, B0); PG8_MMA(1, 1, At, B1); PG8_BAR; PG8_SCHED;
        }
        if constexpr (ALIGN_EPI) { if (wr == 0) PG8_BAR; }
#ifdef DBG_EPI_NOP
        asm volatile("s_nop 15\n s_nop 15\n s_nop 15\n s_nop 15" ::: "memory");
#endif
        E(acc, cur, wr, wc, fr, fq);
        if (!has_next) break;
#pragma unroll
        for (int a = 0; a < 2; ++a)
#pragma unroll
            for (int b = 0; b < 2; ++b)
#pragma unroll
                for (int m = 0; m < 4; ++m)
#pragma unroll
                    for (int n = 0; n < 2; ++n) acc[a][b][m][n] = (f32x4){0.f, 0.f, 0.f, 0.f};
        cur = nxt; cA = nA; cB = nB; ++ui;
        if constexpr (ALIGN_EPI) { if (wr == 1) PG8_BAR; }
    }
    PG8_WAIT_V(0);
    if constexpr (!ALIGN_EPI) { if (wr == 0) PG8_BAR; }
    PG8_BAR;
#undef PG8_SA
#undef PG8_SB
#undef PG8_STAGE
#undef PG8_STAGE_A
#undef PG8_LDA
#undef PG8_LDB
#undef PG8_MMA
#undef PG8_WAIT_V
#undef PG8_WAIT_L
#undef PG8_BAR
#undef PG8_SCHED
}
}

constexpr int NWAVES = 8;
#ifndef MK_N_LAUNCHES
#define MK_N_LAUNCHES 1
#endif
constexpr int PER_PHASE = 13;
constexpr int N_LAUNCHES = MK_N_LAUNCHES;

constexpr int NTOK = 16384, SEQ = 2048, D = 1024, DIN = 3584, DSSM = 512, DCONV = 512, NGRP = 32, NST = 64, GWID = 16, CONVW = 31;
constexpr int NEXP = 32, EPG = 8, DEXP = 512, DPLE = 256, LC = 32, NCH = 64;
constexpr float EPS = 1e-6f;
enum In { I_X = 0, I_P, I_GMIX, I_WIN, I_BGATE, I_ARE, I_AIM, I_LOGDT, I_BRE, I_BIM, I_CRE, I_CIM, I_SD, I_WGLU, I_CDW, I_CDWB, I_CLNG, I_CLNB, I_WCO, I_WOUT, I_GMOE, I_WRG, I_BRG, I_WRE, I_BRE2,
          I_WEG, I_WEU, I_WED, I_GPLE, I_WPG, I_WPLE, I_GFIN, N_IN };

constexpr size_t MiB = 1u << 20;
constexpr size_t WS_CTL = 0, CTL_ZERO_BYTES = 1 * MiB;
constexpr size_t WS_LTOK = 1 * MiB;
constexpr size_t WS_TINFO = 3 * MiB;
constexpr size_t WS_R2 = 5 * MiB, WS_R3 = WS_R2 + 65536, WS_LAM32 = WS_R3 + 65536, WS_WRT = WS_R2 + 262144;
constexpr size_t WS_WST = 6 * MiB;
constexpr size_t WS_BT2 = 10 * MiB;
constexpr size_t WS_WIN = 31 * MiB, WS_WGLU = 38 * MiB, WS_WCO = 40 * MiB, WS_WO = 41 * MiB, WS_WPG = 43 * MiB, WS_WPLE = 45 * MiB;
constexpr size_t WS_PB = 46 * MiB;
constexpr size_t WS_WGU = 54 * MiB;
constexpr size_t WS_WD = 118 * MiB;
constexpr size_t WS_B = 150 * MiB;
constexpr size_t WS_C = 182 * MiB;
constexpr size_t WS_E = 224 * MiB;
constexpr size_t WS_END = 288 * MiB;
constexpr int CW_TMO = 0, CW_CODE = 1, CW_BAR = 4096, CW_ECNT = 16384;
static_assert((CW_ECNT + 64 * NEXP) * 4 <= (int)CTL_ZERO_BYTES, "CTL words inside the memset region");

constexpr int RING_OFF = 0, RING_BYTES = 131072;
constexpr int LDSCTL_OFF = RING_BYTES, MISC_OFF = LDSCTL_OFF + 320;
constexpr int TB_OFF = LDSCTL_OFF + 1024;
constexpr int LDS_BYTES = 147456;
static_assert(TB_OFF + 100 * 4 <= LDS_BYTES, "LDS map");

#define GAS __attribute__((address_space(1)))
#define LAS __attribute__((address_space(3)))
typedef unsigned short bf16;
typedef unsigned v4u __attribute__((ext_vector_type(4)));
typedef unsigned v2u __attribute__((ext_vector_type(2)));
typedef float f32x4 __attribute__((ext_vector_type(4)));
typedef short bf16x8 __attribute__((ext_vector_type(8)));
typedef GAS unsigned gu32;
#define RLX_AGENT __ATOMIC_RELAXED, __HIP_MEMORY_SCOPE_AGENT
#define LDS_WAIT() asm volatile("s_waitcnt lgkmcnt(0)" ::: "memory")
#define VM_WAIT() asm volatile("s_waitcnt vmcnt(0)" ::: "memory")
__device__ __forceinline__ unsigned f2bf(float f) { unsigned u = __builtin_bit_cast(unsigned, f); return (u + 0x7fffu + ((u >> 16) & 1u)) >> 16; }
__device__ __forceinline__ unsigned pk2(float lo, float hi) { return pg8::cvt_pk_bf16(lo, hi); }
__device__ __forceinline__ float bflo(unsigned v) { return __builtin_bit_cast(float, v << 16); }
__device__ __forceinline__ float bfhi(unsigned v) { return __builtin_bit_cast(float, v & 0xffff0000u); }
__device__ __forceinline__ float sigm(float x) { return __builtin_amdgcn_rcpf(1.0f + __expf(-x)); }
__device__ __forceinline__ float gelu_tanh(float y) { const float t = 1.5957691216f * (y + 0.044715f * y * y * y); return y * sigm(t); }

#define XB_TMO      128
#define XB_XCNT(j)  (256  + 64 * (j))
#define XB_XSUB(j)  (1280 + 64 * (j))
#define XB_XGEN(j)  (2304 + 64 * (j))
#define XB_TOP      3328
#define XB_TOPGEN   3392
#define XCD_BAR_WORDS 3456
#define XB_SPIN_CAP (1u << 18)

__device__ __forceinline__ unsigned xb_ld(unsigned* p)              { return __hip_atomic_load(p, __ATOMIC_RELAXED, __HIP_MEMORY_SCOPE_AGENT); }
__device__ __forceinline__ unsigned xb_add(unsigned* p, unsigned v) { return __hip_atomic_fetch_add(p, v, __ATOMIC_RELAXED, __HIP_MEMORY_SCOPE_AGENT); }
__device__ __forceinline__ unsigned xb_xcc_id() { return (unsigned)__builtin_amdgcn_s_getreg((3 << 11) | 20) & 0xFu; }
#define XB_SPIN(cond, bar) do { unsigned _sp = 0; while (cond) { __builtin_amdgcn_s_sleep(1); \
    if ((++_sp & 255u) == 0u) { if (xb_ld(&(bar)[XB_TMO])) break; if (_sp > XB_SPIN_CAP) { atomicAdd(&(bar)[XB_TMO], 1u); break; } } } } while (0)

struct XcdBarrier {
    unsigned* bar; unsigned x;
    volatile LAS unsigned* st;
    int wv;
};

__device__ __forceinline__ XcdBarrier xcd_barrier_post(unsigned* bar, volatile LAS unsigned* st) {
    XcdBarrier b; b.bar = bar; b.x = xb_xcc_id(); b.st = st; b.wv = 0;
    if (threadIdx.x == 0) (void)xb_add(&bar[XB_XCNT(b.x)], 1u);
    return b;
}
__device__ __forceinline__ void xcd_barrier_complete(unsigned* bar, unsigned x, unsigned& nloc, unsigned& nx) {
    const unsigned G = gridDim.x * gridDim.y * gridDim.z;
    unsigned sum, cnt, mine, sp = 0u;
    for (;;) {
        sum = 0u; cnt = 0u; mine = 0u;
#pragma unroll
        for (unsigned j = 0; j < 16; ++j) { const unsigned c = xb_ld(&bar[XB_XCNT(j)]); sum += c; cnt += (c > 0u) ? 1u : 0u; mine = (j == x) ? c : mine; }
        if (sum == G) break;
        __builtin_amdgcn_s_sleep(1);
        if ((++sp & 255u) == 0u) { if (xb_ld(&bar[XB_TMO])) break; if (sp > XB_SPIN_CAP) { atomicAdd(&bar[XB_TMO], 1u); break; } }
    }
    nloc = mine > 0u ? mine : 1u; nx = cnt > 0u ? cnt : 1u;
}

__device__ __forceinline__ void xcd_barrier(const XcdBarrier& b) {
    asm volatile("s_waitcnt vmcnt(0)" ::: "memory");
    __syncthreads();
    if (b.wv == 0 && __builtin_amdgcn_mbcnt_hi(~0u, __builtin_amdgcn_mbcnt_lo(~0u, 0u)) == 0u) {
        unsigned* bar = b.bar;
        __builtin_amdgcn_s_waitcnt(0);
        unsigned nloc = b.st[0], nx = b.st[1];
        if (nloc == 0u) { xcd_barrier_complete(bar, b.x, nloc, nx); b.st[0] = nloc; b.st[1] = nx; }
        const unsigned old = xb_add(&bar[XB_XSUB(b.x)], 1u);
        const unsigned gen = old / nloc;
        if (old + 1u == (gen + 1u) * nloc) {
            __builtin_amdgcn_fence(__ATOMIC_RELEASE, "agent");
            asm volatile("s_waitcnt vmcnt(0)" ::: "memory");
            const unsigned og = xb_add(&bar[XB_TOP], 1u);
            const unsigned tg = og / nx;
            if (og + 1u == (tg + 1u) * nx) xb_add(&bar[XB_TOPGEN], 1u);
            else XB_SPIN(xb_ld(&bar[XB_TOPGEN]) == tg, bar);
            __builtin_amdgcn_fence(__ATOMIC_ACQUIRE, "agent");
            xb_add(&bar[XB_XGEN(b.x)], 1u);
            asm volatile("s_waitcnt vmcnt(0)" ::: "memory");
        } else {
            XB_SPIN(xb_ld(&bar[XB_XGEN(b.x)]) == gen, bar);
            __builtin_amdgcn_fence(__ATOMIC_ACQUIRE, "agent");
            asm volatile("s_waitcnt vmcnt(0)" ::: "memory");
        }
    }
    __syncthreads();
}

struct Frame {
    LAS unsigned char* lds;
    volatile LAS unsigned* MISC;
    gu32* ctl;
    int tid, lane, wave;
    int vcu, G;
    const float* const* in;
    float* out; unsigned char* ws;
};
__device__ __forceinline__ float wave_sum(float v) {
#pragma unroll
    for (int o = 1; o < 64; o <<= 1) v += __shfl_xor(v, o);
    return v;
}

__device__ __forceinline__ int map_glu(int base, int o, int gate) { return base + 8 * (o >> 2) + 4 * gate + (o & 3); }
__device__ __forceinline__ int dest_row(int mode, int n, int half) {
    if (mode == 0) return n;
    if (mode == 1) { if (n < 512) return n; if (n < 1024) return map_glu(512, n - 512, 0); if (n < 1536) return map_glu(512, n - 1024, 1); return n; }
    if (mode == 2) return n < half ? map_glu(0, n, 0) : map_glu(0, n - half, 1);
    if (mode == 3) return map_glu(0, n, 0);
    return map_glu(0, n, 1);
}
__device__ __forceinline__ void tr_item(const float* W, int K, int N, bf16* WT, int mode, int half, const float* ks, LAS unsigned* T, int item, int lane) {
    const int nblk = N / 64, kb = item / nblk, nb = item % nblk, k0 = 64 * kb, n0 = 64 * nb, nq = lane & 15, kq = lane >> 4;
    f32x4 v[8][2];
    const float* src = W + (size_t)(k0 + 2 * kq) * N + n0 + 4 * nq;
#pragma unroll
    for (int s = 0; s < 8; ++s) { v[s][0] = *(const GAS f32x4*)(src + (size_t)(8 * s) * N); v[s][1] = *(const GAS f32x4*)(src + (size_t)(8 * s + 1) * N); }
    if (ks) {
#pragma unroll
        for (int s = 0; s < 8; ++s) { const float a = ks[k0 + 8 * s + 2 * kq], b = ks[k0 + 8 * s + 2 * kq + 1]; v[s][0] *= a; v[s][1] *= b; } }
#pragma unroll
    for (int s = 0; s < 8; ++s)
#pragma unroll
        for (int jj = 0; jj < 4; ++jj) T[(4 * nq + jj) * 33 + 4 * s + kq] = pk2(v[s][0][jj], v[s][1][jj]);
    LDS_WAIT(); asm volatile("" ::: "memory");
    const int c = lane & 7;
#pragma unroll
    for (int i = 0; i < 8; ++i) { const int n = (lane >> 3) + 8 * i; const LAS unsigned* t = T + n * 33 + 4 * c;
        v4u o; o.x = t[0]; o.y = t[1]; o.z = t[2]; o.w = t[3];
        *(GAS v4u*)(WT + (size_t)dest_row(mode, n0 + n, half) * K + k0 + 8 * c) = o; }
    LDS_WAIT(); asm volatile("" ::: "memory");
}
__device__ __forceinline__ void ssm_tables(Frame& F, int g) {
    LAS float* LP = (LAS float*)F.lds;
    LAS float* BB = LP + 33 * 64 * 2;
    LAS float* CC = BB + 2048;
    LAS float* KT = CC + 2048;
    const float* a_re = F.in[I_ARE]; const float* a_im = F.in[I_AIM]; const float* b_re = F.in[I_BRE]; const float* b_im = F.in[I_BIM];
    const float* c_re = F.in[I_CRE]; const float* c_im = F.in[I_CIM]; const float* sd = F.in[I_SD];
    {   const int n = F.tid & 63, tq = F.tid >> 6; const float dt = expf(F.in[I_LOGDT][g]); const float ar = a_re[g * 64 + n], ai = a_im[g * 64 + n]; const float bm = ar * dt, ba = ai * dt;
        for (int tau = tq; tau <= 32; tau += 8) { const float mag = expf(bm * (float)tau); float sn, cs; sincosf(ba * (float)tau, &sn, &cs); LP[(tau * 64 + n) * 2] = mag * cs; LP[(tau * 64 + n) * 2 + 1] = mag * sn; }
        const float mag = expf(bm); float sn, cs; sincosf(ba, &sn, &cs); const float lr = mag * cs, li = mag * sn;
        const float den = ar * ar + ai * ai, nr = lr - 1.0f, ni = li; const float zr = (nr * ar + ni * ai) / den, zi = (ni * ar - nr * ai) / den;
#pragma unroll
        for (int k = 0; k < 2; ++k) { const int ch = 2 * tq + k; const float br = b_re[(g * 64 + n) * 16 + ch], bi = b_im[(g * 64 + n) * 16 + ch];
            BB[(n * 16 + ch) * 2] = zr * br - zi * bi; BB[(n * 16 + ch) * 2 + 1] = zr * bi + zi * br; } }
    for (int e = F.tid; e < 1024; e += 512) { CC[e * 2] = c_re[g * 1024 + e]; CC[e * 2 + 1] = c_im[g * 1024 + e]; }
    __syncthreads();
    if (F.tid < 64) { float* l32 = (float*)(F.ws + WS_LAM32); l32[(g * 64 + F.tid) * 2] = LP[(32 * 64 + F.tid) * 2]; l32[(g * 64 + F.tid) * 2 + 1] = LP[(32 * 64 + F.tid) * 2 + 1]; }
    {
        const int p = F.tid & 255, cp = p >> 4, ch = p & 15, t0 = (F.tid >> 8) * 16; float kacc[16];
#pragma unroll
        for (int t = 0; t < 16; ++t) kacc[t] = 0.f;
        for (int n = 0; n < 64; ++n) {
            const float cr = CC[(cp * 64 + n) * 2], ci = CC[(cp * 64 + n) * 2 + 1], br = BB[(n * 16 + ch) * 2], bi = BB[(n * 16 + ch) * 2 + 1];
            const float pr = cr * br - ci * bi, pi = cr * bi + ci * br, l0r = LP[(t0 * 64 + n) * 2], l0i = LP[(t0 * 64 + n) * 2 + 1], lr = LP[(64 + n) * 2], li = LP[(64 + n) * 2 + 1];
            float wr_ = pr * l0r - pi * l0i, wi_ = pr * l0i + pi * l0r;
#pragma unroll
            for (int t = 0; t < 16; ++t) { kacc[t] += wr_; const float nr = wr_ * lr - wi_ * li, ni = wr_ * li + wi_ * lr; wr_ = nr; wi_ = ni; }
        }
#pragma unroll
        for (int t = 0; t < 16; ++t) KT[((t0 + t) << 8) + p] = kacc[t];
    }
    __syncthreads();
    bf16* Bt2 = (bf16*)(F.ws + WS_BT2) + (size_t)g * 512 * 640;
    for (int q = F.tid; q < 512 * 80; q += 512) {
        const int R = q / 80, cc = q % 80, t = R >> 4, cp = R & 15; float v[8];
        if (cc < 64) { const int j = cc >> 1, chb = (cc & 1) * 8;
#pragma unroll
            for (int i = 0; i < 8; ++i) { const int ch = chb + i; float x = (t >= j) ? KT[((t - j) << 8) + cp * 16 + ch] : 0.f; if (t == j && ch == cp) x += sd[g * 16 + ch]; v[i] = x; }
        } else { const int nb = (cc - 64) * 4;
#pragma unroll
            for (int i = 0; i < 4; ++i) { const int n = nb + i; const float cr = CC[(cp * 64 + n) * 2], ci = CC[(cp * 64 + n) * 2 + 1], lr = LP[((t + 1) * 64 + n) * 2], li = LP[((t + 1) * 64 + n) * 2 + 1];
                v[2 * i] = cr * lr - ci * li; v[2 * i + 1] = -(cr * li + ci * lr); }
        }
        v4u o; o.x = pk2(v[0], v[1]); o.y = pk2(v[2], v[3]); o.z = pk2(v[4], v[5]); o.w = pk2(v[6], v[7]);
        *(GAS v4u*)(Bt2 + (size_t)R * 640 + cc * 8) = o;
    }
    bf16* WsT = (bf16*)(F.ws + WS_WST) + (size_t)g * 128 * 512;
    for (int q = F.tid; q < 128 * 64; q += 512) {
        const int R = q >> 6, cc = q & 63, n = R >> 1, ri = R & 1, j = cc >> 1, chb = (cc & 1) * 8; float v[8];
        const float lr = LP[((31 - j) * 64 + n) * 2], li = LP[((31 - j) * 64 + n) * 2 + 1];
#pragma unroll
        for (int i = 0; i < 8; ++i) { const float br = BB[(n * 16 + chb + i) * 2], bi = BB[(n * 16 + chb + i) * 2 + 1]; v[i] = ri == 0 ? (lr * br - li * bi) : (lr * bi + li * br); }
        v4u o; o.x = pk2(v[0], v[1]); o.y = pk2(v[2], v[3]); o.z = pk2(v[4], v[5]); o.w = pk2(v[6], v[7]);
        *(GAS v4u*)(WsT + (size_t)R * 512 + cc * 8) = o;
    }
    __syncthreads();
}
__device__ __forceinline__ void p0_prologue(Frame& F) {
    const bool split = F.G > NGRP; const bool tabler = split && (int)blockIdx.x < NGRP;
    if (!split || tabler) for (int g = blockIdx.x; g < NGRP; g += F.G) ssm_tables(F, g);
    LAS unsigned* scr = (LAS unsigned*)(F.lds + RING_OFF + F.wave * 16384);
    const int gw = F.vcu * NWAVES + F.wave, NGW = F.G * NWAVES;
    constexpr int I_IN = 16 * 56, I_GLU = 8 * 32, I_CO = 8 * 16, I_O = 16 * 16, I_PG = 16 * 16, I_PLE = 4 * 16, I_EG = 16 * 8, I_ED = 8 * 16;
    constexpr int NITEMS = I_IN + I_GLU + I_CO + I_O + I_PG + I_PLE + NEXP * (2 * I_EG + I_ED);
    const int tw = split ? ((int)blockIdx.x - NGRP) * NWAVES + F.wave : gw, NTW = split ? (F.G - NGRP) * NWAVES : NGW;
    if (!tabler) for (int it = tw; it < NITEMS; it += NTW) {
        int r = it;
        if (r < I_IN) { tr_item(F.in[I_WIN], D, DIN, (bf16*)(F.ws + WS_WIN), 1, 0, nullptr, scr, r, F.lane); continue; } r -= I_IN;
        if (r < I_GLU) { tr_item(F.in[I_WGLU], DSSM, 2 * D, (bf16*)(F.ws + WS_WGLU), 2, D, nullptr, scr, r, F.lane); continue; } r -= I_GLU;
        if (r < I_CO) { tr_item(F.in[I_WCO], DCONV, D, (bf16*)(F.ws + WS_WCO), 0, 0, nullptr, scr, r, F.lane); continue; } r -= I_CO;
        if (r < I_O) { tr_item(F.in[I_WOUT], D, D, (bf16*)(F.ws + WS_WO), 0, 0, nullptr, scr, r, F.lane); continue; } r -= I_O;
        if (r < I_PG) { tr_item(F.in[I_WPG], D, D, (bf16*)(F.ws + WS_WPG), 0, 0, F.in[I_GPLE], scr, r, F.lane); continue; } r -= I_PG;
        if (r < I_PLE) { tr_item(F.in[I_WPLE], DPLE, D, (bf16*)(F.ws + WS_WPLE), 0, 0, nullptr, scr, r, F.lane); continue; } r -= I_PLE;
        const int e = r / (2 * I_EG + I_ED); r -= e * (2 * I_EG + I_ED);
        if (r < I_EG) { tr_item(F.in[I_WEG] + (size_t)e * D * DEXP, D, DEXP, (bf16*)(F.ws + WS_WGU) + (size_t)e * D * D, 3, 0, F.in[I_GMOE], scr, r, F.lane); continue; } r -= I_EG;
        if (r < I_EG) { tr_item(F.in[I_WEU] + (size_t)e * D * DEXP, D, DEXP, (bf16*)(F.ws + WS_WGU) + (size_t)e * D * D, 4, 0, F.in[I_GMOE], scr, r, F.lane); continue; } r -= I_EG;
        tr_item(F.in[I_WED] + (size_t)e * DEXP * D, DEXP, D, (bf16*)(F.ws + WS_WD) + (size_t)e * D * DEXP, 0, 0, nullptr, scr, r, F.lane);
    }
    { const float* x = F.in[I_X]; const float* gm = F.in[I_GMIX]; bf16* XN = (bf16*)(F.ws + WS_B);
      f32x4 gv[4];
#pragma unroll
      for (int j = 0; j < 4; ++j) gv[j] = *(const f32x4*)(gm + 4 * F.lane + 256 * j);
      for (int m = gw; m < NTOK; m += NGW) {
        const GAS f32x4* xr = (const GAS f32x4*)(x + (size_t)m * D) + F.lane; f32x4 v[4]; float s = 0.f;
#pragma unroll
        for (int j = 0; j < 4; ++j) { v[j] = xr[64 * j]; s += (v[j].x * v[j].x + v[j].y * v[j].y) + (v[j].z * v[j].z + v[j].w * v[j].w); }
        const float r = 1.0f / sqrtf(wave_sum(s) * (1.f / D) + EPS);
        GAS v2u* o8 = (GAS v2u*)(XN + (size_t)m * D) + F.lane;
#pragma unroll
        for (int j = 0; j < 4; ++j) { v2u o; o.x = pk2(v[j].x * r * gv[j].x, v[j].y * r * gv[j].y); o.y = pk2(v[j].z * r * gv[j].z, v[j].w * r * gv[j].w); o8[64 * j] = o; }
      } }
    { const float* p = F.in[I_P]; bf16* PB = (bf16*)(F.ws + WS_PB); const int gt = F.vcu * 512 + F.tid, NGT = F.G * 512;
      for (int q = gt; q < NTOK * DPLE / 8; q += NGT) { const f32x4 a = *(const f32x4*)(p + (size_t)q * 8), b = *(const f32x4*)(p + (size_t)q * 8 + 4);
        v4u o; o.x = pk2(a.x, a.y); o.y = pk2(a.z, a.w); o.z = pk2(b.x, b.y); o.w = pk2(b.z, b.w); *(GAS v4u*)(PB + (size_t)q * 8) = o; }
      bf16* WRT = (bf16*)(F.ws + WS_WRT); const float* gmoe = F.in[I_GMOE];
      for (int q = gt; q < 48 * 1024; q += NGT) { const int o = q >> 10, k = q & 1023; float v = 0.f;
        if (o < 4) v = F.in[I_WRG][k * 4 + o] * gmoe[k]; else if (o < 36) v = F.in[I_WRE][k * 32 + (o - 4)] * gmoe[k];
        const unsigned h = f2bf(v); const float lo = v - __builtin_bit_cast(float, h << 16); WRT[q] = (bf16)h; WRT[48 * 1024 + q] = (bf16)f2bf(lo); } }
}

using pg8::Unit;
typedef const f32x4 (&AccRef)[2][2][4][2];
struct EpiP1 {
    bf16* U; bf16* Z; bf16* SG; const float* bg;
    __device__ __forceinline__ void operator()(AccRef acc, const Unit& u, int wr, int wc, int fr, int fq) const {
        const int r0 = u.pm * 256 + wr * 64 + fr;
        if (u.pn < 2) {
#pragma unroll
            for (int ai = 0; ai < 2; ++ai)
#pragma unroll
                for (int m = 0; m < 4; ++m) { const int r = r0 + ai * 128 + m * 16, b = r >> 11, t = r & 2047;
#pragma unroll
                    for (int bj = 0; bj < 2; ++bj) { const int c0 = u.pn * 256 + bj * 128 + wc * 32 + fq * 8, g = c0 >> 4, ch0 = c0 & 15;
                        const f32x4 v0 = acc[ai][bj][m][0], v1 = acc[ai][bj][m][1];
                        v4u w; w.x = pk2(v0[0], v0[1]); w.y = pk2(v0[2], v0[3]); w.z = pk2(v1[0], v1[1]); w.w = pk2(v1[2], v1[3]);
                        *(GAS v4u*)(U + (((size_t)(b * 32 + g) * 2048 + t) * 16 + ch0)) = w; } }
        } else if (u.pn < 6) {
#pragma unroll
            for (int ai = 0; ai < 2; ++ai)
#pragma unroll
                for (int m = 0; m < 4; ++m) { const int r = r0 + ai * 128 + m * 16;
#pragma unroll
                    for (int bj = 0; bj < 2; ++bj) { const int o0 = (u.pn - 2) * 128 + bj * 64 + wc * 16 + fq * 4;
                        const f32x4 va = acc[ai][bj][m][0], ga = acc[ai][bj][m][1];
                        v2u w; w.x = pk2(va[0] * sigm(ga[0]), va[1] * sigm(ga[1])); w.y = pk2(va[2] * sigm(ga[2]), va[3] * sigm(ga[3]));
                        *(GAS v2u*)(Z + (size_t)r * 512 + o0) = w; } }
        } else {
#pragma unroll
            for (int bj = 0; bj < 2; ++bj) { const int s0 = (u.pn - 6) * 256 + bj * 128 + wc * 32 + fq * 8;
#ifdef DBG_NO_BIAS
                const f32x4 b0 = (f32x4){0.f, 0.f, 0.f, 0.f}, b1 = b0;
#else
                const f32x4 b0 = *(const f32x4*)(bg + s0), b1 = *(const f32x4*)(bg + s0 + 4);
#endif
#pragma unroll
                for (int ai = 0; ai < 2; ++ai)
#pragma unroll
                    for (int m = 0; m < 4; ++m) { const int r = r0 + ai * 128 + m * 16;
#ifdef DBG_BIAS_ONLY
                        const f32x4 v0 = b0, v1 = b1;
#else
                        const f32x4 v0 = acc[ai][bj][m][0] + b0, v1 = acc[ai][bj][m][1] + b1;
#endif
                        v4u w; w.x = pk2(sigm(v0[0]), sigm(v0[1])); w.y = pk2(sigm(v0[2]), sigm(v0[3])); w.z = pk2(sigm(v1[0]), sigm(v1[1])); w.w = pk2(sigm(v1[2]), sigm(v1[3]));
#ifdef DBG_SG_CONST
                        w.x = w.y = w.z = w.w = 0x3f003f00u;
#endif
                        *(GAS v4u*)(SG + (size_t)r * 2048 + s0) = w; } }
        }
    }
};
struct EpiGlu {
    bf16* MS; const bf16* SG;
    static __device__ __forceinline__ void run(AccRef acc, const Unit& u, int wr, int wc, int fr, int fq, bf16* __restrict__ MS, const bf16* __restrict__ SG) {
        const int r0 = u.pm * 256 + wr * 64 + fr;
#pragma unroll
        for (int ai = 0; ai < 2; ++ai)
#pragma unroll
            for (int m = 0; m < 4; ++m) { const int r = r0 + ai * 128 + m * 16;
#pragma unroll
                for (int bj = 0; bj < 2; ++bj) { const int o0 = u.pn * 128 + bj * 64 + wc * 16 + fq * 4;
                    const v2u sg = *(const GAS v2u*)(SG + (size_t)r * 2048 + o0);
                    const f32x4 va = acc[ai][bj][m][0], ga = acc[ai][bj][m][1];
                    v2u o; o.x = pk2(va[0] * sigm(ga[0]) * bflo(sg.x), va[1] * sigm(ga[1]) * bfhi(sg.x)); o.y = pk2(va[2] * sigm(ga[2]) * bflo(sg.y), va[3] * sigm(ga[3]) * bfhi(sg.y));
                    *(GAS v2u*)(MS + (size_t)r * 1024 + o0) = o; } }
    }
    __device__ __forceinline__ void operator()(AccRef acc, const Unit& u, int wr, int wc, int fr, int fq) const { run(acc, u, wr, wc, fr, fq, MS, SG); }
};
struct EpiCo {
    const bf16* MS; const bf16* SG; bf16* MG;
    static __device__ __forceinline__ void run(AccRef acc, const Unit& u, int wr, int wc, int fr, int fq, const bf16* __restrict__ MS, const bf16* __restrict__ SG, bf16* __restrict__ MG) {
        const int r0 = u.pm * 256 + wr * 64 + fr;
#pragma unroll
        for (int ai = 0; ai < 2; ++ai)
#pragma unroll
            for (int m = 0; m < 4; ++m) { const int r = r0 + ai * 128 + m * 16;
#pragma unroll
                for (int bj = 0; bj < 2; ++bj) { const int c0 = u.pn * 256 + bj * 128 + wc * 32 + fq * 8;
                    const v4u ms = *(const GAS v4u*)(MS + (size_t)r * 1024 + c0);
                    const v4u sg = *(const GAS v4u*)(SG + (size_t)r * 2048 + 1024 + c0);
                    const f32x4 v0 = acc[ai][bj][m][0], v1 = acc[ai][bj][m][1];
                    v4u w; w.x = pk2(bflo(ms.x) + bflo(sg.x) * v0[0], bfhi(ms.x) + bfhi(sg.x) * v0[1]); w.y = pk2(bflo(ms.y) + bflo(sg.y) * v0[2], bfhi(ms.y) + bfhi(sg.y) * v0[3]);
                    w.z = pk2(bflo(ms.z) + bflo(sg.z) * v1[0], bfhi(ms.z) + bfhi(sg.z) * v1[1]); w.w = pk2(bflo(ms.w) + bflo(sg.w) * v1[2], bfhi(ms.w) + bfhi(sg.w) * v1[3]);
                    *(GAS v4u*)(MG + (size_t)r * 1024 + c0) = w; } }
    }
    __device__ __forceinline__ void operator()(AccRef acc, const Unit& u, int wr, int wc, int fr, int fq) const { run(acc, u, wr, wc, fr, fq, MS, SG, MG); }
};
struct EpiRes {
    const float* X; bf16* X1B;
    static __device__ __forceinline__ void run(AccRef acc, const Unit& u, int wr, int wc, int fr, int fq, const float* __restrict__ X, bf16* __restrict__ X1B) {
        const int r0 = u.pm * 256 + wr * 64 + fr;
#pragma unroll
        for (int ai = 0; ai < 2; ++ai)
#pragma unroll
            for (int m = 0; m < 4; ++m) { const int r = r0 + ai * 128 + m * 16;
#pragma unroll
                for (int bj = 0; bj < 2; ++bj) { const size_t o = (size_t)r * 1024 + u.pn * 256 + bj * 128 + wc * 32 + fq * 8;
                    const f32x4 x0 = *(const GAS f32x4*)(X + o) + acc[ai][bj][m][0], x1 = *(const GAS f32x4*)(X + o + 4) + acc[ai][bj][m][1];
                    v4u w; w.x = pk2(x0[0], x0[1]); w.y = pk2(x0[2], x0[3]); w.z = pk2(x1[0], x1[1]); w.w = pk2(x1[2], x1[3]);
                    *(GAS v4u*)(X1B + o) = w; } }
    }
    __device__ __forceinline__ void operator()(AccRef acc, const Unit& u, int wr, int wc, int fr, int fq) const { run(acc, u, wr, wc, fr, fq, X, X1B); }
};
struct EpiAct {
    bf16* ACT; const int* ltok; const float* R2;
    static __device__ __forceinline__ void run(AccRef acc, const Unit& u, int wr, int wc, int fr, int fq, bf16* __restrict__ ACT, const int* __restrict__ ltok, const float* __restrict__ R2) {
        float rr[2][4];
#pragma unroll
        for (int ai = 0; ai < 2; ++ai)
#pragma unroll
            for (int m = 0; m < 4; ++m) { const int rl = ai * 128 + wr * 64 + m * 16 + fr; const int tok = (rl < u.rows) ? ltok[u.e * NTOK + u.mt * 256 + rl] : 0; rr[ai][m] = R2[tok]; }
#pragma unroll
        for (int ai = 0; ai < 2; ++ai)
#pragma unroll
            for (int m = 0; m < 4; ++m) { const int rl = ai * 128 + wr * 64 + m * 16 + fr;
                if (rl < u.rows) {
#pragma unroll
                    for (int bj = 0; bj < 2; ++bj) { const int o0 = u.pn * 128 + bj * 64 + wc * 16 + fq * 4;
                        const f32x4 ga = acc[ai][bj][m][0] * rr[ai][m], ua = acc[ai][bj][m][1] * rr[ai][m];
                        v2u w; w.x = pk2(ga[0] * sigm(ga[0]) * ua[0], ga[1] * sigm(ga[1]) * ua[1]); w.y = pk2(ga[2] * sigm(ga[2]) * ua[2], ga[3] * sigm(ga[3]) * ua[3]);
                        *(GAS v2u*)(ACT + (size_t)(u.pm * 256 + rl) * 512 + o0) = w; } } }
    }
    __device__ __forceinline__ void operator()(AccRef acc, const Unit& u, int wr, int wc, int fr, int fq) const { run(acc, u, wr, wc, fr, fq, ACT, ltok, R2); }
};
struct EpiY {
    bf16* Y;
    __device__ __forceinline__ void operator()(AccRef acc, const Unit& u, int wr, int wc, int fr, int fq) const {
#pragma unroll
        for (int ai = 0; ai < 2; ++ai)
#pragma unroll
            for (int m = 0; m < 4; ++m) { const int rl = ai * 128 + wr * 64 + m * 16 + fr;
                if (rl < u.rows) {
#pragma unroll
                    for (int bj = 0; bj < 2; ++bj) { const f32x4 v0 = acc[ai][bj][m][0], v1 = acc[ai][bj][m][1];
                        v4u w; w.x = pk2(v0[0], v0[1]); w.y = pk2(v0[2], v0[3]); w.z = pk2(v1[0], v1[1]); w.w = pk2(v1[2], v1[3]);
                        *(GAS v4u*)(Y + (size_t)(u.cb + rl) * 1024 + u.pn * 256 + bj * 128 + wc * 32 + fq * 8) = w; } } }
    }
};
struct EpiE {
    bf16* EO;
    __device__ __forceinline__ void operator()(AccRef acc, const Unit& u, int wr, int wc, int fr, int fq) const {
        const int r0 = u.pm * 256 + wr * 64 + fr;
#pragma unroll
        for (int ai = 0; ai < 2; ++ai)
#pragma unroll
            for (int m = 0; m < 4; ++m) { const int r = r0 + ai * 128 + m * 16;
#pragma unroll
                for (int bj = 0; bj < 2; ++bj) { const size_t o = (size_t)r * 1024 + u.pn * 256 + bj * 128 + wc * 32 + fq * 8; const f32x4 v0 = acc[ai][bj][m][0], v1 = acc[ai][bj][m][1];
                    v4u w; w.x = pk2(v0[0], v0[1]); w.y = pk2(v0[2], v0[3]); w.z = pk2(v1[0], v1[1]); w.w = pk2(v1[2], v1[3]);
                    *(GAS v4u*)(EO + o) = w; } }
    }
};
struct EpiPle {
    const bf16* X2; const bf16* EO; const float* R3; bf16* X3;
    static __device__ __forceinline__ void run(AccRef acc, const Unit& u, int wr, int wc, int fr, int fq, const bf16* __restrict__ X2, const bf16* __restrict__ EO, const float* __restrict__ R3, bf16* __restrict__ X3) {
        const int r0 = u.pm * 256 + wr * 64 + fr;
#pragma unroll
        for (int ai = 0; ai < 2; ++ai)
#pragma unroll
            for (int m = 0; m < 4; ++m) { const int r = r0 + ai * 128 + m * 16; const float r3 = R3[r];
#pragma unroll
                for (int bj = 0; bj < 2; ++bj) { const size_t o = (size_t)r * 1024 + u.pn * 256 + bj * 128 + wc * 32 + fq * 8;
                    const v4u x = *(const GAS v4u*)(X2 + o), e = *(const GAS v4u*)(EO + o);
                    const f32x4 a0 = acc[ai][bj][m][0] * r3, a1 = acc[ai][bj][m][1] * r3;
                    v4u w; w.x = pk2(bflo(x.x) + sigm(a0[0]) * bflo(e.x), bfhi(x.x) + sigm(a0[1]) * bfhi(e.x)); w.y = pk2(bflo(x.y) + sigm(a0[2]) * bflo(e.y), bfhi(x.y) + sigm(a0[3]) * bfhi(e.y));
                    w.z = pk2(bflo(x.z) + sigm(a1[0]) * bflo(e.z), bfhi(x.z) + sigm(a1[1]) * bfhi(e.z)); w.w = pk2(bflo(x.w) + sigm(a1[2]) * bflo(e.w), bfhi(x.w) + sigm(a1[3]) * bfhi(e.w));
                    *(GAS v4u*)(X3 + o) = w; } }
    }
    __device__ __forceinline__ void operator()(AccRef acc, const Unit& u, int wr, int wc, int fr, int fq) const { run(acc, u, wr, wc, fr, fq, X2, EO, R3, X3); }
};
struct DenseOrder : pg8::StaticOrder {
    const char* A; const char* Bt; size_t tstep;
    __device__ __forceinline__ const char* a_base(const Unit& u) const { return A + (size_t)u.pm * tstep; }
    __device__ __forceinline__ const char* b_base(const Unit& u) const { return Bt + (size_t)u.pn * tstep; }
    __device__ __forceinline__ unsigned row_off(const Unit&, int) const { return 0u; }
};
struct MoeOrder {
    const LAS int* tb; const LAS int* cn; int G, c, K, npn;
    const char* A; const char* Bt; size_t b_estride; const int* ltok; bool gather;
    __device__ __forceinline__ bool next(int i, Unit& u) const {
        const int L = i * G + c, total = tb[NEXP] * npn; if (L >= total) return false;
        const int tile = L / npn; int e = 0;
        for (int k = 1; k < NEXP; ++k) e += (tb[k] <= tile) ? 1 : 0;
        u.e = e; u.pm = tile; u.pn = L % npn; u.mt = tile - tb[e]; const int left = cn[e] - u.mt * 256; u.rows = left < 256 ? left : 256; u.cb = cn[33 + e] + u.mt * 256; return true;
    }
    __device__ __forceinline__ const char* a_base(const Unit& u) const { return gather ? A : A + (size_t)u.pm * 256 * K * 2; }
    __device__ __forceinline__ const char* b_base(const Unit& u) const { return Bt + (size_t)u.e * b_estride + (size_t)u.pn * 256 * K * 2; }
    __device__ __forceinline__ unsigned row_off(const Unit& u, int r) const { const int tok = (r < u.rows) ? ltok[u.e * NTOK + u.mt * 256 + r] : 0; return (unsigned)tok * (unsigned)(K * 2); }
};

constexpr int SSM_AP = 1296;
__device__ __forceinline__ void ssm_unit(Frame& F, int b, int g) {
    LAS unsigned char* Al = F.lds;
    LAS float* SL = (LAS float*)(F.lds + 64 * SSM_AP);
    const int fr = F.lane & 15, fq = F.lane >> 4, w = F.wave;
    const bf16* Ug = (const bf16*)(F.ws + WS_C) + (size_t)(b * 32 + g) * 2048 * 16;
#pragma unroll 4
    for (int q = F.tid; q < 4096; q += 512) { const int row = q >> 6, cc = q & 63; const v4u v = *(const GAS v4u*)(Ug + row * 512 + cc * 8); *(LAS v4u*)(Al + row * SSM_AP + cc * 16) = v; }
    __syncthreads();
    {
        const bf16* WS = (const bf16*)(F.ws + WS_WST) + ((size_t)g * 128 + 16 * w + fr) * 512 + 8 * fq;
        f32x4 acc[4];
#pragma unroll
        for (int m = 0; m < 4; ++m) acc[m] = (f32x4){0.f, 0.f, 0.f, 0.f};
#pragma unroll 4
        for (int s = 0; s < 16; ++s) { const bf16x8 bw = *(const GAS bf16x8*)(WS + 32 * s);
#pragma unroll
            for (int m = 0; m < 4; ++m) { const bf16x8 a = *(const LAS bf16x8*)(Al + (16 * m + fr) * SSM_AP + (32 * s + 8 * fq) * 2); acc[m] = __builtin_amdgcn_mfma_f32_16x16x32_bf16(bw, a, acc[m], 0, 0, 0); } }
#pragma unroll
        for (int m = 0; m < 4; ++m) *(LAS f32x4*)(SL + (16 * m + fr) * 132 + 16 * w + 4 * fq) = acc[m];
    }
    __syncthreads();
    if (w == 0) {
        const int n = F.lane; const float* l32 = (const float*)(F.ws + WS_LAM32) + (g * 64 + n) * 2; const float lr = l32[0], li = l32[1]; float sr = 0.f, si = 0.f;
        for (int c = 0; c < NCH; ++c) { *(LAS unsigned*)(Al + c * SSM_AP + 1024 + 4 * n) = pk2(sr, si);
            const float ur = SL[c * 132 + 2 * n], ui = SL[c * 132 + 2 * n + 1]; const float nr = lr * sr - li * si + ur, ni = lr * si + li * sr + ui; sr = nr; si = ni; }
    }
    __syncthreads();
    {
        const bf16* BT = (const bf16*)(F.ws + WS_BT2) + ((size_t)g * 512 + 64 * w + fr) * 640 + 8 * fq;
        f32x4 acc[4][4];
#pragma unroll
        for (int m = 0; m < 4; ++m)
#pragma unroll
            for (int n = 0; n < 4; ++n) acc[m][n] = (f32x4){0.f, 0.f, 0.f, 0.f};
#pragma unroll 2
        for (int s = 0; s < 20; ++s) { bf16x8 bf[4], af[4];
#pragma unroll
            for (int n = 0; n < 4; ++n) bf[n] = *(const GAS bf16x8*)(BT + (size_t)n * 16 * 640 + 32 * s);
#pragma unroll
            for (int m = 0; m < 4; ++m) af[m] = *(const LAS bf16x8*)(Al + (16 * m + fr) * SSM_AP + (32 * s + 8 * fq) * 2);
#pragma unroll
            for (int m = 0; m < 4; ++m)
#pragma unroll
                for (int n = 0; n < 4; ++n) acc[m][n] = __builtin_amdgcn_mfma_f32_16x16x32_bf16(bf[n], af[m], acc[m][n], 0, 0, 0); }
        bf16* GY = (bf16*)(F.ws + WS_B);
#pragma unroll
        for (int m = 0; m < 4; ++m)
#pragma unroll
            for (int n = 0; n < 4; ++n) { const int tok = b * SEQ + LC * (16 * m + fr) + 4 * w + n; const f32x4 y = acc[m][n];
                v2u o; o.x = pk2(gelu_tanh(y[0]), gelu_tanh(y[1])); o.y = pk2(gelu_tanh(y[2]), gelu_tanh(y[3]));
                *(GAS v2u*)(GY + (size_t)tok * 512 + 16 * g + 4 * fq) = o; }
    }
    __syncthreads();
}
__device__ __forceinline__ void conv_tile(Frame& F, int tile) {
    const int tok0 = tile * 64, b = tok0 >> 11, t0 = tok0 & 2047;
    LAS unsigned* zl = (LAS unsigned*)F.lds;
    LAS float* red = (LAS float*)(F.lds + 98304);
    const bf16* Z = (const bf16*)(F.ws + WS_C + 16 * MiB);
#pragma unroll 2
    for (int q = F.tid; q < 94 * 64; q += 512) { const int rr = q >> 6, cc = q & 63, t = t0 - 30 + rr; v4u v = (v4u){0u, 0u, 0u, 0u};
        if (t >= 0) v = *(const GAS v4u*)(Z + (size_t)(b * SEQ + t) * 512 + cc * 8); *(LAS v4u*)(zl + rr * 256 + cc * 4) = v; }
    __syncthreads();
    const int wq = F.wave & 3, th = F.wave >> 2, cp = wq * 64 + F.lane;
    float dw0[31], dw1[31];
    {   const float* pw = F.in[I_CDW] + 2 * cp;
        typedef float f32x2 __attribute__((ext_vector_type(2)));
#pragma unroll
        for (int k = 0; k < 31; ++k) { const f32x2 v = *(const GAS f32x2*)pw; dw0[k] = v.x; dw1[k] = v.y; pw += 512; asm volatile("" : "+v"(pw)); } }
    const float cb0 = F.in[I_CDWB][2 * cp], cb1 = F.in[I_CDWB][2 * cp + 1], lg0 = F.in[I_CLNG][2 * cp], lg1 = F.in[I_CLNG][2 * cp + 1], lb0 = F.in[I_CLNB][2 * cp], lb1 = F.in[I_CLNB][2 * cp + 1];
    bf16* CA = (bf16*)(F.ws + WS_B + 16 * MiB);
#pragma unroll 1
    for (int ch = 0; ch < 4; ++ch) {
        float a0[8], a1[8];
#pragma unroll
        for (int o = 0; o < 8; ++o) { a0[o] = cb0; a1[o] = cb1; }
        const int rbase = th * 32 + ch * 8;
#pragma unroll
        for (int r = 0; r < 38; ++r) { const unsigned v = zl[(rbase + r) * 256 + cp]; const float x0 = bflo(v), x1 = bfhi(v);
#pragma unroll
            for (int o = 0; o < 8; ++o) { const int k = r - o; if (k >= 0 && k <= 30) { a0[o] += dw0[k] * x0; a1[o] += dw1[k] * x1; } }
            __builtin_amdgcn_sched_barrier(0); }
        LAS float* rp = red + ((ch & 1) * 2 + th) * 64;
#pragma unroll
        for (int o = 0; o < 8; ++o) { const float s = wave_sum(a0[o] + a1[o]), q = wave_sum(a0[o] * a0[o] + a1[o] * a1[o]); if (F.lane == 0) { rp[(o * 4 + wq) * 2] = s; rp[(o * 4 + wq) * 2 + 1] = q; } }
        __syncthreads();
#pragma unroll
        for (int o = 0; o < 8; ++o) { float s = 0.f, q = 0.f;
#pragma unroll
            for (int k = 0; k < 4; ++k) { s += rp[(o * 4 + k) * 2]; q += rp[(o * 4 + k) * 2 + 1]; }
            const float mean = s * (1.f / 512.f), var = q * (1.f / 512.f) - mean * mean, rstd = 1.0f / sqrtf(var + EPS);
            const float y0 = (a0[o] - mean) * rstd * lg0 + lb0, y1 = (a1[o] - mean) * rstd * lg1 + lb1;
            *(GAS unsigned*)(CA + (size_t)(tok0 + rbase + o) * 512 + 2 * cp) = pk2(y0 * sigm(y0), y1 * sigm(y1)); }
    }
    __syncthreads();
}
__device__ __forceinline__ void router_phase(Frame& F) {
    const int fr = F.lane & 15, fq = F.lane >> 4, tl = F.wave & 3, kh = F.wave >> 2;
    const bf16* XB = (const bf16*)(F.ws + WS_B); float* R2 = (float*)(F.ws + WS_R2);
    const bf16* WRT = (const bf16*)(F.ws + WS_WRT); int* ltok = (int*)(F.ws + WS_LTOK); int* tinfo = (int*)(F.ws + WS_TINFO);
    LAS float* part = (LAS float*)(F.lds + 32768);
    LAS float* lg = (LAS float*)(F.lds + tl * 4096);
    for (int tg = F.vcu; tg < NTOK / 64; tg += F.G) {
        const int tile = tg * 4 + tl, tok = tile * 16 + fr;
        const bf16* xr = XB + (size_t)tok * D + 512 * kh + 8 * fq; const bf16* wh = WRT + (size_t)fr * D + 512 * kh + 8 * fq;
        f32x4 acc[3]; float ss = 0.f;
#pragma unroll
        for (int n = 0; n < 3; ++n) acc[n] = (f32x4){0.f, 0.f, 0.f, 0.f};
#pragma unroll 4
        for (int s = 0; s < 16; ++s) {
            const v4u h = *(const GAS v4u*)(xr + 32 * s);
            const float a0 = bflo(h.x), a1 = bfhi(h.x), a2 = bflo(h.y), a3 = bfhi(h.y), a4 = bflo(h.z), a5 = bfhi(h.z), a6 = bflo(h.w), a7 = bfhi(h.w);
            ss += (a0 * a0 + a1 * a1) + (a2 * a2 + a3 * a3) + (a4 * a4 + a5 * a5) + (a6 * a6 + a7 * a7);
            const bf16x8 xh = __builtin_bit_cast(bf16x8, h);
#pragma unroll
            for (int n = 0; n < 3; ++n) { const bf16x8 whi = *(const GAS bf16x8*)(wh + (size_t)n * 16 * D + 32 * s), wlo = *(const GAS bf16x8*)(wh + (size_t)(48 + n * 16) * D + 32 * s);
                acc[n] = __builtin_amdgcn_mfma_f32_16x16x32_bf16(whi, xh, acc[n], 0, 0, 0); acc[n] = __builtin_amdgcn_mfma_f32_16x16x32_bf16(wlo, xh, acc[n], 0, 0, 0); }
        }
        ss += __shfl_xor(ss, 16); ss += __shfl_xor(ss, 32);
        if (kh == 1) { LAS float* pp = part + (tl * 64 + F.lane) * 13;
#pragma unroll
            for (int n = 0; n < 3; ++n)
#pragma unroll
                for (int j = 0; j < 4; ++j) pp[4 * n + j] = acc[n][j];
            pp[12] = ss; }
        __syncthreads();
        if (kh == 0) {
            const LAS float* pp = part + (tl * 64 + F.lane) * 13;
            ss += pp[12];
            const float r = 1.0f / sqrtf(ss * (1.f / D) + EPS);
            if (fq == 0) R2[tok] = r;
#pragma unroll
            for (int n = 0; n < 3; ++n)
#pragma unroll
                for (int j = 0; j < 4; ++j) { const int o = 16 * n + 4 * fq + j; if (o < 36) { const float bias = o < 4 ? F.in[I_BRG][o] : F.in[I_BRE2][o - 4]; lg[fr * 49 + o] = (acc[n][j] + pp[4 * n + j]) * r + bias; } }
            LDS_WAIT(); asm volatile("" ::: "memory");
            if (F.lane < 16) {
                const LAS float* l = lg + F.lane * 49; const int token = tile * 16 + F.lane;
                float gm = l[0]; int gs = 0;
#pragma unroll
                for (int i = 1; i < 4; ++i) if (l[i] > gm) { gm = l[i]; gs = i; }
                float den = 0.f;
#pragma unroll
                for (int i = 0; i < 4; ++i) den += __expf(l[i] - gm);
                const float pg = 1.0f / den;
                const LAS float* el = l + 4 + 8 * gs;
                float v1 = el[0]; int j1 = 0;
#pragma unroll
                for (int i = 1; i < 8; ++i) if (el[i] > v1) { v1 = el[i]; j1 = i; }
                float v2 = -3.0e38f; int j2 = 0;
#pragma unroll
                for (int i = 0; i < 8; ++i) if (i != j1 && el[i] > v2) { v2 = el[i]; j2 = i; }
                const float w1 = pg / (1.0f + __expf(v2 - v1)), w2 = pg - w1;
                const int e1 = gs * 8 + j1, e2 = gs * 8 + j2;
                const unsigned s1 = __hip_atomic_fetch_add((unsigned*)(F.ctl + CW_ECNT + 64 * e1), 1u, RLX_AGENT);
                const unsigned s2 = __hip_atomic_fetch_add((unsigned*)(F.ctl + CW_ECNT + 64 * e2), 1u, RLX_AGENT);
                ltok[e1 * NTOK + s1] = token; ltok[e2 * NTOK + s2] = token;
                typedef int i32x4 __attribute__((ext_vector_type(4))); *(GAS i32x4*)(tinfo + 4 * token) = (i32x4){e1 * NTOK + (int)s1, e2 * NTOK + (int)s2, __builtin_bit_cast(int, w1), __builtin_bit_cast(int, w2)};
            }
        }
        __syncthreads();
    }
}
__device__ __forceinline__ void rows_to_bf16(Frame& F, const float* X, bf16* XB, float* RR) {
    const int gw = F.vcu * NWAVES + F.wave, NGW = F.G * NWAVES;
    for (int m = gw; m < NTOK; m += NGW) {
        const GAS f32x4* xr = (const GAS f32x4*)(X + (size_t)m * D) + F.lane; f32x4 v[4]; float s = 0.f;
#pragma unroll
        for (int j = 0; j < 4; ++j) { v[j] = xr[64 * j]; s += (v[j].x * v[j].x + v[j].y * v[j].y) + (v[j].z * v[j].z + v[j].w * v[j].w); }
        const float r = 1.0f / sqrtf(wave_sum(s) * (1.f / D) + EPS);
        if (F.lane == 0) RR[m] = r;
        GAS v2u* o8 = (GAS v2u*)(XB + (size_t)m * D) + F.lane;
#pragma unroll
        for (int j = 0; j < 4; ++j) { v2u o; o.x = pk2(v[j].x, v[j].y); o.y = pk2(v[j].z, v[j].w); o8[64 * j] = o; }
    }
}
__device__ __forceinline__ void moe_combine_rows(Frame& F, bf16* XB, const bf16* Y, float* RR) {
    const int gw = F.vcu * NWAVES + F.wave, NGW = F.G * NWAVES; const LAS int* cs = (const LAS int*)(F.lds + TB_OFF) + 66; const int* tinfo = (const int*)(F.ws + WS_TINFO);
    for (int m = gw; m < NTOK; m += NGW) {
        typedef int i32x4 __attribute__((ext_vector_type(4))); const i32x4 ti = *(const GAS i32x4*)(tinfo + 4 * m);
        const int r1 = cs[ti.x >> 14] + (ti.x & (NTOK - 1)), r2 = cs[ti.y >> 14] + (ti.y & (NTOK - 1)); const int wz = ti.z, ww = ti.w; const float w1 = __builtin_bit_cast(float, wz), w2 = __builtin_bit_cast(float, ww);
        GAS v4u* xr = (GAS v4u*)(XB + (size_t)m * D) + F.lane; const GAS v4u* y1 = (const GAS v4u*)(Y + (size_t)r1 * D) + F.lane; const GAS v4u* y2 = (const GAS v4u*)(Y + (size_t)r2 * D) + F.lane;
        v4u o[2]; float s = 0.f;
#pragma unroll
        for (int j = 0; j < 2; ++j) { const v4u x = xr[64 * j], a = y1[64 * j], b = y2[64 * j]; float v[8];
            v[0] = bflo(x.x) + w1 * bflo(a.x) + w2 * bflo(b.x); v[1] = bfhi(x.x) + w1 * bfhi(a.x) + w2 * bfhi(b.x); v[2] = bflo(x.y) + w1 * bflo(a.y) + w2 * bflo(b.y); v[3] = bfhi(x.y) + w1 * bfhi(a.y) + w2 * bfhi(b.y);
            v[4] = bflo(x.z) + w1 * bflo(a.z) + w2 * bflo(b.z); v[5] = bfhi(x.z) + w1 * bfhi(a.z) + w2 * bfhi(b.z); v[6] = bflo(x.w) + w1 * bflo(a.w) + w2 * bflo(b.w); v[7] = bfhi(x.w) + w1 * bfhi(a.w) + w2 * bfhi(b.w);
            o[j].x = pk2(v[0], v[1]); o[j].y = pk2(v[2], v[3]); o[j].z = pk2(v[4], v[5]); o[j].w = pk2(v[6], v[7]);
            const float q0 = bflo(o[j].x), q1 = bfhi(o[j].x), q2 = bflo(o[j].y), q3 = bfhi(o[j].y), q4 = bflo(o[j].z), q5 = bfhi(o[j].z), q6 = bflo(o[j].w), q7 = bfhi(o[j].w);
            s += (q0 * q0 + q1 * q1) + (q2 * q2 + q3 * q3) + (q4 * q4 + q5 * q5) + (q6 * q6 + q7 * q7); }
        const float r = 1.0f / sqrtf(wave_sum(s) * (1.f / D) + EPS);
        if (F.lane == 0) RR[m] = r;
#pragma unroll
        for (int j = 0; j < 2; ++j) xr[64 * j] = o[j];
    }
}
__device__ __forceinline__ void final_norm(Frame& F, const bf16* X, float* out, const float* gf) {
    const int gw = F.vcu * NWAVES + F.wave, NGW = F.G * NWAVES;
    f32x4 gv[2][2];
#pragma unroll
    for (int j = 0; j < 2; ++j) { gv[j][0] = *(const f32x4*)(gf + 8 * F.lane + 512 * j); gv[j][1] = *(const f32x4*)(gf + 8 * F.lane + 512 * j + 4); }
    for (int m = gw; m < NTOK; m += NGW) {
        const GAS v4u* xr = (const GAS v4u*)(X + (size_t)m * D) + F.lane; f32x4 v[2][2]; float s = 0.f;
#pragma unroll
        for (int j = 0; j < 2; ++j) { const v4u x = xr[64 * j]; v[j][0] = (f32x4){bflo(x.x), bfhi(x.x), bflo(x.y), bfhi(x.y)}; v[j][1] = (f32x4){bflo(x.z), bfhi(x.z), bflo(x.w), bfhi(x.w)};
            s += (v[j][0].x * v[j][0].x + v[j][0].y * v[j][0].y) + (v[j][0].z * v[j][0].z + v[j][0].w * v[j][0].w) + (v[j][1].x * v[j][1].x + v[j][1].y * v[j][1].y) + (v[j][1].z * v[j][1].z + v[j][1].w * v[j][1].w); }
        const float r = 1.0f / sqrtf(wave_sum(s) * (1.f / D) + EPS);
        GAS f32x4* o = (GAS f32x4*)(out + (size_t)m * D) + 2 * F.lane;
#pragma unroll
        for (int j = 0; j < 2; ++j) { o[128 * j] = v[j][0] * r * gv[j][0]; o[128 * j + 1] = v[j][1] * r * gv[j][1]; }
    }
}
__device__ __forceinline__ void moe_tables(Frame& F) {
    LAS int* tb = (LAS int*)(F.lds + TB_OFF); LAS int* cn = tb + 33; LAS int* cs = cn + 33;
    if (F.tid == 0) { int t = 0, r = 0; for (int e = 0; e < NEXP; ++e) { const int c = (int)__hip_atomic_load((unsigned*)(F.ctl + CW_ECNT + 64 * e), RLX_AGENT); cn[e] = c; tb[e] = t; cs[e] = r; t += (c + 255) >> 8; r += c; } tb[NEXP] = t; cs[NEXP] = r; }
    __syncthreads();
}

struct Args { const float* in[N_IN]; float* out; unsigned char* ws; int ph_lo, ph_hi; };
__global__ void __launch_bounds__(NWAVES * 64, 2) mk_fwd(Args args) {
    extern __shared__ __attribute__((aligned(16))) unsigned char lds[];
    Frame F;
    F.lds = (LAS unsigned char*)lds;
    F.MISC = (volatile LAS unsigned*)(F.lds + MISC_OFF);
    F.tid = threadIdx.x; F.lane = F.tid & 63; F.wave = __builtin_amdgcn_readfirstlane(F.tid >> 6);
    const int wave_s = F.wave;
    F.G = gridDim.x; { const int bx = blockIdx.x; F.vcu = (F.G % 8 == 0) ? (bx % 8) * (F.G / 8) + bx / 8 : bx; }
    F.in = args.in; F.out = args.out; F.ws = args.ws; F.ctl = (gu32*)(args.ws + WS_CTL);
    for (int u = F.tid; u < (LDS_BYTES - LDSCTL_OFF) / 4; u += NWAVES * 64) ((LAS unsigned*)(F.lds + LDSCTL_OFF))[u] = 0u;
    __syncthreads();
    if (N_LAUNCHES != PER_PHASE) (void)xcd_barrier_post((unsigned*)(F.ctl + CW_BAR), F.MISC + 8);
#define GRID_BAR() do { if (N_LAUNCHES == PER_PHASE) { if (F.tid == 0) __hip_atomic_store(F.ctl + CW_TMO, 0xBADBA0u, RLX_AGENT); } else { \
        XcdBarrier bb_; bb_.bar = (unsigned*)(F.ctl + CW_BAR); bb_.x = xb_xcc_id(); bb_.st = (volatile LAS unsigned*)(F.lds + MISC_OFF) + 8; bb_.wv = wave_s; xcd_barrier(bb_); } } while (0)
#define PHASE_BEGIN() do { int l_ = (int)__builtin_amdgcn_mbcnt_hi(~0u, __builtin_amdgcn_mbcnt_lo(~0u, 0u)); asm volatile("" : "+v"(l_)); F.lane = l_; F.wave = wave_s; F.tid = wave_s * 64 + l_; \
        unsigned long long w_ = (unsigned long long)args.ws; asm volatile("" : "+s"(w_)); ws = (unsigned char*)(GAS unsigned char*)w_; F.ws = ws; F.ctl = (gu32*)(ws + WS_CTL); } while (0)
    const int lo = args.ph_lo, hi = args.ph_hi;
#ifndef PHASE_MASK
#define PHASE_MASK 0x1FFF
#endif
#define IN(k) (lo <= (k) && (k) < hi && ((PHASE_MASK >> (k)) & 1))
#define BOTH(k) (IN(k) && IN((k) + 1))
#ifndef REP_MASK
#define REP_MASK 0
#endif
#define REPS(k) (((REP_MASK >> (k)) & 1) ? 2 : 1)
    unsigned char* ws = args.ws;
    const size_t TS1024 = (size_t)256 * 1024 * 2, TS512 = (size_t)256 * 512 * 2, TS256 = (size_t)256 * 256 * 2;

    if (IN(0)) for (int rep_ = 0; rep_ < REPS(0); ++rep_) { PHASE_BEGIN(); p0_prologue(F); if (BOTH(0)) GRID_BAR(); }
    if (IN(1)) for (int rep_ = 0; rep_ < REPS(1); ++rep_) {
        PHASE_BEGIN();
        DenseOrder S; S.init(NTOK, DIN, F.G, (int)blockIdx.x); S.A = (const char*)(ws + WS_B); S.Bt = (const char*)(ws + WS_WIN); S.tstep = TS1024;
        EpiP1 E{(bf16*)(ws + WS_C), (bf16*)(ws + WS_C + 16 * MiB), (bf16*)F.out, F.in[I_BGATE]};
        pg8::gemm_phase<EpiP1, DenseOrder>(F.lds + RING_OFF, F.tid, D, S, E);
        if (BOTH(1)) GRID_BAR();
    }
    if (IN(2)) for (int rep_ = 0; rep_ < REPS(2); ++rep_) {
        PHASE_BEGIN();
#ifndef NO_SSM
        for (int u = F.vcu; u < 8 * NGRP; u += F.G) { const int x = u / 32, idx = u % 32; ssm_unit(F, idx & 7, 4 * x + (idx >> 3)); }
#endif
#ifndef NO_CONV
        PHASE_BEGIN();
        for (int t = blockIdx.x; t < NTOK / 64; t += F.G) conv_tile(F, t);
#endif
        if (BOTH(2)) GRID_BAR();
    }
    if (IN(3)) for (int rep_ = 0; rep_ < REPS(3); ++rep_) {
        PHASE_BEGIN();
        DenseOrder S; S.init(NTOK, 2 * D, F.G, (int)blockIdx.x); S.A = (const char*)(ws + WS_B); S.Bt = (const char*)(ws + WS_WGLU); S.tstep = TS512;
        EpiGlu E{(bf16*)(ws + WS_E), (const bf16*)F.out};
        pg8::gemm_phase<EpiGlu, DenseOrder>(F.lds + RING_OFF, F.tid, DSSM, S, E);
        if (BOTH(3)) GRID_BAR();
    }
    if (IN(4)) for (int rep_ = 0; rep_ < REPS(4); ++rep_) {
        PHASE_BEGIN();
        DenseOrder S; S.init(NTOK, D, F.G, (int)blockIdx.x); S.A = (const char*)(ws + WS_B + 16 * MiB); S.Bt = (const char*)(ws + WS_WCO); S.tstep = TS512;
        EpiCo E{(const bf16*)(ws + WS_E), (const bf16*)F.out, (bf16*)(ws + WS_C)};
        pg8::gemm_phase<EpiCo, DenseOrder>(F.lds + RING_OFF, F.tid, DCONV, S, E);
        if (BOTH(4)) GRID_BAR();
    }
    if (IN(5)) for (int rep_ = 0; rep_ < REPS(5); ++rep_) {
        PHASE_BEGIN();
        DenseOrder S; S.init(NTOK, D, F.G, (int)blockIdx.x); S.A = (const char*)(ws + WS_C); S.Bt = (const char*)(ws + WS_WO); S.tstep = TS1024;
        EpiRes E{F.in[I_X], (bf16*)(ws + WS_B)};
        pg8::gemm_phase<EpiRes, DenseOrder>(F.lds + RING_OFF, F.tid, D, S, E);
        if (BOTH(5)) GRID_BAR();
    }
    if (IN(6)) for (int rep_ = 0; rep_ < REPS(6); ++rep_) { PHASE_BEGIN(); router_phase(F); if (BOTH(6)) GRID_BAR(); }
    if (IN(7)) for (int rep_ = 0; rep_ < REPS(7); ++rep_) {
        PHASE_BEGIN();
        moe_tables(F);
        MoeOrder S; S.tb = (const LAS int*)(F.lds + TB_OFF); S.cn = S.tb + 33; S.G = F.G; S.c = F.vcu; S.K = D; S.npn = 4;
        S.A = (const char*)(ws + WS_B); S.Bt = (const char*)(ws + WS_WGU); S.b_estride = (size_t)D * D * 2; S.ltok = (const int*)(ws + WS_LTOK); S.gather = true;
        EpiAct E{(bf16*)(ws + WS_C), (const int*)(ws + WS_LTOK), (const float*)(ws + WS_R2)};
        pg8::gemm_phase<EpiAct, MoeOrder, true>(F.lds + RING_OFF, F.tid, D, S, E);
        if (BOTH(7)) GRID_BAR();
    }
    if (IN(8)) for (int rep_ = 0; rep_ < REPS(8); ++rep_) {
        PHASE_BEGIN();
        moe_tables(F);
        MoeOrder S; S.tb = (const LAS int*)(F.lds + TB_OFF); S.cn = S.tb + 33; S.G = F.G; S.c = F.vcu; S.K = DEXP; S.npn = 4;
        S.A = (const char*)(ws + WS_C); S.Bt = (const char*)(ws + WS_WD); S.b_estride = (size_t)D * DEXP * 2; S.ltok = (const int*)(ws + WS_LTOK); S.gather = false;
        EpiY E{(bf16*)F.out};
        pg8::gemm_phase<EpiY, MoeOrder, false>(F.lds + RING_OFF, F.tid, DEXP, S, E);
        if (BOTH(8)) GRID_BAR();
    }
    if (IN(9)) for (int rep_ = 0; rep_ < REPS(9); ++rep_) { PHASE_BEGIN(); moe_tables(F); moe_combine_rows(F, (bf16*)(ws + WS_B), (const bf16*)F.out, (float*)(ws + WS_R3)); if (BOTH(9)) GRID_BAR(); }
#ifdef DBG_SG_COPY
    if (lo <= 10 && 10 < hi) { const int gt = F.vcu * 512 + (int)threadIdx.x, NGT = F.G * 512; const bf16* sgp = (const bf16*)args.out + (size_t)DBG_SG_COPY * NTOK * D; float* dst = (float*)(args.ws + WS_E);
        for (int q = gt; q < NTOK * D; q += NGT) { const float v = bflo((unsigned)sgp[q]); const int col = q & 2047;
#ifdef DBG_SG_SEL_LO
            dst[q] = (v >= 0.f && v <= 1.f) ? 0.f : ((col >= DBG_SG_SEL_LO && col < DBG_SG_SEL_HI) ? 1000.f : 0.f);
#else
            dst[q] = v;
#endif
        } }
#endif
    if (IN(10)) for (int rep_ = 0; rep_ < REPS(10); ++rep_) {
        PHASE_BEGIN();
        DenseOrder S; S.init(NTOK, D, F.G, (int)blockIdx.x); S.A = (const char*)(ws + WS_PB); S.Bt = (const char*)(ws + WS_WPLE); S.tstep = TS256;
        EpiE E{(bf16*)F.out};
        pg8::gemm_phase<EpiE, DenseOrder>(F.lds + RING_OFF, F.tid, DPLE, S, E);
        if (BOTH(10)) GRID_BAR();
    }
    if (IN(11)) for (int rep_ = 0; rep_ < REPS(11); ++rep_) {
        PHASE_BEGIN();
        DenseOrder S; S.init(NTOK, D, F.G, (int)blockIdx.x); S.A = (const char*)(ws + WS_B); S.Bt = (const char*)(ws + WS_WPG); S.tstep = TS1024;
        EpiPle E{(const bf16*)(ws + WS_B), (const bf16*)F.out, (const float*)(ws + WS_R3), (bf16*)(ws + WS_C)};
        pg8::gemm_phase<EpiPle, DenseOrder>(F.lds + RING_OFF, F.tid, D, S, E);
        if (BOTH(11)) GRID_BAR();
    }
#ifdef DBG_DUMP_OFF
    if (hi == PER_PHASE) {   PHASE_BEGIN();
        const int gt = F.vcu * 512 + F.tid, NGT = F.G * 512;
#if DBG_DUMP_BF16
        const bf16* src = (const bf16*)(ws + (size_t)DBG_DUMP_OFF);
        for (int q = gt; q < NTOK * D; q += NGT) F.out[q] = bflo((unsigned)src[q]);
#else
        const float* src = (const float*)(ws + (size_t)DBG_DUMP_OFF);
        for (int q = gt; q < NTOK * D; q += NGT) F.out[q] = src[q];
#endif
    }
#else
    if (IN(12)) for (int rep_ = 0; rep_ < REPS(12); ++rep_) { PHASE_BEGIN(); final_norm(F, (const bf16*)(ws + WS_C), F.out, F.in[I_GFIN]); }
#endif
#undef IN
#undef BOTH
}

extern "C" void kernel_launch(void* const* d_in, const int* in_sizes, int n_in, void* d_out, int out_size, void* d_ws, size_t ws_size, hipStream_t stream) {
    static int grid = 0;
    if (grid == 0) {
        if (n_in != N_IN || in_sizes[0] != NTOK * D || out_size != NTOK * D || ws_size < WS_END) { fprintf(stderr, "kernel_launch: unexpected shapes (n_in %d, in0 %d, out %d, ws %zu; need ws >= %zu); nothing launched\n", n_in, n_in > 0 ? in_sizes[0] : -1, out_size, ws_size, (size_t)WS_END); grid = -1; return; }
        int dev = 0, cus = 0, per_cu = 0;
        if (hipGetDevice(&dev) != hipSuccess || hipDeviceGetAttribute(&cus, hipDeviceAttributeMultiprocessorCount, dev) != hipSuccess) { grid = -1; return; }
        if (hipFuncSetAttribute((const void*)mk_fwd, hipFuncAttributeMaxDynamicSharedMemorySize, LDS_BYTES) != hipSuccess) { fprintf(stderr, "kernel_launch: hipFuncSetAttribute failed\n"); grid = -1; return; }
        if (hipOccupancyMaxActiveBlocksPerMultiprocessor(&per_cu, (const void*)mk_fwd, NWAVES * 64, LDS_BYTES) != hipSuccess || per_cu < 1) { fprintf(stderr, "kernel_launch: occupancy query reports %d workgroups per CU\n", per_cu); (void)hipGetLastError(); grid = -1; return; }
        grid = cus;
    }
    if (grid < 0) return;
    if (hipMemsetAsync((char*)d_ws + WS_CTL, 0, CTL_ZERO_BYTES, stream) != hipSuccess) return;
    Args a{};
    for (int i = 0; i < N_IN; ++i) a.in[i] = (const float*)d_in[i];
    a.out = (float*)d_out; a.ws = (unsigned char*)d_ws;
    for (int li = 0; li < N_LAUNCHES; ++li) {
        a.ph_lo = (N_LAUNCHES == PER_PHASE) ? li : 0; a.ph_hi = (N_LAUNCHES == PER_PHASE) ? li + 1 : PER_PHASE;
        hipLaunchKernelGGL(mk_fwd, dim3(grid), dim3(NWAVES * 64), LDS_BYTES, stream, a);
        if (hipPeekAtLastError() != hipSuccess) { fprintf(stderr, "kernel_launch: launch %d failed\n", li); break; }
    }
}
```

```cpp
#include <hip/hip_runtime.h>
#include <cstdio>
#include <cstdint>

namespace pg8 {
#define PG8_LAS __attribute__((address_space(3)))
typedef unsigned short bf16_t;
typedef short bf16x8 __attribute__((ext_vector_type(8)));
typedef float f32x4 __attribute__((ext_vector_type(4)));
typedef unsigned u32x4 __attribute__((ext_vector_type(4)));
typedef unsigned u32x2 __attribute__((ext_vector_type(2)));
constexpr int BM = 256, BK = 64, HALF = 128, HTB = HALF * BK * 2  , STAGE_BYTES = 8 * HTB, NXCD = 8, WGM = 8;

__host__ __device__ __forceinline__ int lds_byte(int r, int c) { const int st = (r >> 4) * 2 + (c >> 5), rr = r & 15, cc = c & 31, ob = rr * 64 + cc * 2; return st * 1024 + (ob ^ (((ob >> 9) & 1) << 5)); }
__host__ __device__ __forceinline__ void stage_rc(int b, int& R, int& C) { const int st = b / 1024, sb = b % 1024, swz = sb ^ (((sb >> 9) & 1) << 5); R = (st >> 1) * 16 + swz / 64; C = (st & 1) * 32 + (swz % 64) / 2; }
__host__ __device__ __forceinline__ int perm32(int rho) { const int n = rho >> 4, i = rho & 15; return 8 * (i >> 2) + 4 * n + (i & 3); }

struct Unit { int pm, pn, e, rows, mt, cb; };

typedef float cvt_f32x2 __attribute__((ext_vector_type(2)));
typedef __bf16 cvt_bf16x2 __attribute__((ext_vector_type(2)));
__device__ __forceinline__ unsigned cvt_pk_bf16(float lo, float hi) { const cvt_f32x2 v = {lo, hi}; const cvt_bf16x2 b = __builtin_convertvector(v, cvt_bf16x2); return __builtin_bit_cast(unsigned, b); }

struct StaticOrder {
    int nM, nN, nwg, G, c;
    __host__ __device__ void init(int M, int N, int G_, int c_) { nM = M / BM; nN = N / BM; nwg = nM * nN; G = G_; c = c_; }
    __host__ __device__ bool next(int i, Unit& u) const {
        const long L = (long)i * G + c; if (L >= nwg) return false;
        int wgid = (int)L; { const int q = nwg / NXCD, r = nwg % NXCD, xcd = wgid % NXCD, off = wgid / NXCD; wgid = (xcd < r ? xcd * (q + 1) : r * (q + 1) + (xcd - r) * q) + off; }
        const int nig = WGM * nN, gid = wgid / nig, fm = gid * WGM, gsz = (nM - fm) < WGM ? (nM - fm) : WGM;
        u.pm = fm + ((wgid % nig) % gsz); u.pn = (wgid % nig) / gsz; u.e = 0; u.rows = BM; u.mt = 0; u.cb = 0; return true;
    }
};

template <class Epi, class Sched, bool GATHER = false, bool ALIGN_EPI = true>
__device__ __forceinline__ void gemm_phase(PG8_LAS unsigned char* lds, const int tid, const int K, const Sched& S, const Epi& E) {
    const int wid = __builtin_amdgcn_readfirstlane(tid >> 6), lane = tid & 63, wr = wid >> 2, wc = wid & 3, fr = lane & 15, fq = lane >> 4;
    const int nt = K / BK;
    unsigned voffA[2], voffB[2]; int rowA[2], colA[2];
#pragma unroll
    for (int i = 0; i < 2; ++i) { int R, C; stage_rc(tid * 16 + i * 8192, R, C); const int Rb = (R & ~31) + perm32(R & 31);
        voffA[i] = (unsigned)(R * K + C) * 2u; voffB[i] = (unsigned)(Rb * K + C) * 2u; rowA[i] = R; colA[i] = C * 2; }
    const size_t kstep = (size_t)(BK * 2);
    const unsigned hstep = (unsigned)HALF * (unsigned)K * 2u;
    const unsigned ldsw = (unsigned)wid * 1024u;
    const int aoff = lds_byte(wr * 64 + fr, fq * 8), boff = lds_byte(wc * 32 + fr, fq * 8);
#define PG8_SA(b, h) (((b) * 2 + (h)) * HTB)
#define PG8_SB(b, h) ((4 + (b) * 2 + (h)) * HTB)
#define PG8_STAGE(bufoff, gbase, voff) do { _Pragma("unroll") for (int _i = 0; _i < 2; ++_i) \
        __builtin_amdgcn_global_load_lds((const unsigned*)((const char*)(gbase) + (voff)[_i]), (PG8_LAS unsigned*)(lds + (bufoff) + ldsw + _i * 8192), 16, 0, 0); } while (0)
#define PG8_STAGE_A(bufoff, gbase, V, h) do { _Pragma("unroll") for (int _i = 0; _i < 2; ++_i) { const unsigned _o = GATHER ? (V)[h][_i] : (voffA[_i] + (unsigned)(h) * hstep); \
        __builtin_amdgcn_global_load_lds((const unsigned*)((const char*)(gbase) + _o), (PG8_LAS unsigned*)(lds + (bufoff) + ldsw + _i * 8192), 16, 0, 0); } } while (0)
#define PG8_LDA(dst, b, h) do { _Pragma("unroll") for (int m = 0; m < 4; ++m) _Pragma("unroll") for (int k = 0; k < 2; ++k) dst[m][k] = *(const PG8_LAS bf16x8*)(lds + PG8_SA(b, h) + aoff + m * 2048 + k * 1024); } while (0)
#define PG8_LDB(dst, b, h) do { _Pragma("unroll") for (int n = 0; n < 2; ++n) _Pragma("unroll") for (int k = 0; k < 2; ++k) dst[n][k] = *(const PG8_LAS bf16x8*)(lds + PG8_SB(b, h) + boff + n * 2048 + k * 1024); } while (0)
#define PG8_MMA(ai, bj, At, Bt) do { __builtin_amdgcn_s_setprio(1); _Pragma("unroll") for (int m = 0; m < 4; ++m) _Pragma("unroll") for (int n = 0; n < 2; ++n) _Pragma("unroll") for (int k = 0; k < 2; ++k) \
        acc[ai][bj][m][n] = __builtin_amdgcn_mfma_f32_16x16x32_bf16(Bt[n][k], At[m][k], acc[ai][bj][m][n], 0, 0, 0); __builtin_amdgcn_s_setprio(0); } while (0)
#define PG8_WAIT_V(n) asm volatile("s_waitcnt vmcnt(" #n ")" ::: "memory")
#define PG8_WAIT_L(n) asm volatile("s_waitcnt lgkmcnt(" #n ")" ::: "memory")
#define PG8_BAR __builtin_amdgcn_s_barrier()
#define PG8_SCHED __builtin_amdgcn_sched_barrier(0)
    Unit cur, nxt; int ui = 0;
    if (!S.next(0, cur)) return;
    f32x4 acc[2][2][4][2];
#pragma unroll
    for (int a = 0; a < 2; ++a)
#pragma unroll
        for (int b = 0; b < 2; ++b)
#pragma unroll
            for (int m = 0; m < 4; ++m)
#pragma unroll
                for (int n = 0; n < 2; ++n) acc[a][b][m][n] = (f32x4){0.f, 0.f, 0.f, 0.f};
    bf16x8 At[4][2], B0[2][2], B1[2][2];
    unsigned cva[2][2] = {{0u, 0u}, {0u, 0u}}, nva[2][2] = {{0u, 0u}, {0u, 0u}};
    const char* cA = S.a_base(cur); const char* cB = S.b_base(cur);
    if constexpr (GATHER) {
#pragma unroll
        for (int h = 0; h < 2; ++h)
#pragma unroll
            for (int i = 0; i < 2; ++i) cva[h][i] = S.row_off(cur, h * HALF + rowA[i]) + (unsigned)colA[i];
    }
    PG8_STAGE(PG8_SB(0, 0), cB, voffB); PG8_STAGE(PG8_SB(0, 1), cB + hstep, voffB); PG8_STAGE_A(PG8_SA(0, 0), cA, cva, 0); PG8_STAGE_A(PG8_SA(0, 1), cA, cva, 1);
    if (wr == 1) PG8_BAR;
    PG8_WAIT_V(2); PG8_BAR;
    PG8_STAGE(PG8_SB(1, 0), cB + kstep, voffB); PG8_STAGE_A(PG8_SA(1, 0), cA + kstep, cva, 0); PG8_STAGE(PG8_SB(1, 1), cB + hstep + kstep, voffB);
    PG8_WAIT_V(6); PG8_BAR;
    for (;;) {
        const bool has_next = S.next(ui + 1, nxt);
        const char* nA = has_next ? S.a_base(nxt) : cA; const char* nB = has_next ? S.b_base(nxt) : cB;
        if constexpr (GATHER) {
#pragma unroll
            for (int h = 0; h < 2; ++h)
#pragma unroll
                for (int i = 0; i < 2; ++i) nva[h][i] = has_next ? (S.row_off(nxt, h * HALF + rowA[i]) + (unsigned)colA[i]) : cva[h][i];
        }
#pragma unroll 1
        for (int t = 0; t < nt; t += 2) {
            const bool last = (t == nt - 2);
            const char* a1 = cA + (size_t)(t + 1) * kstep;
            const char* a2 = last ? nA : cA + (size_t)(t + 2) * kstep; const char* b2 = last ? nB : cB + (size_t)(t + 2) * kstep;
            const char* a3 = a2 + kstep; const char* b3 = b2 + kstep;
            PG8_LDB(B0, 0, 0); PG8_LDB(B1, 0, 1); PG8_SCHED; PG8_LDA(At, 0, 0); PG8_STAGE_A(PG8_SA(1, 1), a1, cva, 1);
            if constexpr (GATHER) { if (last) {
#pragma unroll
                for (int h = 0; h < 2; ++h)
#pragma unroll
                    for (int i = 0; i < 2; ++i) cva[h][i] = nva[h][i]; } }
            PG8_WAIT_V(8); PG8_WAIT_L(0); PG8_BAR; PG8_MMA(0, 0, At, B0); PG8_MMA(0, 1, At, B1); PG8_BAR; PG8_SCHED;
            PG8_LDA(At, 0, 1); PG8_STAGE(PG8_SB(0, 0), b2, voffB); PG8_STAGE(PG8_SB(0, 1), b2 + hstep, voffB); PG8_STAGE_A(PG8_SA(0, 0), a2, cva, 0);
            PG8_WAIT_V(8); PG8_WAIT_L(0); PG8_BAR; PG8_MMA(1, 0, At, B0); PG8_MMA(1, 1, At, B1); PG8_BAR; PG8_SCHED;
            PG8_LDB(B0, 1, 0); PG8_LDB(B1, 1, 1); PG8_SCHED; PG8_LDA(At, 1, 0); PG8_STAGE_A(PG8_SA(0, 1), a2, cva, 1);
            PG8_WAIT_V(8); PG8_WAIT_L(0); PG8_BAR; PG8_MMA(0, 0, At, B0); PG8_MMA(0, 1, At, B1); PG8_BAR; PG8_SCHED;
            PG8_LDA(At, 1, 1); PG8_STAGE(PG8_SB(1, 0), b3, voffB); PG8_STAGE(PG8_SB(1, 1), b3 + hstep, voffB); PG8_STAGE_A(PG8_SA(1, 0), a3, cva, 0);
            PG8_WAIT_V(8); PG8_WAIT_L(0); PG8_BAR; PG8_MMA(1, 0, At, B0); PG8_MMA(1, 1, At, B1); PG8_BAR; PG8_SCHED;
        }
        if constexpr (ALIGN_EPI) { if (wr == 0) PG8_BAR; }
#ifdef DBG_EPI_NOP
        asm volatile("s_nop 15\n s_nop 15\n s_nop 15\n s_nop 15" ::: "memory");
#endif
        E(acc, cur, wr, wc, fr, fq);
        if (!has_next) break;
#pragma unroll
        for (int a = 0; a < 2; ++a)
#pragma unroll
            for (int b = 0; b < 2; ++b)
#pragma unroll
                for (int m = 0; m < 4; ++m)
#pragma unroll
                    for (int n = 0; n < 2; ++n) acc[a][b][m][n] = (f32x4){0.f, 0.f, 0.f, 0.f};
        cur = nxt; cA = nA; cB = nB; ++ui;
        if constexpr (ALIGN_EPI) { if (wr == 1) PG8_BAR; }
    }
    PG8_WAIT_V(0);
    if constexpr (!ALIGN_EPI) { if (wr == 0) PG8_BAR; }
    PG8_BAR;
#undef PG8_SA
#undef PG8_SB
#undef PG8_STAGE
#undef PG8_STAGE_A
#undef PG8_LDA
#undef PG8_LDB
#undef PG8_MMA
#undef PG8_WAIT_V
#undef PG8_WAIT_L
#undef PG8_BAR
#undef PG8_SCHED
}
}

constexpr int NWAVES = 8;
#ifndef MK_N_LAUNCHES
#define MK_N_LAUNCHES 1
#endif
constexpr int PER_PHASE = 13;
constexpr int N_LAUNCHES = MK_N_LAUNCHES;

constexpr int NTOK = 16384, SEQ = 2048, D = 1024, DIN = 3584, DSSM = 512, DCONV = 512, NGRP = 32, NST = 64, GWID = 16, CONVW = 31;
constexpr int NEXP = 32, EPG = 8, DEXP = 512, DPLE = 256, LC = 32, NCH = 64;
constexpr float EPS = 1e-6f;
enum In { I_X = 0, I_P, I_GMIX, I_WIN, I_BGATE, I_ARE, I_AIM, I_LOGDT, I_BRE, I_BIM, I_CRE, I_CIM, I_SD, I_WGLU, I_CDW, I_CDWB, I_CLNG, I_CLNB, I_WCO, I_WOUT, I_GMOE, I_WRG, I_BRG, I_WRE, I_BRE2,
          I_WEG, I_WEU, I_WED, I_GPLE, I_WPG, I_WPLE, I_GFIN, N_IN };

constexpr size_t MiB = 1u << 20;
constexpr size_t WS_CTL = 0, CTL_ZERO_BYTES = 1 * MiB;
constexpr size_t WS_LTOK = 1 * MiB;
constexpr size_t WS_TINFO = 3 * MiB;
constexpr size_t WS_R2 = 5 * MiB, WS_R3 = WS_R2 + 65536, WS_LAM32 = WS_R3 + 65536, WS_WRT = WS_R2 + 262144;
constexpr size_t WS_WST = 6 * MiB;
constexpr size_t WS_BT2 = 10 * MiB;
constexpr size_t WS_WIN = 31 * MiB, WS_WGLU = 38 * MiB, WS_WCO = 40 * MiB, WS_WO = 41 * MiB, WS_WPG = 43 * MiB, WS_WPLE = 45 * MiB;
constexpr size_t WS_PB = 46 * MiB;
constexpr size_t WS_WGU = 54 * MiB;
constexpr size_t WS_WD = 118 * MiB;
constexpr size_t WS_B = 150 * MiB;
constexpr size_t WS_C = 182 * MiB;
constexpr size_t WS_E = 224 * MiB;
constexpr size_t WS_END = 288 * MiB;
constexpr int CW_TMO = 0, CW_CODE = 1, CW_BAR = 4096, CW_ECNT = 16384;
static_assert((CW_ECNT + 64 * NEXP) * 4 <= (int)CTL_ZERO_BYTES, "CTL words inside the memset region");

constexpr int RING_OFF = 0, RING_BYTES = 131072;
constexpr int LDSCTL_OFF = RING_BYTES, MISC_OFF = LDSCTL_OFF + 320;
constexpr int TB_OFF = LDSCTL_OFF + 1024;
constexpr int LDS_BYTES = 147456;
static_assert(TB_OFF + 100 * 4 <= LDS_BYTES, "LDS map");

#define GAS __attribute__((address_space(1)))
#define LAS __attribute__((address_space(3)))
typedef unsigned short bf16;
typedef unsigned v4u __attribute__((ext_vector_type(4)));
typedef unsigned v2u __attribute__((ext_vector_type(2)));
typedef float f32x4 __attribute__((ext_vector_type(4)));
typedef short bf16x8 __attribute__((ext_vector_type(8)));
typedef GAS unsigned gu32;
#define RLX_AGENT __ATOMIC_RELAXED, __HIP_MEMORY_SCOPE_AGENT
#define LDS_WAIT() asm volatile("s_waitcnt lgkmcnt(0)" ::: "memory")
#define VM_WAIT() asm volatile("s_waitcnt vmcnt(0)" ::: "memory")
__device__ __forceinline__ unsigned f2bf(float f) { unsigned u = __builtin_bit_cast(unsigned, f); return (u + 0x7fffu + ((u >> 16) & 1u)) >> 16; }
__device__ __forceinline__ unsigned pk2(float lo, float hi) { return pg8::cvt_pk_bf16(lo, hi); }
__device__ __forceinline__ float bflo(unsigned v) { return __builtin_bit_cast(float, v << 16); }
__device__ __forceinline__ float bfhi(unsigned v) { return __builtin_bit_cast(float, v & 0xffff0000u); }
__device__ __forceinline__ float sigm(float x) { return __builtin_amdgcn_rcpf(1.0f + __expf(-x)); }
__device__ __forceinline__ float gelu_tanh(float y) { const float t = 1.5957691216f * (y + 0.044715f * y * y * y); return y * sigm(t); }

#define XB_TMO      128
#define XB_XCNT(j)  (256  + 64 * (j))
#define XB_XSUB(j)  (1280 + 64 * (j))
#define XB_XGEN(j)  (2304 + 64 * (j))
#define XB_TOP      3328
#define XB_TOPGEN   3392
#define XCD_BAR_WORDS 3456
#define XB_SPIN_CAP (1u << 18)

__device__ __forceinline__ unsigned xb_ld(unsigned* p)              { return __hip_atomic_load(p, __ATOMIC_RELAXED, __HIP_MEMORY_SCOPE_AGENT); }
__device__ __forceinline__ unsigned xb_add(unsigned* p, unsigned v) { return __hip_atomic_fetch_add(p, v, __ATOMIC_RELAXED, __HIP_MEMORY_SCOPE_AGENT); }
__device__ __forceinline__ unsigned xb_xcc_id() { return (unsigned)__builtin_amdgcn_s_getreg((3 << 11) | 20) & 0xFu; }
#define XB_SPIN(cond, bar) do { unsigned _sp = 0; while (cond) { __builtin_amdgcn_s_sleep(1); \
    if ((++_sp & 255u) == 0u) { if (xb_ld(&(bar)[XB_TMO])) break; if (_sp > XB_SPIN_CAP) { atomicAdd(&(bar)[XB_TMO], 1u); break; } } } } while (0)

struct XcdBarrier {
    unsigned* bar; unsigned x;
    volatile LAS unsigned* st;
    int wv;
};

__device__ __forceinline__ XcdBarrier xcd_barrier_post(unsigned* bar, volatile LAS unsigned* st) {
    XcdBarrier b; b.bar = bar; b.x = xb_xcc_id(); b.st = st; b.wv = 0;
    if (threadIdx.x == 0) (void)xb_add(&bar[XB_XCNT(b.x)], 1u);
    return b;
}
__device__ __forceinline__ void xcd_barrier_complete(unsigned* bar, unsigned x, unsigned& nloc, unsigned& nx) {
    const unsigned G = gridDim.x * gridDim.y * gridDim.z;
    unsigned sum, cnt, mine, sp = 0u;
    for (;;) {
        sum = 0u; cnt = 0u; mine = 0u;
#pragma unroll
        for (unsigned j = 0; j < 16; ++j) { const unsigned c = xb_ld(&bar[XB_XCNT(j)]); sum += c; cnt += (c > 0u) ? 1u : 0u; mine = (j == x) ? c : mine; }
        if (sum == G) break;
        __builtin_amdgcn_s_sleep(1);
        if ((++sp & 255u) == 0u) { if (xb_ld(&bar[XB_TMO])) break; if (sp > XB_SPIN_CAP) { atomicAdd(&bar[XB_TMO], 1u); break; } }
    }
    nloc = mine > 0u ? mine : 1u; nx = cnt > 0u ? cnt : 1u;
}

__device__ __forceinline__ void xcd_barrier(const XcdBarrier& b) {
    asm volatile("s_waitcnt vmcnt(0)" ::: "memory");
    __syncthreads();
    if (b.wv == 0 && __builtin_amdgcn_mbcnt_hi(~0u, __builtin_amdgcn_mbcnt_lo(~0u, 0u)) == 0u) {
        unsigned* bar = b.bar;
        __builtin_amdgcn_s_waitcnt(0);
        unsigned nloc = b.st[0], nx = b.st[1];
        if (nloc == 0u) { xcd_barrier_complete(bar, b.x, nloc, nx); b.st[0] = nloc; b.st[1] = nx; }
        const unsigned old = xb_add(&bar[XB_XSUB(b.x)], 1u);
        const unsigned gen = old / nloc;
        if (old + 1u == (gen + 1u) * nloc) {
            __builtin_amdgcn_fence(__ATOMIC_RELEASE, "agent");
            asm volatile("s_waitcnt vmcnt(0)" ::: "memory");
            const unsigned og = xb_add(&bar[XB_TOP], 1u);
            const unsigned tg = og / nx;
            if (og + 1u == (tg + 1u) * nx) xb_add(&bar[XB_TOPGEN], 1u);
            else XB_SPIN(xb_ld(&bar[XB_TOPGEN]) == tg, bar);
            __builtin_amdgcn_fence(__ATOMIC_ACQUIRE, "agent");
            xb_add(&bar[XB_XGEN(b.x)], 1u);
            asm volatile("s_waitcnt vmcnt(0)" ::: "memory");
        } else {
            XB_SPIN(xb_ld(&bar[XB_XGEN(b.x)]) == gen, bar);
            __builtin_amdgcn_fence(__ATOMIC_ACQUIRE, "agent");
            asm volatile("s_waitcnt vmcnt(0)" ::: "memory");
        }
    }
    __syncthreads();
}

struct Frame {
    LAS unsigned char* lds;
    volatile LAS unsigned* MISC;
    gu32* ctl;
    int tid, lane, wave;
    int vcu, G;
    const float* const* in;
    float* out; unsigned char* ws;
};
__device__ __forceinline__ float wave_sum(float v) {
#pragma unroll
    for (int o = 1; o < 64; o <<= 1) v += __shfl_xor(v, o);
    return v;
}

__device__ __forceinline__ int map_glu(int base, int o, int gate) { return base + 8 * (o >> 2) + 4 * gate + (o & 3); }
__device__ __forceinline__ int dest_row(int mode, int n, int half) {
    if (mode == 0) return n;
    if (mode == 1) { if (n < 512) return n; if (n < 1024) return map_glu(512, n - 512, 0); if (n < 1536) return map_glu(512, n - 1024, 1); return n; }
    if (mode == 2) return n < half ? map_glu(0, n, 0) : map_glu(0, n - half, 1);
    if (mode == 3) return map_glu(0, n, 0);
    return map_glu(0, n, 1);
}
__device__ __forceinline__ void tr_item(const float* W, int K, int N, bf16* WT, int mode, int half, const float* ks, LAS unsigned* T, int item, int lane) {
    const int nblk = N / 64, kb = item / nblk, nb = item % nblk, k0 = 64 * kb, n0 = 64 * nb, nq = lane & 15, kq = lane >> 4;
    f32x4 v[8][2];
    const float* src = W + (size_t)(k0 + 2 * kq) * N + n0 + 4 * nq;
#pragma unroll
    for (int s = 0; s < 8; ++s) { v[s][0] = *(const GAS f32x4*)(src + (size_t)(8 * s) * N); v[s][1] = *(const GAS f32x4*)(src + (size_t)(8 * s + 1) * N); }
    if (ks) {
#pragma unroll
        for (int s = 0; s < 8; ++s) { const float a = ks[k0 + 8 * s + 2 * kq], b = ks[k0 + 8 * s + 2 * kq + 1]; v[s][0] *= a; v[s][1] *= b; } }
#pragma unroll
    for (int s = 0; s < 8; ++s)
#pragma unroll
        for (int jj = 0; jj < 4; ++jj) T[(4 * nq + jj) * 33 + 4 * s + kq] = pk2(v[s][0][jj], v[s][1][jj]);
    LDS_WAIT(); asm volatile("" ::: "memory");
    const int c = lane & 7;
#pragma unroll
    for (int i = 0; i < 8; ++i) { const int n = (lane >> 3) + 8 * i; const LAS unsigned* t = T + n * 33 + 4 * c;
        v4u o; o.x = t[0]; o.y = t[1]; o.z = t[2]; o.w = t[3];
        *(GAS v4u*)(WT + (size_t)dest_row(mode, n0 + n, half) * K + k0 + 8 * c) = o; }
    LDS_WAIT(); asm volatile("" ::: "memory");
}
__device__ __forceinline__ void ssm_tables(Frame& F, int g) {
    LAS float* LP = (LAS float*)F.lds;
    LAS float* BB = LP + 33 * 64 * 2;
    LAS float* CC = BB + 2048;
    LAS float* KT = CC + 2048;
    const float* a_re = F.in[I_ARE]; const float* a_im = F.in[I_AIM]; const float* b_re = F.in[I_BRE]; const float* b_im = F.in[I_BIM];
    const float* c_re = F.in[I_CRE]; const float* c_im = F.in[I_CIM]; const float* sd = F.in[I_SD];
    {   const int n = F.tid & 63, tq = F.tid >> 6; const float dt = expf(F.in[I_LOGDT][g]); const float ar = a_re[g * 64 + n], ai = a_im[g * 64 + n]; const float bm = ar * dt, ba = ai * dt;
        for (int tau = tq; tau <= 32; tau += 8) { const float mag = expf(bm * (float)tau); float sn, cs; sincosf(ba * (float)tau, &sn, &cs); LP[(tau * 64 + n) * 2] = mag * cs; LP[(tau * 64 + n) * 2 + 1] = mag * sn; }
        const float mag = expf(bm); float sn, cs; sincosf(ba, &sn, &cs); const float lr = mag * cs, li = mag * sn;
        const float den = ar * ar + ai * ai, nr = lr - 1.0f, ni = li; const float zr = (nr * ar + ni * ai) / den, zi = (ni * ar - nr * ai) / den;
#pragma unroll
        for (int k = 0; k < 2; ++k) { const int ch = 2 * tq + k; const float br = b_re[(g * 64 + n) * 16 + ch], bi = b_im[(g * 64 + n) * 16 + ch];
            BB[(n * 16 + ch) * 2] = zr * br - zi * bi; BB[(n * 16 + ch) * 2 + 1] = zr * bi + zi * br; } }
    for (int e = F.tid; e < 1024; e += 512) { CC[e * 2] = c_re[g * 1024 + e]; CC[e * 2 + 1] = c_im[g * 1024 + e]; }
    __syncthreads();
    if (F.tid < 64) { float* l32 = (float*)(F.ws + WS_LAM32); l32[(g * 64 + F.tid) * 2] = LP[(32 * 64 + F.tid) * 2]; l32[(g * 64 + F.tid) * 2 + 1] = LP[(32 * 64 + F.tid) * 2 + 1]; }
    {
        const int p = F.tid & 255, cp = p >> 4, ch = p & 15, t0 = (F.tid >> 8) * 16; float kacc[16];
#pragma unroll
        for (int t = 0; t < 16; ++t) kacc[t] = 0.f;
        for (int n = 0; n < 64; ++n) {
            const float cr = CC[(cp * 64 + n) * 2], ci = CC[(cp * 64 + n) * 2 + 1], br = BB[(n * 16 + ch) * 2], bi = BB[(n * 16 + ch) * 2 + 1];
            const float pr = cr * br - ci * bi, pi = cr * bi + ci * br, l0r = LP[(t0 * 64 + n) * 2], l0i = LP[(t0 * 64 + n) * 2 + 1], lr = LP[(64 + n) * 2], li = LP[(64 + n) * 2 + 1];
            float wr_ = pr * l0r - pi * l0i, wi_ = pr * l0i + pi * l0r;
#pragma unroll
            for (int t = 0; t < 16; ++t) { kacc[t] += wr_; const float nr = wr_ * lr - wi_ * li, ni = wr_ * li + wi_ * lr; wr_ = nr; wi_ = ni; }
        }
#pragma unroll
        for (int t = 0; t < 16; ++t) KT[((t0 + t) << 8) + p] = kacc[t];
    }
    __syncthreads();
    bf16* Bt2 = (bf16*)(F.ws + WS_BT2) + (size_t)g * 512 * 640;
    for (int q = F.tid; q < 512 * 80; q += 512) {
        const int R = q / 80, cc = q % 80, t = R >> 4, cp = R & 15; float v[8];
        if (cc < 64) { const int j = cc >> 1, chb = (cc & 1) * 8;
#pragma unroll
            for (int i = 0; i < 8; ++i) { const int ch = chb + i; float x = (t >= j) ? KT[((t - j) << 8) + cp * 16 + ch] : 0.f; if (t == j && ch == cp) x += sd[g * 16 + ch]; v[i] = x; }
        } else { const int nb = (cc - 64) * 4;
#pragma unroll
            for (int i = 0; i < 4; ++i) { const int n = nb + i; const float cr = CC[(cp * 64 + n) * 2], ci = CC[(cp * 64 + n) * 2 + 1], lr = LP[((t + 1) * 64 + n) * 2], li = LP[((t + 1) * 64 + n) * 2 + 1];
                v[2 * i] = cr * lr - ci * li; v[2 * i + 1] = -(cr * li + ci * lr); }
        }
        v4u o; o.x = pk2(v[0], v[1]); o.y = pk2(v[2], v[3]); o.z = pk2(v[4], v[5]); o.w = pk2(v[6], v[7]);
        *(GAS v4u*)(Bt2 + (size_t)R * 640 + cc * 8) = o;
    }
    bf16* WsT = (bf16*)(F.ws + WS_WST) + (size_t)g * 128 * 512;
    for (int q = F.tid; q < 128 * 64; q += 512) {
        const int R = q >> 6, cc = q & 63, n = R >> 1, ri = R & 1, j = cc >> 1, chb = (cc & 1) * 8; float v[8];
        const float lr = LP[((31 - j) * 64 + n) * 2], li = LP[((31 - j) * 64 + n) * 2 + 1];
#pragma unroll
        for (int i = 0; i < 8; ++i) { const float br = BB[(n * 16 + chb + i) * 2], bi = BB[(n * 16 + chb + i) * 2 + 1]; v[i] = ri == 0 ? (lr * br - li * bi) : (lr * bi + li * br); }
        v4u o; o.x = pk2(v[0], v[1]); o.y = pk2(v[2], v[3]); o.z = pk2(v[4], v[5]); o.w = pk2(v[6], v[7]);
        *(GAS v4u*)(WsT + (size_t)R * 512 + cc * 8) = o;
    }
    __syncthreads();
}
__device__ __forceinline__ void p0_prologue(Frame& F) {
    const bool split = F.G > NGRP; const bool tabler = split && (int)blockIdx.x < NGRP;
#ifndef P0_REP_TAB
#define P0_REP_TAB 1
#define P0_REP_TR 1
#define P0_REP_ROWS 1
#endif
    for (int rp_ = 0; rp_ < P0_REP_TAB; ++rp_)
    if (!split || tabler) for (int g = blockIdx.x; g < NGRP; g += F.G) ssm_tables(F, g);
    LAS unsigned* scr = (LAS unsigned*)(F.lds + RING_OFF + F.wave * 16384);
    const int gw = F.vcu * NWAVES + F.wave, NGW = F.G * NWAVES;
    constexpr int I_IN = 16 * 56, I_GLU = 8 * 32, I_CO = 8 * 16, I_O = 16 * 16, I_PG = 16 * 16, I_PLE = 4 * 16, I_EG = 16 * 8, I_ED = 8 * 16;
    constexpr int NITEMS = I_IN + I_GLU + I_CO + I_O + I_PG + I_PLE + NEXP * (2 * I_EG + I_ED);
    const int tw = split ? ((int)blockIdx.x - NGRP) * NWAVES + F.wave : gw, NTW = split ? (F.G - NGRP) * NWAVES : NGW;
    for (int rp_ = 0; rp_ < P0_REP_TR; ++rp_)
    if (!tabler) for (int it = tw; it < NITEMS; it += NTW) {
        int r = it;
        if (r < I_IN) { tr_item(F.in[I_WIN], D, DIN, (bf16*)(F.ws + WS_WIN), 1, 0, nullptr, scr, r, F.lane); continue; } r -= I_IN;
        if (r < I_GLU) { tr_item(F.in[I_WGLU], DSSM, 2 * D, (bf16*)(F.ws + WS_WGLU), 2, D, nullptr, scr, r, F.lane); continue; } r -= I_GLU;
        if (r < I_CO) { tr_item(F.in[I_WCO], DCONV, D, (bf16*)(F.ws + WS_WCO), 0, 0, nullptr, scr, r, F.lane); continue; } r -= I_CO;
        if (r < I_O) { tr_item(F.in[I_WOUT], D, D, (bf16*)(F.ws + WS_WO), 0, 0, nullptr, scr, r, F.lane); continue; } r -= I_O;
        if (r < I_PG) { tr_item(F.in[I_WPG], D, D, (bf16*)(F.ws + WS_WPG), 0, 0, F.in[I_GPLE], scr, r, F.lane); continue; } r -= I_PG;
        if (r < I_PLE) { tr_item(F.in[I_WPLE], DPLE, D, (bf16*)(F.ws + WS_WPLE), 0, 0, nullptr, scr, r, F.lane); continue; } r -= I_PLE;
        const int e = r / (2 * I_EG + I_ED); r -= e * (2 * I_EG + I_ED);
        if (r < I_EG) { tr_item(F.in[I_WEG] + (size_t)e * D * DEXP, D, DEXP, (bf16*)(F.ws + WS_WGU) + (size_t)e * D * D, 3, 0, F.in[I_GMOE], scr, r, F.lane); continue; } r -= I_EG;
        if (r < I_EG) { tr_item(F.in[I_WEU] + (size_t)e * D * DEXP, D, DEXP, (bf16*)(F.ws + WS_WGU) + (size_t)e * D * D, 4, 0, F.in[I_GMOE], scr, r, F.lane); continue; } r -= I_EG;
        tr_item(F.in[I_WED] + (size_t)e * DEXP * D, DEXP, D, (bf16*)(F.ws + WS_WD) + (size_t)e * D * DEXP, 0, 0, nullptr, scr, r, F.lane);
    }
    for (int rp_ = 0; rp_ < P0_REP_ROWS; ++rp_) { const float* x = F.in[I_X]; const float* gm = F.in[I_GMIX]; bf16* XN = (bf16*)(F.ws + WS_B);
      f32x4 gv[4];
#pragma unroll
      for (int j = 0; j < 4; ++j) gv[j] = *(const f32x4*)(gm + 4 * F.lane + 256 * j);
      for (int m = gw; m < NTOK; m += NGW) {
        const GAS f32x4* xr = (const GAS f32x4*)(x + (size_t)m * D) + F.lane; f32x4 v[4]; float s = 0.f;
#pragma unroll
        for (int j = 0; j < 4; ++j) { v[j] = xr[64 * j]; s += (v[j].x * v[j].x + v[j].y * v[j].y) + (v[j].z * v[j].z + v[j].w * v[j].w); }
        const float r = 1.0f / sqrtf(wave_sum(s) * (1.f / D) + EPS);
        GAS v2u* o8 = (GAS v2u*)(XN + (size_t)m * D) + F.lane;
#pragma unroll
        for (int j = 0; j < 4; ++j) { v2u o; o.x = pk2(v[j].x * r * gv[j].x, v[j].y * r * gv[j].y); o.y = pk2(v[j].z * r * gv[j].z, v[j].w * r * gv[j].w); o8[64 * j] = o; }
      } }
    { const float* p = F.in[I_P]; bf16* PB = (bf16*)(F.ws + WS_PB); const int gt = F.vcu * 512 + F.tid, NGT = F.G * 512;
      for (int q = gt; q < NTOK * DPLE / 8; q += NGT) { const f32x4 a = *(const f32x4*)(p + (size_t)q * 8), b = *(const f32x4*)(p + (size_t)q * 8 + 4);
        v4u o; o.x = pk2(a.x, a.y); o.y = pk2(a.z, a.w); o.z = pk2(b.x, b.y); o.w = pk2(b.z, b.w); *(GAS v4u*)(PB + (size_t)q * 8) = o; }
      bf16* WRT = (bf16*)(F.ws + WS_WRT); const float* gmoe = F.in[I_GMOE];
      for (int q = gt; q < 48 * 1024; q += NGT) { const int o = q >> 10, k = q & 1023; float v = 0.f;
        if (o < 4) v = F.in[I_WRG][k * 4 + o] * gmoe[k]; else if (o < 36) v = F.in[I_WRE][k * 32 + (o - 4)] * gmoe[k];
        const unsigned h = f2bf(v); const float lo = v - __builtin_bit_cast(float, h << 16); WRT[q] = (bf16)h; WRT[48 * 1024 + q] = (bf16)f2bf(lo); } }
}

using pg8::Unit;
typedef const f32x4 (&AccRef)[2][2][4][2];
struct EpiP1 {
    bf16* U; bf16* Z; bf16* SG; const float* bg;
    __device__ __forceinline__ void operator()(AccRef acc, const Unit& u, int wr, int wc, int fr, int fq) const {
        const int r0 = u.pm * 256 + wr * 64 + fr;
        if (u.pn < 2) {
#pragma unroll
            for (int ai = 0; ai < 2; ++ai)
#pragma unroll
                for (int m = 0; m < 4; ++m) { const int r = r0 + ai * 128 + m * 16, b = r >> 11, t = r & 2047;
#pragma unroll
                    for (int bj = 0; bj < 2; ++bj) { const int c0 = u.pn * 256 + bj * 128 + wc * 32 + fq * 8, g = c0 >> 4, ch0 = c0 & 15;
                        const f32x4 v0 = acc[ai][bj][m][0], v1 = acc[ai][bj][m][1];
                        v4u w; w.x = pk2(v0[0], v0[1]); w.y = pk2(v0[2], v0[3]); w.z = pk2(v1[0], v1[1]); w.w = pk2(v1[2], v1[3]);
                        *(GAS v4u*)(U + (((size_t)(b * 32 + g) * 2048 + t) * 16 + ch0)) = w; } }
        } else if (u.pn < 6) {
#pragma unroll
            for (int ai = 0; ai < 2; ++ai)
#pragma unroll
                for (int m = 0; m < 4; ++m) { const int r = r0 + ai * 128 + m * 16;
#pragma unroll
                    for (int bj = 0; bj < 2; ++bj) { const int o0 = (u.pn - 2) * 128 + bj * 64 + wc * 16 + fq * 4;
                        const f32x4 va = acc[ai][bj][m][0], ga = acc[ai][bj][m][1];
                        v2u w; w.x = pk2(va[0] * sigm(ga[0]), va[1] * sigm(ga[1])); w.y = pk2(va[2] * sigm(ga[2]), va[3] * sigm(ga[3]));
                        *(GAS v2u*)(Z + (size_t)r * 512 + o0) = w; } }
        } else {
#pragma unroll
            for (int bj = 0; bj < 2; ++bj) { const int s0 = (u.pn - 6) * 256 + bj * 128 + wc * 32 + fq * 8;
#ifdef DBG_NO_BIAS
                const f32x4 b0 = (f32x4){0.f, 0.f, 0.f, 0.f}, b1 = b0;
#else
                const f32x4 b0 = *(const f32x4*)(bg + s0), b1 = *(const f32x4*)(bg + s0 + 4);
#endif
#pragma unroll
                for (int ai = 0; ai < 2; ++ai)
#pragma unroll
                    for (int m = 0; m < 4; ++m) { const int r = r0 + ai * 128 + m * 16;
#ifdef DBG_BIAS_ONLY
                        const f32x4 v0 = b0, v1 = b1;
#else
                        const f32x4 v0 = acc[ai][bj][m][0] + b0, v1 = acc[ai][bj][m][1] + b1;
#endif
                        v4u w; w.x = pk2(sigm(v0[0]), sigm(v0[1])); w.y = pk2(sigm(v0[2]), sigm(v0[3])); w.z = pk2(sigm(v1[0]), sigm(v1[1])); w.w = pk2(sigm(v1[2]), sigm(v1[3]));
#ifdef DBG_SG_CONST
                        w.x = w.y = w.z = w.w = 0x3f003f00u;
#endif
                        *(GAS v4u*)(SG + (size_t)r * 2048 + s0) = w; } }
        }
    }
};
struct EpiGlu {
    bf16* MS; const bf16* SG;
    static __device__ __forceinline__ void run(AccRef acc, const Unit& u, int wr, int wc, int fr, int fq, bf16* __restrict__ MS, const bf16* __restrict__ SG) {
        const int r0 = u.pm * 256 + wr * 64 + fr;
#pragma unroll
        for (int ai = 0; ai < 2; ++ai)
#pragma unroll
            for (int m = 0; m < 4; ++m) { const int r = r0 + ai * 128 + m * 16;
#pragma unroll
                for (int bj = 0; bj < 2; ++bj) { const int o0 = u.pn * 128 + bj * 64 + wc * 16 + fq * 4;
                    const v2u sg = *(const GAS v2u*)(SG + (size_t)r * 2048 + o0);
                    const f32x4 va = acc[ai][bj][m][0], ga = acc[ai][bj][m][1];
                    v2u o; o.x = pk2(va[0] * sigm(ga[0]) * bflo(sg.x), va[1] * sigm(ga[1]) * bfhi(sg.x)); o.y = pk2(va[2] * sigm(ga[2]) * bflo(sg.y), va[3] * sigm(ga[3]) * bfhi(sg.y));
                    *(GAS v2u*)(MS + (size_t)r * 1024 + o0) = o; } }
    }
    __device__ __forceinline__ void operator()(AccRef acc, const Unit& u, int wr, int wc, int fr, int fq) const { run(acc, u, wr, wc, fr, fq, MS, SG); }
};
struct EpiCo {
    const bf16* MS; const bf16* SG; bf16* MG;
    static __device__ __forceinline__ void run(AccRef acc, const Unit& u, int wr, int wc, int fr, int fq, const bf16* __restrict__ MS, const bf16* __restrict__ SG, bf16* __restrict__ MG) {
        const int r0 = u.pm * 256 + wr * 64 + fr;
#pragma unroll
        for (int ai = 0; ai < 2; ++ai)
#pragma unroll
            for (int m = 0; m < 4; ++m) { const int r = r0 + ai * 128 + m * 16;
#pragma unroll
                for (int bj = 0; bj < 2; ++bj) { const int c0 = u.pn * 256 + bj * 128 + wc * 32 + fq * 8;
                    const v4u ms = *(const GAS v4u*)(MS + (size_t)r * 1024 + c0);
                    const v4u sg = *(const GAS v4u*)(SG + (size_t)r * 2048 + 1024 + c0);
                    const f32x4 v0 = acc[ai][bj][m][0], v1 = acc[ai][bj][m][1];
                    v4u w; w.x = pk2(bflo(ms.x) + bflo(sg.x) * v0[0], bfhi(ms.x) + bfhi(sg.x) * v0[1]); w.y = pk2(bflo(ms.y) + bflo(sg.y) * v0[2], bfhi(ms.y) + bfhi(sg.y) * v0[3]);
                    w.z = pk2(bflo(ms.z) + bflo(sg.z) * v1[0], bfhi(ms.z) + bfhi(sg.z) * v1[1]); w.w = pk2(bflo(ms.w) + bflo(sg.w) * v1[2], bfhi(ms.w) + bfhi(sg.w) * v1[3]);
                    *(GAS v4u*)(MG + (size_t)r * 1024 + c0) = w; } }
    }
    __device__ __forceinline__ void operator()(AccRef acc, const Unit& u, int wr, int wc, int fr, int fq) const { run(acc, u, wr, wc, fr, fq, MS, SG, MG); }
};
struct EpiRes {
    const float* X; bf16* X1B;
    static __device__ __forceinline__ void run(AccRef acc, const Unit& u, int wr, int wc, int fr, int fq, const float* __restrict__ X, bf16* __restrict__ X1B) {
        const int r0 = u.pm * 256 + wr * 64 + fr;
#pragma unroll
        for (int ai = 0; ai < 2; ++ai)
#pragma unroll
            for (int m = 0; m < 4; ++m) { const int r = r0 + ai * 128 + m * 16;
#pragma unroll
                for (int bj = 0; bj < 2; ++bj) { const size_t o = (size_t)r * 1024 + u.pn * 256 + bj * 128 + wc * 32 + fq * 8;
                    const f32x4 x0 = *(const GAS f32x4*)(X + o) + acc[ai][bj][m][0], x1 = *(const GAS f32x4*)(X + o + 4) + acc[ai][bj][m][1];
                    v4u w; w.x = pk2(x0[0], x0[1]); w.y = pk2(x0[2], x0[3]); w.z = pk2(x1[0], x1[1]); w.w = pk2(x1[2], x1[3]);
                    *(GAS v4u*)(X1B + o) = w; } }
    }
    __device__ __forceinline__ void operator()(AccRef acc, const Unit& u, int wr, int wc, int fr, int fq) const { run(acc, u, wr, wc, fr, fq, X, X1B); }
};
struct EpiAct {
    bf16* ACT; const int* ltok; const float* R2;
    static __device__ __forceinline__ void run(AccRef acc, const Unit& u, int wr, int wc, int fr, int fq, bf16* __restrict__ ACT, const int* __restrict__ ltok, const float* __restrict__ R2) {
        float rr[2][4];
#pragma unroll
        for (int ai = 0; ai < 2; ++ai)
#pragma unroll
            for (int m = 0; m < 4; ++m) { const int rl = ai * 128 + wr * 64 + m * 16 + fr; const int tok = (rl < u.rows) ? ltok[u.e * NTOK + u.mt * 256 + rl] : 0; rr[ai][m] = R2[tok]; }
#pragma unroll
        for (int ai = 0; ai < 2; ++ai)
#pragma unroll
            for (int m = 0; m < 4; ++m) { const int rl = ai * 128 + wr * 64 + m * 16 + fr;
                if (rl < u.rows) {
#pragma unroll
                    for (int bj = 0; bj < 2; ++bj) { const int o0 = u.pn * 128 + bj * 64 + wc * 16 + fq * 4;
                        const f32x4 ga = acc[ai][bj][m][0] * rr[ai][m], ua = acc[ai][bj][m][1] * rr[ai][m];
                        v2u w; w.x = pk2(ga[0] * sigm(ga[0]) * ua[0], ga[1] * sigm(ga[1]) * ua[1]); w.y = pk2(ga[2] * sigm(ga[2]) * ua[2], ga[3] * sigm(ga[3]) * ua[3]);
                        *(GAS v2u*)(ACT + (size_t)(u.pm * 256 + rl) * 512 + o0) = w; } } }
    }
    __device__ __forceinline__ void operator()(AccRef acc, const Unit& u, int wr, int wc, int fr, int fq) const { run(acc, u, wr, wc, fr, fq, ACT, ltok, R2); }
};
struct EpiY {
    bf16* Y;
    __device__ __forceinline__ void operator()(AccRef acc, const Unit& u, int wr, int wc, int fr, int fq) const {
#pragma unroll
        for (int ai = 0; ai < 2; ++ai)
#pragma unroll
            for (int m = 0; m < 4; ++m) { const int rl = ai * 128 + wr * 64 + m * 16 + fr;
                if (rl < u.rows) {
#pragma unroll
                    for (int bj = 0; bj < 2; ++bj) { const f32x4 v0 = acc[ai][bj][m][0], v1 = acc[ai][bj][m][1];
                        v4u w; w.x = pk2(v0[0], v0[1]); w.y = pk2(v0[2], v0[3]); w.z = pk2(v1[0], v1[1]); w.w = pk2(v1[2], v1[3]);
                        *(GAS v4u*)(Y + (size_t)(u.cb + rl) * 1024 + u.pn * 256 + bj * 128 + wc * 32 + fq * 8) = w; } } }
    }
};
struct EpiE {
    bf16* EO;
    __device__ __forceinline__ void operator()(AccRef acc, const Unit& u, int wr, int wc, int fr, int fq) const {
        const int r0 = u.pm * 256 + wr * 64 + fr;
#pragma unroll
        for (int ai = 0; ai < 2; ++ai)
#pragma unroll
            for (int m = 0; m < 4; ++m) { const int r = r0 + ai * 128 + m * 16;
#pragma unroll
                for (int bj = 0; bj < 2; ++bj) { const size_t o = (size_t)r * 1024 + u.pn * 256 + bj * 128 + wc * 32 + fq * 8; const f32x4 v0 = acc[ai][bj][m][0], v1 = acc[ai][bj][m][1];
                    v4u w; w.x = pk2(v0[0], v0[1]); w.y = pk2(v0[2], v0[3]); w.z = pk2(v1[0], v1[1]); w.w = pk2(v1[2], v1[3]);
                    *(GAS v4u*)(EO + o) = w; } }
    }
};
struct EpiPle {
    const bf16* X2; const bf16* EO; const float* R3; bf16* X3;
    static __device__ __forceinline__ void run(AccRef acc, const Unit& u, int wr, int wc, int fr, int fq, const bf16* __restrict__ X2, const bf16* __restrict__ EO, const float* __restrict__ R3, bf16* __restrict__ X3) {
        const int r0 = u.pm * 256 + wr * 64 + fr;
#pragma unroll
        for (int ai = 0; ai < 2; ++ai)
#pragma unroll
            for (int m = 0; m < 4; ++m) { const int r = r0 + ai * 128 + m * 16; const float r3 = R3[r];
#pragma unroll
                for (int bj = 0; bj < 2; ++bj) { const size_t o = (size_t)r * 1024 + u.pn * 256 + bj * 128 + wc * 32 + fq * 8;
                    const v4u x = *(const GAS v4u*)(X2 + o), e = *(const GAS v4u*)(EO + o);
                    const f32x4 a0 = acc[ai][bj][m][0] * r3, a1 = acc[ai][bj][m][1] * r3;
                    v4u w; w.x = pk2(bflo(x.x) + sigm(a0[0]) * bflo(e.x), bfhi(x.x) + sigm(a0[1]) * bfhi(e.x)); w.y = pk2(bflo(x.y) + sigm(a0[2]) * bflo(e.y), bfhi(x.y) + sigm(a0[3]) * bfhi(e.y));
                    w.z = pk2(bflo(x.z) + sigm(a1[0]) * bflo(e.z), bfhi(x.z) + sigm(a1[1]) * bfhi(e.z)); w.w = pk2(bflo(x.w) + sigm(a1[2]) * bflo(e.w), bfhi(x.w) + sigm(a1[3]) * bfhi(e.w));
                    *(GAS v4u*)(X3 + o) = w; } }
    }
    __device__ __forceinline__ void operator()(AccRef acc, const Unit& u, int wr, int wc, int fr, int fq) const { run(acc, u, wr, wc, fr, fq, X2, EO, R3, X3); }
};
struct DenseOrder : pg8::StaticOrder {
    const char* A; const char* Bt; size_t tstep;
    __device__ __forceinline__ const char* a_base(const Unit& u) const { return A + (size_t)u.pm * tstep; }
    __device__ __forceinline__ const char* b_base(const Unit& u) const { return Bt + (size_t)u.pn * tstep; }
    __device__ __forceinline__ unsigned row_off(const Unit&, int) const { return 0u; }
};
struct GluPairOrder : DenseOrder {
    __device__ __forceinline__ bool next(int i, Unit& u) const { if (i >= 2) return false; Unit t; if (!pg8::StaticOrder::next(0, t)) return false; u = t; u.pn = 2 * t.pn + i; return true; }
};
struct MoeOrder {
    const LAS int* tb; const LAS int* cn; int G, c, K, npn;
    const char* A; const char* Bt; size_t b_estride; const int* ltok; bool gather;
    __device__ __forceinline__ bool next(int i, Unit& u) const {
        const int L = i * G + c, total = tb[NEXP] * npn; if (L >= total) return false;
        const int tile = L / npn; int e = 0;
        for (int k = 1; k < NEXP; ++k) e += (tb[k] <= tile) ? 1 : 0;
        u.e = e; u.pm = tile; u.pn = L % npn; u.mt = tile - tb[e]; const int left = cn[e] - u.mt * 256; u.rows = left < 256 ? left : 256; u.cb = cn[33 + e] + u.mt * 256; return true;
    }
    __device__ __forceinline__ const char* a_base(const Unit& u) const { return gather ? A : A + (size_t)u.pm * 256 * K * 2; }
    __device__ __forceinline__ const char* b_base(const Unit& u) const { return Bt + (size_t)u.e * b_estride + (size_t)u.pn * 256 * K * 2; }
    __device__ __forceinline__ unsigned row_off(const Unit& u, int r) const { const int tok = (r < u.rows) ? ltok[u.e * NTOK + u.mt * 256 + r] : 0; return (unsigned)tok * (unsigned)(K * 2); }
};

constexpr int SSM_AP = 1296;
__device__ __forceinline__ void ssm_unit(Frame& F, int b, int g) {
    LAS unsigned char* Al = F.lds;
    LAS float* SL = (LAS float*)(F.lds + 64 * SSM_AP);
    const int fr = F.lane & 15, fq = F.lane >> 4, w = F.wave;
    const bf16* Ug = (const bf16*)(F.ws + WS_C) + (size_t)(b * 32 + g) * 2048 * 16;
#pragma unroll 4
    for (int q = F.tid; q < 4096; q += 512) { const int row = q >> 6, cc = q & 63; const v4u v = *(const GAS v4u*)(Ug + row * 512 + cc * 8); *(LAS v4u*)(Al + row * SSM_AP + cc * 16) = v; }
    __syncthreads();
    {
        const bf16* WS = (const bf16*)(F.ws + WS_WST) + ((size_t)g * 128 + 16 * w + fr) * 512 + 8 * fq;
        f32x4 acc[4];
#pragma unroll
        for (int m = 0; m < 4; ++m) acc[m] = (f32x4){0.f, 0.f, 0.f, 0.f};
#pragma unroll 4
        for (int s = 0; s < 16; ++s) { const bf16x8 bw = *(const GAS bf16x8*)(WS + 32 * s);
#pragma unroll
            for (int m = 0; m < 4; ++m) { const bf16x8 a = *(const LAS bf16x8*)(Al + (16 * m + fr) * SSM_AP + (32 * s + 8 * fq) * 2); acc[m] = __builtin_amdgcn_mfma_f32_16x16x32_bf16(bw, a, acc[m], 0, 0, 0); } }
#pragma unroll
        for (int m = 0; m < 4; ++m) *(LAS f32x4*)(SL + (16 * m + fr) * 132 + 16 * w + 4 * fq) = acc[m];
    }
    __syncthreads();
    if (w == 0) {
        const int n = F.lane; const float* l32 = (const float*)(F.ws + WS_LAM32) + (g * 64 + n) * 2; const float lr = l32[0], li = l32[1]; float sr = 0.f, si = 0.f;
        for (int c = 0; c < NCH; ++c) { *(LAS unsigned*)(Al + c * SSM_AP + 1024 + 4 * n) = pk2(sr, si);
            const float ur = SL[c * 132 + 2 * n], ui = SL[c * 132 + 2 * n + 1]; const float nr = lr * sr - li * si + ur, ni = lr * si + li * sr + ui; sr = nr; si = ni; }
    }
    __syncthreads();
    {
        const bf16* BT = (const bf16*)(F.ws + WS_BT2) + ((size_t)g * 512 + 64 * w + fr) * 640 + 8 * fq;
        f32x4 acc[4][4];
#pragma unroll
        for (int m = 0; m < 4; ++m)
#pragma unroll
            for (int n = 0; n < 4; ++n) acc[m][n] = (f32x4){0.f, 0.f, 0.f, 0.f};
#pragma unroll 2
        for (int s = 0; s < 20; ++s) { bf16x8 bf[4], af[4];
#pragma unroll
            for (int n = 0; n < 4; ++n) bf[n] = *(const GAS bf16x8*)(BT + (size_t)n * 16 * 640 + 32 * s);
#pragma unroll
            for (int m = 0; m < 4; ++m) af[m] = *(const LAS bf16x8*)(Al + (16 * m + fr) * SSM_AP + (32 * s + 8 * fq) * 2);
#pragma unroll
            for (int m = 0; m < 4; ++m)
#pragma unroll
                for (int n = 0; n < 4; ++n) acc[m][n] = __builtin_amdgcn_mfma_f32_16x16x32_bf16(bf[n], af[m], acc[m][n], 0, 0, 0); }
        bf16* GY = (bf16*)(F.ws + WS_B);
#pragma unroll
        for (int m = 0; m < 4; ++m)
#pragma unroll
            for (int n = 0; n < 4; ++n) { const int tok = b * SEQ + LC * (16 * m + fr) + 4 * w + n; const f32x4 y = acc[m][n];
                v2u o; o.x = pk2(gelu_tanh(y[0]), gelu_tanh(y[1])); o.y = pk2(gelu_tanh(y[2]), gelu_tanh(y[3]));
                *(GAS v2u*)(GY + (size_t)tok * 512 + 16 * g + 4 * fq) = o; }
    }
    __syncthreads();
}
__device__ __forceinline__ void conv_tile(Frame& F, int tile) {
    const int tok0 = tile * 64, b = tok0 >> 11, t0 = tok0 & 2047;
    LAS unsigned* zl = (LAS unsigned*)F.lds;
    LAS float* red = (LAS float*)(F.lds + 98304);
    const bf16* Z = (const bf16*)(F.ws + WS_C + 16 * MiB);
#pragma unroll 2
    for (int q = F.tid; q < 94 * 64; q += 512) { const int rr = q >> 6, cc = q & 63, t = t0 - 30 + rr; v4u v = (v4u){0u, 0u, 0u, 0u};
        if (t >= 0) v = *(const GAS v4u*)(Z + (size_t)(b * SEQ + t) * 512 + cc * 8); *(LAS v4u*)(zl + rr * 256 + cc * 4) = v; }
    __syncthreads();
    const int wq = F.wave & 3, th = F.wave >> 2, cp = wq * 64 + F.lane;
    float dw0[31], dw1[31];
    {   const float* pw = F.in[I_CDW] + 2 * cp;
        typedef float f32x2 __attribute__((ext_vector_type(2)));
#pragma unroll
        for (int k = 0; k < 31; ++k) { const f32x2 v = *(const GAS f32x2*)pw; dw0[k] = v.x; dw1[k] = v.y; pw += 512; asm volatile("" : "+v"(pw)); } }
    const float cb0 = F.in[I_CDWB][2 * cp], cb1 = F.in[I_CDWB][2 * cp + 1], lg0 = F.in[I_CLNG][2 * cp], lg1 = F.in[I_CLNG][2 * cp + 1], lb0 = F.in[I_CLNB][2 * cp], lb1 = F.in[I_CLNB][2 * cp + 1];
    bf16* CA = (bf16*)(F.ws + WS_B + 16 * MiB);
#pragma unroll 1
    for (int ch = 0; ch < 4; ++ch) {
        float a0[8], a1[8];
#pragma unroll
        for (int o = 0; o < 8; ++o) { a0[o] = cb0; a1[o] = cb1; }
        const int rbase = th * 32 + ch * 8;
#pragma unroll
        for (int r = 0; r < 38; ++r) { const unsigned v = zl[(rbase + r) * 256 + cp]; const float x0 = bflo(v), x1 = bfhi(v);
#pragma unroll
            for (int o = 0; o < 8; ++o) { const int k = r - o; if (k >= 0 && k <= 30) { a0[o] += dw0[k] * x0; a1[o] += dw1[k] * x1; } }
            __builtin_amdgcn_sched_barrier(0); }
        LAS float* rp = red + ((ch & 1) * 2 + th) * 64;
#pragma unroll
        for (int o = 0; o < 8; ++o) { const float s = wave_sum(a0[o] + a1[o]), q = wave_sum(a0[o] * a0[o] + a1[o] * a1[o]); if (F.lane == 0) { rp[(o * 4 + wq) * 2] = s; rp[(o * 4 + wq) * 2 + 1] = q; } }
        __syncthreads();
#pragma unroll
        for (int o = 0; o < 8; ++o) { float s = 0.f, q = 0.f;
#pragma unroll
            for (int k = 0; k < 4; ++k) { s += rp[(o * 4 + k) * 2]; q += rp[(o * 4 + k) * 2 + 1]; }
            const float mean = s * (1.f / 512.f), var = q * (1.f / 512.f) - mean * mean, rstd = 1.0f / sqrtf(var + EPS);
            const float y0 = (a0[o] - mean) * rstd * lg0 + lb0, y1 = (a1[o] - mean) * rstd * lg1 + lb1;
            *(GAS unsigned*)(CA + (size_t)(tok0 + rbase + o) * 512 + 2 * cp) = pk2(y0 * sigm(y0), y1 * sigm(y1)); }
    }
    __syncthreads();
}
__device__ __forceinline__ void router_phase(Frame& F) {
    const int fr = F.lane & 15, fq = F.lane >> 4, tl = F.wave & 3, kh = F.wave >> 2;
    const bf16* XB = (const bf16*)(F.ws + WS_B); float* R2 = (float*)(F.ws + WS_R2);
    const bf16* WRT = (const bf16*)(F.ws + WS_WRT); int* ltok = (int*)(F.ws + WS_LTOK); int* tinfo = (int*)(F.ws + WS_TINFO);
    LAS float* part = (LAS float*)(F.lds + 32768);
    LAS float* lg = (LAS float*)(F.lds + tl * 4096);
    LAS unsigned* lcnt = (LAS unsigned*)(F.lds + 49152);
    LAS unsigned* lbase = lcnt + 32;
    LAS unsigned* dec = lcnt + 64;
    if (F.tid < NEXP) lcnt[F.tid] = 0u;
    __syncthreads();
    for (int tg = F.vcu; tg < NTOK / 64; tg += F.G) {
        const int tile = tg * 4 + tl, tok = tile * 16 + fr;
        const bf16* xr = XB + (size_t)tok * D + 512 * kh + 8 * fq; const bf16* wh = WRT + (size_t)fr * D + 512 * kh + 8 * fq;
        f32x4 acc[3]; float ss = 0.f;
#pragma unroll
        for (int n = 0; n < 3; ++n) acc[n] = (f32x4){0.f, 0.f, 0.f, 0.f};
#pragma unroll 4
        for (int s = 0; s < 16; ++s) {
            const v4u h = *(const GAS v4u*)(xr + 32 * s);
            const float a0 = bflo(h.x), a1 = bfhi(h.x), a2 = bflo(h.y), a3 = bfhi(h.y), a4 = bflo(h.z), a5 = bfhi(h.z), a6 = bflo(h.w), a7 = bfhi(h.w);
            ss += (a0 * a0 + a1 * a1) + (a2 * a2 + a3 * a3) + (a4 * a4 + a5 * a5) + (a6 * a6 + a7 * a7);
            const bf16x8 xh = __builtin_bit_cast(bf16x8, h);
#pragma unroll
            for (int n = 0; n < 3; ++n) { const bf16x8 whi = *(const GAS bf16x8*)(wh + (size_t)n * 16 * D + 32 * s), wlo = *(const GAS bf16x8*)(wh + (size_t)(48 + n * 16) * D + 32 * s);
                acc[n] = __builtin_amdgcn_mfma_f32_16x16x32_bf16(whi, xh, acc[n], 0, 0, 0); acc[n] = __builtin_amdgcn_mfma_f32_16x16x32_bf16(wlo, xh, acc[n], 0, 0, 0); }
        }
        ss += __shfl_xor(ss, 16); ss += __shfl_xor(ss, 32);
        if (kh == 1) { LAS float* pp = part + (tl * 64 + F.lane) * 13;
#pragma unroll
            for (int n = 0; n < 3; ++n)
#pragma unroll
                for (int j = 0; j < 4; ++j) pp[4 * n + j] = acc[n][j];
            pp[12] = ss; }
        __syncthreads();
        if (kh == 0) {
            const LAS float* pp = part + (tl * 64 + F.lane) * 13;
            ss += pp[12];
            const float r = 1.0f / sqrtf(ss * (1.f / D) + EPS);
            if (fq == 0) R2[tok] = r;
#pragma unroll
            for (int n = 0; n < 3; ++n)
#pragma unroll
                for (int j = 0; j < 4; ++j) { const int o = 16 * n + 4 * fq + j; if (o < 36) { const float bias = o < 4 ? F.in[I_BRG][o] : F.in[I_BRE2][o - 4]; lg[fr * 49 + o] = (acc[n][j] + pp[4 * n + j]) * r + bias; } }
            LDS_WAIT(); asm volatile("" ::: "memory");
            if (F.lane < 16) {
                const LAS float* l = lg + F.lane * 49;
                float gm = l[0]; int gs = 0;
#pragma unroll
                for (int i = 1; i < 4; ++i) if (l[i] > gm) { gm = l[i]; gs = i; }
                float den = 0.f;
#pragma unroll
                for (int i = 0; i < 4; ++i) den += __expf(l[i] - gm);
                const float pg = 1.0f / den;
                const LAS float* el = l + 4 + 8 * gs;
                float v1 = el[0]; int j1 = 0;
#pragma unroll
                for (int i = 1; i < 8; ++i) if (el[i] > v1) { v1 = el[i]; j1 = i; }
                float v2 = -3.0e38f; int j2 = 0;
#pragma unroll
                for (int i = 0; i < 8; ++i) if (i != j1 && el[i] > v2) { v2 = el[i]; j2 = i; }
                const float w1 = pg / (1.0f + __expf(v2 - v1)), w2 = pg - w1;
                const int e1 = gs * 8 + j1, e2 = gs * 8 + j2;
                const unsigned s1 = __hip_atomic_fetch_add(lcnt + e1, 1u, __ATOMIC_RELAXED, __HIP_MEMORY_SCOPE_WORKGROUP), s2 = __hip_atomic_fetch_add(lcnt + e2, 1u, __ATOMIC_RELAXED, __HIP_MEMORY_SCOPE_WORKGROUP);
                LAS unsigned* dd = dec + (tl * 16 + F.lane) * 6; dd[0] = (unsigned)e1; dd[1] = s1; dd[2] = (unsigned)e2; dd[3] = s2; dd[4] = __builtin_bit_cast(unsigned, w1); dd[5] = __builtin_bit_cast(unsigned, w2);
            }
        }
        __syncthreads();
        if (F.tid < NEXP) { const unsigned c = lcnt[F.tid]; lbase[F.tid] = c ? __hip_atomic_fetch_add((unsigned*)(F.ctl + CW_ECNT + 64 * F.tid), c, RLX_AGENT) : 0u; lcnt[F.tid] = 0u; }
        __syncthreads();
        if (F.tid < 64) { const LAS unsigned* dd = dec + F.tid * 6; const int token = tg * 64 + F.tid; const int e1 = (int)dd[0], e2 = (int)dd[2]; const int s1 = (int)(lbase[e1] + dd[1]), s2 = (int)(lbase[e2] + dd[3]);
            ltok[e1 * NTOK + s1] = token; ltok[e2 * NTOK + s2] = token;
            typedef int i32x4 __attribute__((ext_vector_type(4))); *(GAS i32x4*)(tinfo + 4 * token) = (i32x4){e1 * NTOK + s1, e2 * NTOK + s2, (int)dd[4], (int)dd[5]}; }
        __syncthreads();
    }
}
__device__ __forceinline__ void rows_to_bf16(Frame& F, const float* X, bf16* XB, float* RR) {
    const int gw = F.vcu * NWAVES + F.wave, NGW = F.G * NWAVES;
    for (int m = gw; m < NTOK; m += NGW) {
        const GAS f32x4* xr = (const GAS f32x4*)(X + (size_t)m * D) + F.lane; f32x4 v[4]; float s = 0.f;
#pragma unroll
        for (int j = 0; j < 4; ++j) { v[j] = xr[64 * j]; s += (v[j].x * v[j].x + v[j].y * v[j].y) + (v[j].z * v[j].z + v[j].w * v[j].w); }
        const float r = 1.0f / sqrtf(wave_sum(s) * (1.f / D) + EPS);
        if (F.lane == 0) RR[m] = r;
        GAS v2u* o8 = (GAS v2u*)(XB + (size_t)m * D) + F.lane;
#pragma unroll
        for (int j = 0; j < 4; ++j) { v2u o; o.x = pk2(v[j].x, v[j].y); o.y = pk2(v[j].z, v[j].w); o8[64 * j] = o; }
    }
}
__device__ __forceinline__ void moe_combine_rows(Frame& F, const bf16* __restrict__ XB, const bf16* __restrict__ Y, bf16* __restrict__ XO, float* __restrict__ RR) {
    const int gw = F.vcu * NWAVES + F.wave, NGW = F.G * NWAVES; const LAS int* cs = (const LAS int*)(F.lds + TB_OFF) + 66; const int* tinfo = (const int*)(F.ws + WS_TINFO);
    for (int m = gw; m < NTOK; m += NGW) {
        typedef int i32x4 __attribute__((ext_vector_type(4))); const i32x4 ti = *(const GAS i32x4*)(tinfo + 4 * m);
        const int r1 = cs[ti.x >> 14] + (ti.x & (NTOK - 1)), r2 = cs[ti.y >> 14] + (ti.y & (NTOK - 1)); const int wz = ti.z, ww = ti.w; const float w1 = __builtin_bit_cast(float, wz), w2 = __builtin_bit_cast(float, ww);
        const GAS v4u* xr = (const GAS v4u*)(XB + (size_t)m * D) + F.lane; GAS v4u* xo = (GAS v4u*)(XO + (size_t)m * D) + F.lane; const GAS v4u* y1 = (const GAS v4u*)(Y + (size_t)r1 * D) + F.lane; const GAS v4u* y2 = (const GAS v4u*)(Y + (size_t)r2 * D) + F.lane;
        v4u o[2]; float s = 0.f;
#pragma unroll
        for (int j = 0; j < 2; ++j) { const v4u x = xr[64 * j], a = y1[64 * j], b = y2[64 * j]; float v[8];
            v[0] = bflo(x.x) + w1 * bflo(a.x) + w2 * bflo(b.x); v[1] = bfhi(x.x) + w1 * bfhi(a.x) + w2 * bfhi(b.x); v[2] = bflo(x.y) + w1 * bflo(a.y) + w2 * bflo(b.y); v[3] = bfhi(x.y) + w1 * bfhi(a.y) + w2 * bfhi(b.y);
            v[4] = bflo(x.z) + w1 * bflo(a.z) + w2 * bflo(b.z); v[5] = bfhi(x.z) + w1 * bfhi(a.z) + w2 * bfhi(b.z); v[6] = bflo(x.w) + w1 * bflo(a.w) + w2 * bflo(b.w); v[7] = bfhi(x.w) + w1 * bfhi(a.w) + w2 * bfhi(b.w);
            o[j].x = pk2(v[0], v[1]); o[j].y = pk2(v[2], v[3]); o[j].z = pk2(v[4], v[5]); o[j].w = pk2(v[6], v[7]);
            const float q0 = bflo(o[j].x), q1 = bfhi(o[j].x), q2 = bflo(o[j].y), q3 = bfhi(o[j].y), q4 = bflo(o[j].z), q5 = bfhi(o[j].z), q6 = bflo(o[j].w), q7 = bfhi(o[j].w);
            s += (q0 * q0 + q1 * q1) + (q2 * q2 + q3 * q3) + (q4 * q4 + q5 * q5) + (q6 * q6 + q7 * q7); }
        const float r = 1.0f / sqrtf(wave_sum(s) * (1.f / D) + EPS);
        if (F.lane == 0) RR[m] = r;
#pragma unroll
        for (int j = 0; j < 2; ++j) xo[64 * j] = o[j];
    }
}
__device__ __forceinline__ void final_norm(Frame& F, const bf16* X, float* out, const float* gf) {
    const int gw = F.vcu * NWAVES + F.wave, NGW = F.G * NWAVES;
    f32x4 gv[2][2];
#pragma unroll
    for (int j = 0; j < 2; ++j) { gv[j][0] = *(const f32x4*)(gf + 8 * F.lane + 512 * j); gv[j][1] = *(const f32x4*)(gf + 8 * F.lane + 512 * j + 4); }
    for (int m = gw; m < NTOK; m += NGW) {
        const GAS v4u* xr = (const GAS v4u*)(X + (size_t)m * D) + F.lane; f32x4 v[2][2]; float s = 0.f;
#pragma unroll
        for (int j = 0; j < 2; ++j) { const v4u x = xr[64 * j]; v[j][0] = (f32x4){bflo(x.x), bfhi(x.x), bflo(x.y), bfhi(x.y)}; v[j][1] = (f32x4){bflo(x.z), bfhi(x.z), bflo(x.w), bfhi(x.w)};
            s += (v[j][0].x * v[j][0].x + v[j][0].y * v[j][0].y) + (v[j][0].z * v[j][0].z + v[j][0].w * v[j][0].w) + (v[j][1].x * v[j][1].x + v[j][1].y * v[j][1].y) + (v[j][1].z * v[j][1].z + v[j][1].w * v[j][1].w); }
        const float r = 1.0f / sqrtf(wave_sum(s) * (1.f / D) + EPS);
        GAS f32x4* o = (GAS f32x4*)(out + (size_t)m * D) + 2 * F.lane;
#pragma unroll
        for (int j = 0; j < 2; ++j) { o[128 * j] = v[j][0] * r * gv[j][0]; o[128 * j + 1] = v[j][1] * r * gv[j][1]; }
    }
}
__device__ __forceinline__ void moe_tables(Frame& F) {
    LAS int* tb = (LAS int*)(F.lds + TB_OFF); LAS int* cn = tb + 33; LAS int* cs = cn + 33;
    if (F.tid == 0) { int t = 0, r = 0; for (int e = 0; e < NEXP; ++e) { const int c = (int)__hip_atomic_load((unsigned*)(F.ctl + CW_ECNT + 64 * e), RLX_AGENT); cn[e] = c; tb[e] = t; cs[e] = r; t += (c + 255) >> 8; r += c; } tb[NEXP] = t; cs[NEXP] = r; }
    __syncthreads();
}

struct Args { const float* in[N_IN]; float* out; unsigned char* ws; int ph_lo, ph_hi; };
__global__ void __launch_bounds__(NWAVES * 64, 2) mk_fwd(Args args) {
    extern __shared__ __attribute__((aligned(16))) unsigned char lds[];
    Frame F;
    F.lds = (LAS unsigned char*)lds;
    F.MISC = (volatile LAS unsigned*)(F.lds + MISC_OFF);
    F.tid = threadIdx.x; F.lane = F.tid & 63; F.wave = __builtin_amdgcn_readfirstlane(F.tid >> 6);
    const int wave_s = F.wave;
    F.G = gridDim.x; { const int bx = blockIdx.x; F.vcu = (F.G % 8 == 0) ? (bx % 8) * (F.G / 8) + bx / 8 : bx; }
    F.in = args.in; F.out = args.out; F.ws = args.ws; F.ctl = (gu32*)(args.ws + WS_CTL);
    for (int u = F.tid; u < (LDS_BYTES - LDSCTL_OFF) / 4; u += NWAVES * 64) ((LAS unsigned*)(F.lds + LDSCTL_OFF))[u] = 0u;
    __syncthreads();
    if (N_LAUNCHES != PER_PHASE) (void)xcd_barrier_post((unsigned*)(F.ctl + CW_BAR), F.MISC + 8);
#define GRID_BAR() do { if (N_LAUNCHES == PER_PHASE) { if (F.tid == 0) __hip_atomic_store(F.ctl + CW_TMO, 0xBADBA0u, RLX_AGENT); } else { \
        XcdBarrier bb_; bb_.bar = (unsigned*)(F.ctl + CW_BAR); bb_.x = xb_xcc_id(); bb_.st = (volatile LAS unsigned*)(F.lds + MISC_OFF) + 8; bb_.wv = wave_s; xcd_barrier(bb_); } } while (0)
#define PHASE_BEGIN() do { int l_ = (int)__builtin_amdgcn_mbcnt_hi(~0u, __builtin_amdgcn_mbcnt_lo(~0u, 0u)); asm volatile("" : "+v"(l_)); F.lane = l_; F.wave = wave_s; F.tid = wave_s * 64 + l_; \
        unsigned long long w_ = (unsigned long long)args.ws; asm volatile("" : "+s"(w_)); ws = (unsigned char*)(GAS unsigned char*)w_; F.ws = ws; F.ctl = (gu32*)(ws + WS_CTL); } while (0)
    const int lo = args.ph_lo, hi = args.ph_hi;
#ifndef PHASE_MASK
#define PHASE_MASK 0x1FFF
#endif
#define IN(k) (lo <= (k) && (k) < hi && ((PHASE_MASK >> (k)) & 1))
#define BOTH(k) (IN(k) && IN((k) + 1))
#ifndef REP_MASK
#define REP_MASK 0
#endif
#define REPS(k) (((REP_MASK >> (k)) & 1) ? 2 : 1)
    unsigned char* ws = args.ws;
    const size_t TS1024 = (size_t)256 * 1024 * 2, TS512 = (size_t)256 * 512 * 2, TS256 = (size_t)256 * 256 * 2;

    if (IN(0)) for (int rep_ = 0; rep_ < REPS(0); ++rep_) { PHASE_BEGIN(); p0_prologue(F); if (BOTH(0)) GRID_BAR(); }
    if (IN(1)) for (int rep_ = 0; rep_ < REPS(1); ++rep_) {
        PHASE_BEGIN();
        DenseOrder S; S.init(NTOK, DIN, F.G, (int)blockIdx.x); S.A = (const char*)(ws + WS_B); S.Bt = (const char*)(ws + WS_WIN); S.tstep = TS1024;
        EpiP1 E{(bf16*)(ws + WS_C), (bf16*)(ws + WS_C + 16 * MiB), (bf16*)F.out, F.in[I_BGATE]};
        pg8::gemm_phase<EpiP1, DenseOrder>(F.lds + RING_OFF, F.tid, D, S, E);
        {
            const int nfull = (NTOK / 256) * (DIN / 256) / F.G, heavy = (NTOK / 256) * (DIN / 256) - nfull * F.G;
            const int nl = F.G - heavy; const bool spread = heavy > 0 && 2 * nl >= (NTOK / 256) * (D / 256);
            DenseOrder S2; S2.A = (const char*)(ws + WS_PB); S2.Bt = (const char*)(ws + WS_WPLE); S2.tstep = TS256;
            if (spread) S2.init(NTOK, D, nl, (int)blockIdx.x - heavy); else S2.init(NTOK, D, F.G, (int)blockIdx.x);
            EpiE E2{(bf16*)(ws + WS_E + 32 * MiB)};
            if (!spread || (int)blockIdx.x >= heavy) pg8::gemm_phase<EpiE, DenseOrder>(F.lds + RING_OFF, F.tid, DPLE, S2, E2);
        }
        if (BOTH(1)) GRID_BAR();
    }
    if (IN(2)) for (int rep_ = 0; rep_ < REPS(2); ++rep_) {
        PHASE_BEGIN();
#ifndef NO_SSM
        for (int u = F.vcu; u < 8 * NGRP; u += F.G) { const int x = u / 32, idx = u % 32; ssm_unit(F, idx & 7, 4 * x + (idx >> 3)); }
#endif
#ifndef NO_CONV
        PHASE_BEGIN();
        for (int t = blockIdx.x; t < NTOK / 64; t += F.G) conv_tile(F, t);
#endif
        if (BOTH(2)) GRID_BAR();
    }
    if (IN(3)) for (int rep_ = 0; rep_ < REPS(3); ++rep_) {
        PHASE_BEGIN();
        DenseOrder S; S.init(NTOK, 2 * D, F.G, (int)blockIdx.x); S.A = (const char*)(ws + WS_B); S.Bt = (const char*)(ws + WS_WGLU); S.tstep = TS512;
        EpiGlu E{(bf16*)(ws + WS_E), (const bf16*)F.out};
        pg8::gemm_phase<EpiGlu, DenseOrder>(F.lds + RING_OFF, F.tid, DSSM, S, E);
        if (BOTH(3)) GRID_BAR();
    }
    if (IN(4)) for (int rep_ = 0; rep_ < REPS(4); ++rep_) {
        PHASE_BEGIN();
        DenseOrder S; S.init(NTOK, D, F.G, (int)blockIdx.x); S.A = (const char*)(ws + WS_B + 16 * MiB); S.Bt = (const char*)(ws + WS_WCO); S.tstep = TS512;
        EpiCo E{(const bf16*)(ws + WS_E), (const bf16*)F.out, (bf16*)(ws + WS_C)};
        pg8::gemm_phase<EpiCo, DenseOrder>(F.lds + RING_OFF, F.tid, DCONV, S, E);
        if (BOTH(4)) GRID_BAR();
    }
    if (IN(5)) for (int rep_ = 0; rep_ < REPS(5); ++rep_) {
        PHASE_BEGIN();
        DenseOrder S; S.init(NTOK, D, F.G, (int)blockIdx.x); S.A = (const char*)(ws + WS_C); S.Bt = (const char*)(ws + WS_WO); S.tstep = TS1024;
        EpiRes E{F.in[I_X], (bf16*)(ws + WS_B)};
        pg8::gemm_phase<EpiRes, DenseOrder>(F.lds + RING_OFF, F.tid, D, S, E);
        if (BOTH(5)) GRID_BAR();
    }
    if (IN(6)) for (int rep_ = 0; rep_ < REPS(6); ++rep_) { PHASE_BEGIN(); router_phase(F); if (BOTH(6)) GRID_BAR();
        if (rep_ + 1 < REPS(6)) { if (blockIdx.x == 0 && F.tid < NEXP) __hip_atomic_store((unsigned*)(F.ctl + CW_ECNT + 64 * F.tid), 0u, RLX_AGENT); GRID_BAR(); } }
    if (IN(7)) for (int rep_ = 0; rep_ < REPS(7); ++rep_) {
        PHASE_BEGIN();
        moe_tables(F);
        MoeOrder S; S.tb = (const LAS int*)(F.lds + TB_OFF); S.cn = S.tb + 33; S.G = F.G; S.c = F.vcu; S.K = D; S.npn = 4;
        S.A = (const char*)(ws + WS_B); S.Bt = (const char*)(ws + WS_WGU); S.b_estride = (size_t)D * D * 2; S.ltok = (const int*)(ws + WS_LTOK); S.gather = true;
        EpiAct E{(bf16*)(ws + WS_C), (const int*)(ws + WS_LTOK), (const float*)(ws + WS_R2)};
        pg8::gemm_phase<EpiAct, MoeOrder, true>(F.lds + RING_OFF, F.tid, D, S, E);
        if (BOTH(7)) GRID_BAR();
    }
    if (IN(8)) for (int rep_ = 0; rep_ < REPS(8); ++rep_) {
        PHASE_BEGIN();
        moe_tables(F);
        MoeOrder S; S.tb = (const LAS int*)(F.lds + TB_OFF); S.cn = S.tb + 33; S.G = F.G; S.c = F.vcu; S.K = DEXP; S.npn = 4;
        S.A = (const char*)(ws + WS_C); S.Bt = (const char*)(ws + WS_WD); S.b_estride = (size_t)D * DEXP * 2; S.ltok = (const int*)(ws + WS_LTOK); S.gather = false;
        EpiY E{(bf16*)F.out};
        pg8::gemm_phase<EpiY, MoeOrder, false>(F.lds + RING_OFF, F.tid, DEXP, S, E);
        if (BOTH(8)) GRID_BAR();
    }
    if (IN(9)) for (int rep_ = 0; rep_ < REPS(9); ++rep_) { PHASE_BEGIN(); moe_tables(F); moe_combine_rows(F, (const bf16*)(ws + WS_B), (const bf16*)F.out, (bf16*)(ws + WS_E), (float*)(ws + WS_R3)); if (BOTH(9)) GRID_BAR(); }
#ifdef DBG_SG_COPY
    if (lo <= 10 && 10 < hi) { const int gt = F.vcu * 512 + (int)threadIdx.x, NGT = F.G * 512; const bf16* sgp = (const bf16*)args.out + (size_t)DBG_SG_COPY * NTOK * D; float* dst = (float*)(args.ws + WS_E);
        for (int q = gt; q < NTOK * D; q += NGT) { const float v = bflo((unsigned)sgp[q]); const int col = q & 2047;
#ifdef DBG_SG_SEL_LO
            dst[q] = (v >= 0.f && v <= 1.f) ? 0.f : ((col >= DBG_SG_SEL_LO && col < DBG_SG_SEL_HI) ? 1000.f : 0.f);
#else
            dst[q] = v;
#endif
        } }
#endif
    if (IN(11)) for (int rep_ = 0; rep_ < REPS(11); ++rep_) {
        PHASE_BEGIN();
        DenseOrder S; S.init(NTOK, D, F.G, (int)blockIdx.x); S.A = (const char*)(ws + WS_E); S.Bt = (const char*)(ws + WS_WPG); S.tstep = TS1024;
        EpiPle E{(const bf16*)(ws + WS_E), (const bf16*)(ws + WS_E + 32 * MiB), (const float*)(ws + WS_R3), (bf16*)(ws + WS_C)};
        pg8::gemm_phase<EpiPle, DenseOrder>(F.lds + RING_OFF, F.tid, D, S, E);
        if (BOTH(11)) GRID_BAR();
    }
#ifdef DBG_DUMP_OFF
    if (hi == PER_PHASE) {   PHASE_BEGIN();
        const int gt = F.vcu * 512 + F.tid, NGT = F.G * 512;
#if DBG_DUMP_BF16
        const bf16* src = (const bf16*)(ws + (size_t)DBG_DUMP_OFF);
        for (int q = gt; q < NTOK * D; q += NGT) F.out[q] = bflo((unsigned)src[q]);
#else
        const float* src = (const float*)(ws + (size_t)DBG_DUMP_OFF);
        for (int q = gt; q < NTOK * D; q += NGT) F.out[q] = src[q];
#endif
    }
#else
    if (IN(12)) for (int rep_ = 0; rep_ < REPS(12); ++rep_) { PHASE_BEGIN(); final_norm(F, (const bf16*)(ws + WS_C), F.out, F.in[I_GFIN]); }
#endif
#undef IN
#undef BOTH
}

extern "C" void kernel_launch(void* const* d_in, const int* in_sizes, int n_in, void* d_out, int out_size, void* d_ws, size_t ws_size, hipStream_t stream) {
    static int grid = 0;
    if (grid == 0) {
        if (n_in != N_IN || in_sizes[0] != NTOK * D || out_size != NTOK * D || ws_size < WS_END) { fprintf(stderr, "kernel_launch: unexpected shapes (n_in %d, in0 %d, out %d, ws %zu; need ws >= %zu); nothing launched\n", n_in, n_in > 0 ? in_sizes[0] : -1, out_size, ws_size, (size_t)WS_END); grid = -1; return; }
        int dev = 0, cus = 0, per_cu = 0;
        if (hipGetDevice(&dev) != hipSuccess || hipDeviceGetAttribute(&cus, hipDeviceAttributeMultiprocessorCount, dev) != hipSuccess) { grid = -1; return; }
        if (hipFuncSetAttribute((const void*)mk_fwd, hipFuncAttributeMaxDynamicSharedMemorySize, LDS_BYTES) != hipSuccess) { fprintf(stderr, "kernel_launch: hipFuncSetAttribute failed\n"); grid = -1; return; }
        if (hipOccupancyMaxActiveBlocksPerMultiprocessor(&per_cu, (const void*)mk_fwd, NWAVES * 64, LDS_BYTES) != hipSuccess || per_cu < 1) { fprintf(stderr, "kernel_launch: occupancy query reports %d workgroups per CU\n", per_cu); (void)hipGetLastError(); grid = -1; return; }
        grid = cus;
    }
    if (grid < 0) return;
    if (hipMemsetAsync((char*)d_ws + WS_CTL, 0, CTL_ZERO_BYTES, stream) != hipSuccess) return;
    Args a{};
    for (int i = 0; i < N_IN; ++i) a.in[i] = (const float*)d_in[i];
    a.out = (float*)d_out; a.ws = (unsigned char*)d_ws;
    for (int li = 0; li < N_LAUNCHES; ++li) {
        a.ph_lo = (N_LAUNCHES == PER_PHASE) ? li : 0; a.ph_hi = (N_LAUNCHES == PER_PHASE) ? li + 1 : PER_PHASE;
        hipLaunchKernelGGL(mk_fwd, dim3(grid), dim3(NWAVES * 64), LDS_BYTES, stream, a);
        if (hipPeekAtLastError() != hipSuccess) { fprintf(stderr, "kernel_launch: launch %d failed\n", li); break; }
    }
}
```

```cpp
#include <hip/hip_runtime.h>
#include <cstdio>
#include <cstdint>

namespace pg8 {
#define PG8_LAS __attribute__((address_space(3)))
typedef unsigned short bf16_t;
typedef short bf16x8 __attribute__((ext_vector_type(8)));
typedef float f32x4 __attribute__((ext_vector_type(4)));
typedef unsigned u32x4 __attribute__((ext_vector_type(4)));
typedef unsigned u32x2 __attribute__((ext_vector_type(2)));
constexpr int BM = 256, BK = 64, HALF = 128, HTB = HALF * BK * 2  , STAGE_BYTES = 8 * HTB, NXCD = 8, WGM = 8;

__host__ __device__ __forceinline__ int lds_byte(int r, int c) { const int st = (r >> 4) * 2 + (c >> 5), rr = r & 15, cc = c & 31, ob = rr * 64 + cc * 2; return st * 1024 + (ob ^ (((ob >> 9) & 1) << 5)); }
__host__ __device__ __forceinline__ void stage_rc(int b, int& R, int& C) { const int st = b / 1024, sb = b % 1024, swz = sb ^ (((sb >> 9) & 1) << 5); R = (st >> 1) * 16 + swz / 64; C = (st & 1) * 32 + (swz % 64) / 2; }
__host__ __device__ __forceinline__ int perm32(int rho) { const int n = rho >> 4, i = rho & 15; return 8 * (i >> 2) + 4 * n + (i & 3); }

struct Unit { int pm, pn, e, rows, mt, cb; };

typedef float cvt_f32x2 __attribute__((ext_vector_type(2)));
typedef __bf16 cvt_bf16x2 __attribute__((ext_vector_type(2)));
__device__ __forceinline__ unsigned cvt_pk_bf16(float lo, float hi) { const cvt_f32x2 v = {lo, hi}; const cvt_bf16x2 b = __builtin_convertvector(v, cvt_bf16x2); return __builtin_bit_cast(unsigned, b); }

struct StaticOrder {
    int nM, nN, nwg, G, c;
    __host__ __device__ void init(int M, int N, int G_, int c_) { nM = M / BM; nN = N / BM; nwg = nM * nN; G = G_; c = c_; }
    __host__ __device__ bool next(int i, Unit& u) const {
        const long L = (long)i * G + c; if (L >= nwg) return false;
        int wgid = (int)L; { const int q = nwg / NXCD, r = nwg % NXCD, xcd = wgid % NXCD, off = wgid / NXCD; wgid = (xcd < r ? xcd * (q + 1) : r * (q + 1) + (xcd - r) * q) + off; }
        const int nig = WGM * nN, gid = wgid / nig, fm = gid * WGM, gsz = (nM - fm) < WGM ? (nM - fm) : WGM;
        u.pm = fm + ((wgid % nig) % gsz); u.pn = (wgid % nig) / gsz; u.e = 0; u.rows = BM; u.mt = 0; u.cb = 0; return true;
    }
};

template <class Epi, class Sched, bool GATHER = false, bool ALIGN_EPI = true, bool F8 = false>
__device__ __forceinline__ void gemm_phase(PG8_LAS unsigned char* lds, const int tid, const int K_, const Sched& S, const Epi& E) {
    int K = K_; asm volatile("" : "+s"(K));
    const int wid = __builtin_amdgcn_readfirstlane(tid >> 6), lane = tid & 63, wr = wid >> 2, wc = wid & 3, fr = lane & 15, fq = lane >> 4;
    const int nt = K / BK;
    unsigned voffA[2], voffB[2]; int rowA[2], colA[2];
#pragma unroll
    for (int i = 0; i < 2; ++i) { int R, C; stage_rc(tid * 16 + i * 8192, R, C); const int Rb = (R & ~31) + perm32(R & 31);
        voffA[i] = (unsigned)(R * K + C) * 2u; voffB[i] = (unsigned)(Rb * K + C) * 2u; rowA[i] = R; colA[i] = C * 2; }
    const size_t kstep = (size_t)(BK * 2);
    const unsigned hstep = (unsigned)HALF * (unsigned)K * 2u;
    const unsigned ldsw = (unsigned)wid * 1024u;
    const int aoff = lds_byte(wr * 64 + fr, fq * 8), boff = lds_byte(wc * 32 + fr, fq * 8);
#define PG8_SA(b, h) (((b) * 2 + (h)) * HTB)
#define PG8_SB(b, h) ((4 + (b) * 2 + (h)) * HTB)
#define PG8_STAGE(bufoff, gbase, voff) do { _Pragma("unroll") for (int _i = 0; _i < 2; ++_i) \
        __builtin_amdgcn_global_load_lds((const unsigned*)((const char*)(gbase) + (voff)[_i]), (PG8_LAS unsigned*)(lds + (bufoff) + ldsw + _i * 8192), 16, 0, 0); } while (0)
#define PG8_STAGE_A(bufoff, gbase, V, h) do { _Pragma("unroll") for (int _i = 0; _i < 2; ++_i) { const unsigned _o = GATHER ? (V)[h][_i] : (voffA[_i] + (unsigned)(h) * hstep); \
        __builtin_amdgcn_global_load_lds((const unsigned*)((const char*)(gbase) + _o), (PG8_LAS unsigned*)(lds + (bufoff) + ldsw + _i * 8192), 16, 0, 0); } } while (0)
#define PG8_LDA(dst, b, h) do { _Pragma("unroll") for (int m = 0; m < 4; ++m) _Pragma("unroll") for (int k = 0; k < 2; ++k) dst[m][k] = *(const PG8_LAS bf16x8*)(lds + PG8_SA(b, h) + aoff + m * 2048 + k * 1024); } while (0)
#define PG8_LDB(dst, b, h) do { _Pragma("unroll") for (int n = 0; n < 2; ++n) _Pragma("unroll") for (int k = 0; k < 2; ++k) dst[n][k] = *(const PG8_LAS bf16x8*)(lds + PG8_SB(b, h) + boff + n * 2048 + k * 1024); } while (0)
#define PG8_MMA(ai, bj, At, Bt) do { __builtin_amdgcn_s_setprio(1); _Pragma("unroll") for (int m = 0; m < 4; ++m) _Pragma("unroll") for (int n = 0; n < 2; ++n) { \
        if constexpr (F8) { typedef int v4i_ __attribute__((ext_vector_type(4))); typedef int v8i_ __attribute__((ext_vector_type(8))); \
            const v8i_ fa_ = __builtin_shufflevector(__builtin_bit_cast(v4i_, Bt[n][0]), __builtin_bit_cast(v4i_, Bt[n][1]), 0, 1, 2, 3, 4, 5, 6, 7), fb_ = __builtin_shufflevector(__builtin_bit_cast(v4i_, At[m][0]), __builtin_bit_cast(v4i_, At[m][1]), 0, 1, 2, 3, 4, 5, 6, 7); \
            acc[ai][bj][m][n] = __builtin_amdgcn_mfma_scale_f32_16x16x128_f8f6f4(fa_, fb_, acc[ai][bj][m][n], 0, 0, 0, 0x7f7f7f7f, 0, 0x7f7f7f7f); } \
        else { _Pragma("unroll") for (int k = 0; k < 2; ++k) acc[ai][bj][m][n] = __builtin_amdgcn_mfma_f32_16x16x32_bf16(Bt[n][k], At[m][k], acc[ai][bj][m][n], 0, 0, 0); } } __builtin_amdgcn_s_setprio(0); } while (0)
#define PG8_WAIT_V(n) asm volatile("s_waitcnt vmcnt(" #n ")" ::: "memory")
#define PG8_WAIT_L(n) asm volatile("s_waitcnt lgkmcnt(" #n ")" ::: "memory")
#define PG8_BAR __builtin_amdgcn_s_barrier()
#define PG8_SCHED __builtin_amdgcn_sched_barrier(0)
    Unit cur, nxt; int ui = 0;
    if (!S.next(0, cur)) return;
    f32x4 acc[2][2][4][2];
#pragma unroll
    for (int a = 0; a < 2; ++a)
#pragma unroll
        for (int b = 0; b < 2; ++b)
#pragma unroll
            for (int m = 0; m < 4; ++m)
#pragma unroll
                for (int n = 0; n < 2; ++n) acc[a][b][m][n] = (f32x4){0.f, 0.f, 0.f, 0.f};
    bf16x8 At[4][2], B0[2][2], B1[2][2];
    unsigned cva[2][2] = {{0u, 0u}, {0u, 0u}}, nva[2][2] = {{0u, 0u}, {0u, 0u}};
    const char* cA = S.a_base(cur); const char* cB = S.b_base(cur);
    if constexpr (GATHER) {
#pragma unroll
        for (int h = 0; h < 2; ++h)
#pragma unroll
            for (int i = 0; i < 2; ++i) cva[h][i] = S.row_off(cur, h * HALF + rowA[i]) + (unsigned)colA[i];
    }
    PG8_STAGE(PG8_SB(0, 0), cB, voffB); PG8_STAGE(PG8_SB(0, 1), cB + hstep, voffB); PG8_STAGE_A(PG8_SA(0, 0), cA, cva, 0); PG8_STAGE_A(PG8_SA(0, 1), cA, cva, 1);
    if (wr == 1) PG8_BAR;
    PG8_WAIT_V(2); PG8_BAR;
    PG8_STAGE(PG8_SB(1, 0), cB + kstep, voffB); PG8_STAGE_A(PG8_SA(1, 0), cA + kstep, cva, 0); PG8_STAGE(PG8_SB(1, 1), cB + hstep + kstep, voffB);
    PG8_WAIT_V(6); PG8_BAR;
    for (;;) {
        const bool has_next = S.next(ui + 1, nxt);
        const char* nA = has_next ? S.a_base(nxt) : cA; const char* nB = has_next ? S.b_base(nxt) : cB;
        if constexpr (GATHER) {
#pragma unroll
            for (int h = 0; h < 2; ++h)
#pragma unroll
                for (int i = 0; i < 2; ++i) nva[h][i] = has_next ? (S.row_off(nxt, h * HALF + rowA[i]) + (unsigned)colA[i]) : cva[h][i];
        }
#pragma unroll 1
        for (int t = 0; t < nt; t += 2) {
            const bool last = (t == nt - 2);
            asm volatile("" : "+v"(voffA[0]), "+v"(voffA[1]), "+v"(voffB[0]), "+v"(voffB[1]));
            const char* a1 = cA + (size_t)(t + 1) * kstep;
            const char* a2 = last ? nA : cA + (size_t)(t + 2) * kstep; const char* b2 = last ? nB : cB + (size_t)(t + 2) * kstep;
            const char* a3 = a2 + kstep; const char* b3 = b2 + kstep;
            PG8_LDB(B0, 0, 0); PG8_LDB(B1, 0, 1); PG8_SCHED; PG8_LDA(At, 0, 0); PG8_STAGE_A(PG8_SA(1, 1), a1, cva, 1);
            if constexpr (GATHER) { if (last) {
#pragma unroll
                for (int h = 0; h < 2; ++h)
#pragma unroll
                    for (int i = 0; i < 2; ++i) cva[h][i] = nva[h][i]; } }
            PG8_WAIT_V(8); PG8_WAIT_L(0); PG8_BAR; PG8_MMA(0, 0, At, B0); PG8_MMA(0, 1, At, B1); PG8_BAR; PG8_SCHED;
            PG8_LDA(At, 0, 1); PG8_STAGE(PG8_SB(0, 0), b2, voffB); PG8_STAGE(PG8_SB(0, 1), b2 + hstep, voffB); PG8_STAGE_A(PG8_SA(0, 0), a2, cva, 0);
            PG8_WAIT_V(8); PG8_WAIT_L(0); PG8_BAR; PG8_MMA(1, 0, At, B0); PG8_MMA(1, 1, At, B1); PG8_BAR; PG8_SCHED;
            PG8_LDB(B0, 1, 0); PG8_LDB(B1, 1, 1); PG8_SCHED; PG8_LDA(At, 1, 0); PG8_STAGE_A(PG8_SA(0, 1), a2, cva, 1);
            PG8_WAIT_V(8); PG8_WAIT_L(0); PG8_BAR; PG8_MMA(0, 0, At, B0); PG8_MMA(0, 1, At, B1); PG8_BAR; PG8_SCHED;
            PG8_LDA(At, 1, 1); PG8_STAGE(PG8_SB(1, 0), b3, voffB); PG8_STAGE(PG8_SB(1, 1), b3 + hstep, voffB); PG8_STAGE_A(PG8_SA(1, 0), a3, cva, 0);
            PG8_WAIT_V(8); PG8_WAIT_L(0); PG8_BAR; PG8_MMA(1, 0, At, B0); PG8_MMA(1, 1, At, B1); PG8_BAR; PG8_SCHED;
        }
        if constexpr (ALIGN_EPI) { if (wr == 0) PG8_BAR; }
#ifdef DBG_EPI_NOP
        asm volatile("s_nop 15\n s_nop 15\n s_nop 15\n s_nop 15" ::: "memory");
#endif
        { int le_ = lane; asm volatile("" : "+v"(le_));
          E(acc, cur, wr, wc, le_ & 15, le_ >> 4); }
        if (!has_next) break;
#pragma unroll
        for (int a = 0; a < 2; ++a)
#pragma unroll
            for (int b = 0; b < 2; ++b)
#pragma unroll
                for (int m = 0; m < 4; ++m)
#pragma unroll
                    for (int n = 0; n < 2; ++n) acc[a][b][m][n] = (f32x4){0.f, 0.f, 0.f, 0.f};
        cur = nxt; cA = nA; cB = nB; ++ui;
        if constexpr (ALIGN_EPI) { if (wr == 1) PG8_BAR; }
    }
    PG8_WAIT_V(0);
    if constexpr (!ALIGN_EPI) { if (wr == 0) PG8_BAR; }
    PG8_BAR;
#undef PG8_SA
#undef PG8_SB
#undef PG8_STAGE
#undef PG8_STAGE_A
#undef PG8_LDA
#undef PG8_LDB
#undef PG8_MMA
#undef PG8_WAIT_V
#undef PG8_WAIT_L
#undef PG8_BAR
#undef PG8_SCHED
}
}

constexpr int NWAVES = 8;
#ifndef MK_N_LAUNCHES
#define MK_N_LAUNCHES 1
#endif
constexpr int PER_PHASE = 13;
constexpr int N_LAUNCHES = MK_N_LAUNCHES;

constexpr int NTOK = 16384, SEQ = 2048, D = 1024, DIN = 3584, DSSM = 512, DCONV = 512, NGRP = 32, NST = 64, GWID = 16, CONVW = 31;
constexpr int NEXP = 32, EPG = 8, DEXP = 512, DPLE = 256, LC = 32, NCH = 64;
constexpr float EPS = 1e-6f;
enum In { I_X = 0, I_P, I_GMIX, I_WIN, I_BGATE, I_ARE, I_AIM, I_LOGDT, I_BRE, I_BIM, I_CRE, I_CIM, I_SD, I_WGLU, I_CDW, I_CDWB, I_CLNG, I_CLNB, I_WCO, I_WOUT, I_GMOE, I_WRG, I_BRG, I_WRE, I_BRE2,
          I_WEG, I_WEU, I_WED, I_GPLE, I_WPG, I_WPLE, I_GFIN, N_IN };

constexpr size_t MiB = 1u << 20;
constexpr size_t WS_CTL = 0, CTL_ZERO_BYTES = 1 * MiB;
constexpr size_t WS_LTOK = 1 * MiB;
constexpr size_t WS_TINFO = 3 * MiB;
constexpr size_t WS_R2 = 5 * MiB, WS_R3 = WS_R2 + 65536, WS_LAM32 = WS_R3 + 65536, WS_WRT = WS_R2 + 262144;
constexpr size_t WS_WST = 6 * MiB;
constexpr size_t WS_BT2 = 10 * MiB;
constexpr size_t WS_WIN = 31 * MiB, WS_WGLU = 38 * MiB, WS_WCO = 40 * MiB, WS_WO = 41 * MiB, WS_WPG = 43 * MiB, WS_WPLE = 45 * MiB;
constexpr size_t WS_PB = 46 * MiB;
constexpr size_t WS_WGU = 54 * MiB;
constexpr size_t WS_X2F = 86 * MiB;
constexpr size_t WS_WD = 118 * MiB;
constexpr float W8S = 64.0f, W8I = 1.0f / 64.0f;
constexpr size_t WS_B = 150 * MiB;
constexpr size_t WS_C = 182 * MiB;
constexpr size_t WS_E = 224 * MiB;
constexpr size_t WS_END = 288 * MiB;
constexpr int CW_TMO = 0, CW_CODE = 1, CW_BAR = 4096, CW_ECNT = 16384;
static_assert((CW_ECNT + 64 * NEXP) * 4 <= (int)CTL_ZERO_BYTES, "CTL words inside the memset region");

constexpr int RING_OFF = 0, RING_BYTES = 131072;
constexpr int LDSCTL_OFF = RING_BYTES, MISC_OFF = LDSCTL_OFF + 320;
constexpr int TB_OFF = LDSCTL_OFF + 1024;
constexpr int LDS_BYTES = 147456;
static_assert(TB_OFF + 100 * 4 <= LDS_BYTES, "LDS map");

#define GAS __attribute__((address_space(1)))
#define LAS __attribute__((address_space(3)))
typedef unsigned short bf16;
typedef unsigned v4u __attribute__((ext_vector_type(4)));
typedef unsigned v2u __attribute__((ext_vector_type(2)));
typedef float f32x4 __attribute__((ext_vector_type(4)));
typedef short bf16x8 __attribute__((ext_vector_type(8)));
typedef GAS unsigned gu32;
#define RLX_AGENT __ATOMIC_RELAXED, __HIP_MEMORY_SCOPE_AGENT
#define LDS_WAIT() asm volatile("s_waitcnt lgkmcnt(0)" ::: "memory")
#define VM_WAIT() asm volatile("s_waitcnt vmcnt(0)" ::: "memory")
__device__ __forceinline__ unsigned f2bf(float f) { unsigned u = __builtin_bit_cast(unsigned, f); return (u + 0x7fffu + ((u >> 16) & 1u)) >> 16; }
__device__ __forceinline__ unsigned pk2(float lo, float hi) { return pg8::cvt_pk_bf16(lo, hi); }
__device__ __forceinline__ unsigned pk4f8(float a, float b, float c, float d) { int w = __builtin_amdgcn_cvt_pk_fp8_f32(a, b, 0, false); w = __builtin_amdgcn_cvt_pk_fp8_f32(c, d, w, true); return (unsigned)w; }
__device__ __forceinline__ float bflo(unsigned v) { return __builtin_bit_cast(float, v << 16); }
__device__ __forceinline__ float bfhi(unsigned v) { return __builtin_bit_cast(float, v & 0xffff0000u); }
__device__ __forceinline__ float sigm(float x) { return __builtin_amdgcn_rcpf(1.0f + __expf(-x)); }
__device__ __forceinline__ float gelu_tanh(float y) { const float t = 1.5957691216f * (y + 0.044715f * y * y * y); return y * sigm(t); }

#define XB_TMO      128
#define XB_XCNT(j)  (256  + 64 * (j))
#define XB_XSUB(j)  (1280 + 64 * (j))
#define XB_XGEN(j)  (2304 + 64 * (j))
#define XB_TOP      3328
#define XB_TOPGEN   3392
#define XCD_BAR_WORDS 3456
#define XB_SPIN_CAP (1u << 18)

__device__ __forceinline__ unsigned xb_ld(unsigned* p)              { return __hip_atomic_load(p, __ATOMIC_RELAXED, __HIP_MEMORY_SCOPE_AGENT); }
__device__ __forceinline__ unsigned xb_add(unsigned* p, unsigned v) { return __hip_atomic_fetch_add(p, v, __ATOMIC_RELAXED, __HIP_MEMORY_SCOPE_AGENT); }
__device__ __forceinline__ unsigned xb_xcc_id() { return (unsigned)__builtin_amdgcn_s_getreg((3 << 11) | 20) & 0xFu; }
#define XB_SPIN(cond, bar) do { unsigned _sp = 0; while (cond) { __builtin_amdgcn_s_sleep(1); \
    if ((++_sp & 255u) == 0u) { if (xb_ld(&(bar)[XB_TMO])) break; if (_sp > XB_SPIN_CAP) { atomicAdd(&(bar)[XB_TMO], 1u); break; } } } } while (0)

struct XcdBarrier {
    unsigned* bar; unsigned x;
    volatile LAS unsigned* st;
    int wv;
};

__device__ __forceinline__ XcdBarrier xcd_barrier_post(unsigned* bar, volatile LAS unsigned* st) {
    XcdBarrier b; b.bar = bar; b.x = xb_xcc_id(); b.st = st; b.wv = 0;
    if (threadIdx.x == 0) (void)xb_add(&bar[XB_XCNT(b.x)], 1u);
    return b;
}
__device__ __forceinline__ void xcd_barrier_complete(unsigned* bar, unsigned x, unsigned& nloc, unsigned& nx) {
    const unsigned G = gridDim.x * gridDim.y * gridDim.z;
    unsigned sum, cnt, mine, sp = 0u;
    for (;;) {
        sum = 0u; cnt = 0u; mine = 0u;
#pragma unroll
        for (unsigned j = 0; j < 16; ++j) { const unsigned c = xb_ld(&bar[XB_XCNT(j)]); sum += c; cnt += (c > 0u) ? 1u : 0u; mine = (j == x) ? c : mine; }
        if (sum == G) break;
        __builtin_amdgcn_s_sleep(1);
        if ((++sp & 255u) == 0u) { if (xb_ld(&bar[XB_TMO])) break; if (sp > XB_SPIN_CAP) { atomicAdd(&bar[XB_TMO], 1u); break; } }
    }
    nloc = mine > 0u ? mine : 1u; nx = cnt > 0u ? cnt : 1u;
}

__device__ __forceinline__ void xcd_barrier(const XcdBarrier& b) {
    asm volatile("s_waitcnt vmcnt(0)" ::: "memory");
    __syncthreads();
    if (b.wv == 0 && __builtin_amdgcn_mbcnt_hi(~0u, __builtin_amdgcn_mbcnt_lo(~0u, 0u)) == 0u) {
        unsigned* bar = b.bar;
        __builtin_amdgcn_s_waitcnt(0);
        unsigned nloc = b.st[0], nx = b.st[1];
        if (nloc == 0u) { xcd_barrier_complete(bar, b.x, nloc, nx); b.st[0] = nloc; b.st[1] = nx; }
        const unsigned old = xb_add(&bar[XB_XSUB(b.x)], 1u);
        const unsigned gen = old / nloc;
        if (old + 1u == (gen + 1u) * nloc) {
            __builtin_amdgcn_fence(__ATOMIC_RELEASE, "agent");
            asm volatile("s_waitcnt vmcnt(0)" ::: "memory");
            const unsigned og = xb_add(&bar[XB_TOP], 1u);
            const unsigned tg = og / nx;
            if (og + 1u == (tg + 1u) * nx) xb_add(&bar[XB_TOPGEN], 1u);
            else XB_SPIN(xb_ld(&bar[XB_TOPGEN]) == tg, bar);
            __builtin_amdgcn_fence(__ATOMIC_ACQUIRE, "agent");
            xb_add(&bar[XB_XGEN(b.x)], 1u);
            asm volatile("s_waitcnt vmcnt(0)" ::: "memory");
        } else {
            XB_SPIN(xb_ld(&bar[XB_XGEN(b.x)]) == gen, bar);
            __builtin_amdgcn_fence(__ATOMIC_ACQUIRE, "agent");
            asm volatile("s_waitcnt vmcnt(0)" ::: "memory");
        }
    }
    __syncthreads();
}

struct Frame {
    LAS unsigned char* lds;
    volatile LAS unsigned* MISC;
    gu32* ctl;
    int tid, lane, wave;
    int vcu, G;
    const float* const* in;
    float* out; unsigned char* ws;
};
__device__ __forceinline__ float wave_sum(float v) {
#pragma unroll
    for (int o = 1; o < 64; o <<= 1) v += __shfl_xor(v, o);
    return v;
}

__device__ __forceinline__ int map_glu(int base, int o, int gate) { return base + 8 * (o >> 2) + 4 * gate + (o & 3); }
__device__ __forceinline__ int dest_row(int mode, int n, int half) {
    if (mode == 0) return n;
    if (mode == 1) { if (n < 512) return n; if (n < 1024) return map_glu(512, n - 512, 0); if (n < 1536) return map_glu(512, n - 1024, 1); return n; }
    if (mode == 2) return n < half ? map_glu(0, n, 0) : map_glu(0, n - half, 1);
    if (mode == 3) return map_glu(0, n, 0);
    return map_glu(0, n, 1);
}
__device__ __forceinline__ void tr_item(const float* W, int K, int N, bf16* WT, int mode, int half, const float* ks, LAS unsigned* T, int item, int lane) {
    const int nblk = N / 64, kb = item / nblk, nb = item % nblk, k0 = 64 * kb, n0 = 64 * nb, nq = lane & 15, kq = lane >> 4;
    f32x4 v[8][2];
    const float* src = W + (size_t)(k0 + 2 * kq) * N + n0 + 4 * nq;
#pragma unroll
    for (int s = 0; s < 8; ++s) { v[s][0] = *(const GAS f32x4*)(src + (size_t)(8 * s) * N); v[s][1] = *(const GAS f32x4*)(src + (size_t)(8 * s + 1) * N); }
    if (ks) {
#pragma unroll
        for (int s = 0; s < 8; ++s) { const float a = ks[k0 + 8 * s + 2 * kq], b = ks[k0 + 8 * s + 2 * kq + 1]; v[s][0] *= a; v[s][1] *= b; } }
#pragma unroll
    for (int s = 0; s < 8; ++s)
#pragma unroll
        for (int jj = 0; jj < 4; ++jj) T[(4 * nq + jj) * 33 + 4 * s + kq] = pk2(v[s][0][jj], v[s][1][jj]);
    LDS_WAIT(); asm volatile("" ::: "memory");
    const int c = lane & 7;
#pragma unroll
    for (int i = 0; i < 8; ++i) { const int n = (lane >> 3) + 8 * i; const LAS unsigned* t = T + n * 33 + 4 * c;
        v4u o; o.x = t[0]; o.y = t[1]; o.z = t[2]; o.w = t[3];
        *(GAS v4u*)(WT + (size_t)dest_row(mode, n0 + n, half) * K + k0 + 8 * c) = o; }
    LDS_WAIT(); asm volatile("" ::: "memory");
}
__device__ __forceinline__ void tr_item8(const float* W, int K, int N, unsigned char* WT, int mode, int half, const float* ks, float sc, LAS unsigned* T, int item, int lane) {
    const int nblk = N / 64, kb = item / nblk, nb = item % nblk, k0 = 64 * kb, n0 = 64 * nb, nq = lane & 15, kq = lane >> 4;
    f32x4 v[4][4];
    const float* src = W + (size_t)(k0 + 4 * kq) * N + n0 + 4 * nq;
#pragma unroll
    for (int s = 0; s < 4; ++s)
#pragma unroll
        for (int r = 0; r < 4; ++r) v[s][r] = *(const GAS f32x4*)(src + (size_t)(16 * s + r) * N);
#pragma unroll
    for (int s = 0; s < 4; ++s)
#pragma unroll
        for (int r = 0; r < 4; ++r) v[s][r] *= ks ? ks[k0 + 16 * s + 4 * kq + r] * sc : sc;
#pragma unroll
    for (int s = 0; s < 4; ++s)
#pragma unroll
        for (int jj = 0; jj < 4; ++jj) T[(4 * nq + jj) * 17 + 4 * s + kq] = pk4f8(v[s][0][jj], v[s][1][jj], v[s][2][jj], v[s][3][jj]);
    LDS_WAIT(); asm volatile("" ::: "memory");
    const int c = lane & 3;
#pragma unroll
    for (int i = 0; i < 4; ++i) { const int n = (lane >> 2) + 16 * i; const LAS unsigned* t = T + n * 17 + 4 * c;
        v4u o; o.x = t[0]; o.y = t[1]; o.z = t[2]; o.w = t[3];
        *(GAS v4u*)(WT + (size_t)dest_row(mode, n0 + n, half) * K + k0 + 16 * c) = o; }
    LDS_WAIT(); asm volatile("" ::: "memory");
}
__device__ __forceinline__ void ssm_tables(Frame& F, int g) {
    LAS float* LP = (LAS float*)F.lds;
    LAS float* BB = LP + 33 * 64 * 2;
    LAS float* CC = BB + 2048;
    LAS float* KT = CC + 2048;
    const float* a_re = F.in[I_ARE]; const float* a_im = F.in[I_AIM]; const float* b_re = F.in[I_BRE]; const float* b_im = F.in[I_BIM];
    const float* c_re = F.in[I_CRE]; const float* c_im = F.in[I_CIM]; const float* sd = F.in[I_SD];
    {   const int n = F.tid & 63, tq = F.tid >> 6; const float dt = expf(F.in[I_LOGDT][g]); const float ar = a_re[g * 64 + n], ai = a_im[g * 64 + n]; const float bm = ar * dt, ba = ai * dt;
        for (int tau = tq; tau <= 32; tau += 8) { const float mag = expf(bm * (float)tau); float sn, cs; sincosf(ba * (float)tau, &sn, &cs); LP[(tau * 64 + n) * 2] = mag * cs; LP[(tau * 64 + n) * 2 + 1] = mag * sn; }
        const float mag = expf(bm); float sn, cs; sincosf(ba, &sn, &cs); const float lr = mag * cs, li = mag * sn;
        const float den = ar * ar + ai * ai, nr = lr - 1.0f, ni = li; const float zr = (nr * ar + ni * ai) / den, zi = (ni * ar - nr * ai) / den;
#pragma unroll
        for (int k = 0; k < 2; ++k) { const int ch = 2 * tq + k; const float br = b_re[(g * 64 + n) * 16 + ch], bi = b_im[(g * 64 + n) * 16 + ch];
            BB[(n * 16 + ch) * 2] = zr * br - zi * bi; BB[(n * 16 + ch) * 2 + 1] = zr * bi + zi * br; } }
    for (int e = F.tid; e < 1024; e += 512) { CC[e * 2] = c_re[g * 1024 + e]; CC[e * 2 + 1] = c_im[g * 1024 + e]; }
    __syncthreads();
    if (F.tid < 64) { float* l32 = (float*)(F.ws + WS_LAM32); l32[(g * 64 + F.tid) * 2] = LP[(32 * 64 + F.tid) * 2]; l32[(g * 64 + F.tid) * 2 + 1] = LP[(32 * 64 + F.tid) * 2 + 1]; }
    {
        const int p = F.tid & 255, cp = p >> 4, ch = p & 15, t0 = (F.tid >> 8) * 16; float kacc[16];
#pragma unroll
        for (int t = 0; t < 16; ++t) kacc[t] = 0.f;
        for (int n = 0; n < 64; ++n) {
            const float cr = CC[(cp * 64 + n) * 2], ci = CC[(cp * 64 + n) * 2 + 1], br = BB[(n * 16 + ch) * 2], bi = BB[(n * 16 + ch) * 2 + 1];
            const float pr = cr * br - ci * bi, pi = cr * bi + ci * br, l0r = LP[(t0 * 64 + n) * 2], l0i = LP[(t0 * 64 + n) * 2 + 1], lr = LP[(64 + n) * 2], li = LP[(64 + n) * 2 + 1];
            float wr_ = pr * l0r - pi * l0i, wi_ = pr * l0i + pi * l0r;
#pragma unroll
            for (int t = 0; t < 16; ++t) { kacc[t] += wr_; const float nr = wr_ * lr - wi_ * li, ni = wr_ * li + wi_ * lr; wr_ = nr; wi_ = ni; }
        }
#pragma unroll
        for (int t = 0; t < 16; ++t) KT[((t0 + t) << 8) + p] = kacc[t];
    }
    __syncthreads();
    bf16* Bt2 = (bf16*)(F.ws + WS_BT2) + (size_t)g * 512 * 640;
    for (int q = F.tid; q < 512 * 80; q += 512) {
        const int R = q / 80, cc = q % 80, t = R >> 4, cp = R & 15; float v[8];
        if (cc < 64) { const int j = cc >> 1, chb = (cc & 1) * 8;
#pragma unroll
            for (int i = 0; i < 8; ++i) { const int ch = chb + i; float x = (t >= j) ? KT[((t - j) << 8) + cp * 16 + ch] : 0.f; if (t == j && ch == cp) x += sd[g * 16 + ch]; v[i] = x; }
        } else { const int nb = (cc - 64) * 4;
#pragma unroll
            for (int i = 0; i < 4; ++i) { const int n = nb + i; const float cr = CC[(cp * 64 + n) * 2], ci = CC[(cp * 64 + n) * 2 + 1], lr = LP[((t + 1) * 64 + n) * 2], li = LP[((t + 1) * 64 + n) * 2 + 1];
                v[2 * i] = cr * lr - ci * li; v[2 * i + 1] = -(cr * li + ci * lr); }
        }
        v4u o; o.x = pk2(v[0], v[1]); o.y = pk2(v[2], v[3]); o.z = pk2(v[4], v[5]); o.w = pk2(v[6], v[7]);
        *(GAS v4u*)(Bt2 + (size_t)R * 640 + cc * 8) = o;
    }
    bf16* WsT = (bf16*)(F.ws + WS_WST) + (size_t)g * 128 * 512;
    for (int q = F.tid; q < 128 * 64; q += 512) {
        const int R = q >> 6, cc = q & 63, n = R >> 1, ri = R & 1, j = cc >> 1, chb = (cc & 1) * 8; float v[8];
        const float lr = LP[((31 - j) * 64 + n) * 2], li = LP[((31 - j) * 64 + n) * 2 + 1];
#pragma unroll
        for (int i = 0; i < 8; ++i) { const float br = BB[(n * 16 + chb + i) * 2], bi = BB[(n * 16 + chb + i) * 2 + 1]; v[i] = ri == 0 ? (lr * br - li * bi) : (lr * bi + li * br); }
        v4u o; o.x = pk2(v[0], v[1]); o.y = pk2(v[2], v[3]); o.z = pk2(v[4], v[5]); o.w = pk2(v[6], v[7]);
        *(GAS v4u*)(WsT + (size_t)R * 512 + cc * 8) = o;
    }
    __syncthreads();
}
__device__ __forceinline__ void p0_prologue(Frame& F) {
    const bool split = F.G > NGRP; const bool tabler = split && (int)blockIdx.x < NGRP;
#ifndef P0_REP_TAB
#define P0_REP_TAB 1
#define P0_REP_TR 1
#define P0_REP_ROWS 1
#endif
    for (int rp_ = 0; rp_ < P0_REP_TAB; ++rp_)
    if (!split || tabler) for (int g = blockIdx.x; g < NGRP; g += F.G) ssm_tables(F, g);
    LAS unsigned* scr = (LAS unsigned*)(F.lds + RING_OFF + F.wave * 16384);
    const int gw = F.vcu * NWAVES + F.wave, NGW = F.G * NWAVES;
    constexpr int I_IN = 16 * 56, I_GLU = 8 * 32, I_CO = 8 * 16, I_O = 16 * 16, I_PG = 16 * 16, I_PLE = 4 * 16, I_EG = 16 * 8, I_ED = 8 * 16;
    constexpr int NITEMS = I_IN + I_GLU + I_CO + I_O + I_PG + I_PLE + NEXP * (2 * I_EG + I_ED);
    const int tw = split ? ((int)blockIdx.x - NGRP) * NWAVES + F.wave : gw, NTW = split ? (F.G - NGRP) * NWAVES : NGW;
    for (int rp_ = 0; rp_ < P0_REP_TR; ++rp_)
    if (!tabler) for (int it = tw; it < NITEMS; it += NTW) {
        int r = it;
        if (r < I_IN) { tr_item(F.in[I_WIN], D, DIN, (bf16*)(F.ws + WS_WIN), 1, 0, nullptr, scr, r, F.lane); continue; } r -= I_IN;
        if (r < I_GLU) { tr_item(F.in[I_WGLU], DSSM, 2 * D, (bf16*)(F.ws + WS_WGLU), 2, D, nullptr, scr, r, F.lane); continue; } r -= I_GLU;
        if (r < I_CO) { tr_item(F.in[I_WCO], DCONV, D, (bf16*)(F.ws + WS_WCO), 0, 0, nullptr, scr, r, F.lane); continue; } r -= I_CO;
        if (r < I_O) { tr_item(F.in[I_WOUT], D, D, (bf16*)(F.ws + WS_WO), 0, 0, nullptr, scr, r, F.lane); continue; } r -= I_O;
        if (r < I_PG) { tr_item(F.in[I_WPG], D, D, (bf16*)(F.ws + WS_WPG), 0, 0, F.in[I_GPLE], scr, r, F.lane); continue; } r -= I_PG;
        if (r < I_PLE) { tr_item(F.in[I_WPLE], DPLE, D, (bf16*)(F.ws + WS_WPLE), 0, 0, nullptr, scr, r, F.lane); continue; } r -= I_PLE;
        const int e = r / (2 * I_EG + I_ED); r -= e * (2 * I_EG + I_ED);
        if (r < I_EG) { tr_item8(F.in[I_WEG] + (size_t)e * D * DEXP, D, DEXP, F.ws + WS_WGU + (size_t)e * D * D, 3, 0, F.in[I_GMOE], W8S, scr, r, F.lane); continue; } r -= I_EG;
        if (r < I_EG) { tr_item8(F.in[I_WEU] + (size_t)e * D * DEXP, D, DEXP, F.ws + WS_WGU + (size_t)e * D * D, 4, 0, F.in[I_GMOE], W8S, scr, r, F.lane); continue; } r -= I_EG;
        tr_item(F.in[I_WED] + (size_t)e * DEXP * D, DEXP, D, (bf16*)(F.ws + WS_WD) + (size_t)e * D * DEXP, 0, 0, nullptr, scr, r, F.lane);
    }
    for (int rp_ = 0; rp_ < P0_REP_ROWS; ++rp_) { const float* x = F.in[I_X]; const float* gm = F.in[I_GMIX]; bf16* XN = (bf16*)(F.ws + WS_B);
      f32x4 gv[4];
#pragma unroll
      for (int j = 0; j < 4; ++j) gv[j] = *(const f32x4*)(gm + 4 * F.lane + 256 * j);
      for (int m = gw; m < NTOK; m += NGW) {
        const GAS f32x4* xr = (const GAS f32x4*)(x + (size_t)m * D) + F.lane; f32x4 v[4]; float s = 0.f;
#pragma unroll
        for (int j = 0; j < 4; ++j) { v[j] = xr[64 * j]; s += (v[j].x * v[j].x + v[j].y * v[j].y) + (v[j].z * v[j].z + v[j].w * v[j].w); }
        const float r = 1.0f / sqrtf(wave_sum(s) * (1.f / D) + EPS);
        GAS v2u* o8 = (GAS v2u*)(XN + (size_t)m * D) + F.lane;
#pragma unroll
        for (int j = 0; j < 4; ++j) { v2u o; o.x = pk2(v[j].x * r * gv[j].x, v[j].y * r * gv[j].y); o.y = pk2(v[j].z * r * gv[j].z, v[j].w * r * gv[j].w); o8[64 * j] = o; }
      } }
    { const float* p = F.in[I_P]; bf16* PB = (bf16*)(F.ws + WS_PB); const int gt = F.vcu * 512 + F.tid, NGT = F.G * 512;
      for (int q = gt; q < NTOK * DPLE / 8; q += NGT) { const f32x4 a = *(const f32x4*)(p + (size_t)q * 8), b = *(const f32x4*)(p + (size_t)q * 8 + 4);
        v4u o; o.x = pk2(a.x, a.y); o.y = pk2(a.z, a.w); o.z = pk2(b.x, b.y); o.w = pk2(b.z, b.w); *(GAS v4u*)(PB + (size_t)q * 8) = o; }
      bf16* WRT = (bf16*)(F.ws + WS_WRT); const float* gmoe = F.in[I_GMOE];
      for (int q = gt; q < 48 * 1024; q += NGT) { const int o = q >> 10, k = q & 1023; float v = 0.f;
        if (o < 4) v = F.in[I_WRG][k * 4 + o] * gmoe[k]; else if (o < 36) v = F.in[I_WRE][k * 32 + (o - 4)] * gmoe[k];
        const unsigned h = f2bf(v); const float lo = v - __builtin_bit_cast(float, h << 16); WRT[q] = (bf16)h; WRT[48 * 1024 + q] = (bf16)f2bf(lo); } }
}

using pg8::Unit;
typedef const f32x4 (&AccRef)[2][2][4][2];
struct EpiP1 {
    bf16* U; bf16* Z; bf16* SG; const float* bg;
    __device__ __forceinline__ void operator()(AccRef acc, const Unit& u, int wr, int wc, int fr, int fq) const {
        const int r0 = u.pm * 256 + wr * 64 + fr;
        if (u.pn < 2) {
#pragma unroll
            for (int ai = 0; ai < 2; ++ai)
#pragma unroll
                for (int m = 0; m < 4; ++m) { const int r = r0 + ai * 128 + m * 16, b = r >> 11, t = r & 2047;
#pragma unroll
                    for (int bj = 0; bj < 2; ++bj) { const int c0 = u.pn * 256 + bj * 128 + wc * 32 + fq * 8, g = c0 >> 4, ch0 = c0 & 15;
                        const f32x4 v0 = acc[ai][bj][m][0], v1 = acc[ai][bj][m][1];
                        v4u w; w.x = pk2(v0[0], v0[1]); w.y = pk2(v0[2], v0[3]); w.z = pk2(v1[0], v1[1]); w.w = pk2(v1[2], v1[3]);
                        *(GAS v4u*)(U + (((size_t)(b * 32 + g) * 2048 + t) * 16 + ch0)) = w; } }
        } else if (u.pn < 6) {
#pragma unroll
            for (int ai = 0; ai < 2; ++ai)
#pragma unroll
                for (int m = 0; m < 4; ++m) { const int r = r0 + ai * 128 + m * 16;
#pragma unroll
                    for (int bj = 0; bj < 2; ++bj) { const int o0 = (u.pn - 2) * 128 + bj * 64 + wc * 16 + fq * 4;
                        const f32x4 va = acc[ai][bj][m][0], ga = acc[ai][bj][m][1];
                        v2u w; w.x = pk2(va[0] * sigm(ga[0]), va[1] * sigm(ga[1])); w.y = pk2(va[2] * sigm(ga[2]), va[3] * sigm(ga[3]));
                        *(GAS v2u*)(Z + (size_t)r * 512 + o0) = w; } }
        } else {
#pragma unroll
            for (int bj = 0; bj < 2; ++bj) { const int s0 = (u.pn - 6) * 256 + bj * 128 + wc * 32 + fq * 8;
#ifdef DBG_NO_BIAS
                const f32x4 b0 = (f32x4){0.f, 0.f, 0.f, 0.f}, b1 = b0;
#else
                const f32x4 b0 = *(const f32x4*)(bg + s0), b1 = *(const f32x4*)(bg + s0 + 4);
#endif
#pragma unroll
                for (int ai = 0; ai < 2; ++ai)
#pragma unroll
                    for (int m = 0; m < 4; ++m) { const int r = r0 + ai * 128 + m * 16;
#ifdef DBG_BIAS_ONLY
                        const f32x4 v0 = b0, v1 = b1;
#else
                        const f32x4 v0 = acc[ai][bj][m][0] + b0, v1 = acc[ai][bj][m][1] + b1;
#endif
                        v4u w; w.x = pk2(sigm(v0[0]), sigm(v0[1])); w.y = pk2(sigm(v0[2]), sigm(v0[3])); w.z = pk2(sigm(v1[0]), sigm(v1[1])); w.w = pk2(sigm(v1[2]), sigm(v1[3]));
#ifdef DBG_SG_CONST
                        w.x = w.y = w.z = w.w = 0x3f003f00u;
#endif
                        *(GAS v4u*)(SG + (size_t)r * 2048 + s0) = w; } }
        }
    }
};
struct EpiGlu {
    bf16* MS; const bf16* SG;
    static __device__ __forceinline__ void run(AccRef acc, const Unit& u, int wr, int wc, int fr, int fq, bf16* __restrict__ MS, const bf16* __restrict__ SG) {
        const int r0 = u.pm * 256 + wr * 64 + fr;
#pragma unroll
        for (int ai = 0; ai < 2; ++ai)
#pragma unroll
            for (int m = 0; m < 4; ++m) { const int r = r0 + ai * 128 + m * 16;
#pragma unroll
                for (int bj = 0; bj < 2; ++bj) { const int o0 = u.pn * 128 + bj * 64 + wc * 16 + fq * 4;
                    const v2u sg = *(const GAS v2u*)(SG + (size_t)r * 2048 + o0);
                    const f32x4 va = acc[ai][bj][m][0], ga = acc[ai][bj][m][1];
                    v2u o; o.x = pk2(va[0] * sigm(ga[0]) * bflo(sg.x), va[1] * sigm(ga[1]) * bfhi(sg.x)); o.y = pk2(va[2] * sigm(ga[2]) * bflo(sg.y), va[3] * sigm(ga[3]) * bfhi(sg.y));
                    *(GAS v2u*)(MS + (size_t)r * 1024 + o0) = o; } }
    }
    __device__ __forceinline__ void operator()(AccRef acc, const Unit& u, int wr, int wc, int fr, int fq) const { run(acc, u, wr, wc, fr, fq, MS, SG); }
};
struct EpiCo {
    const bf16* MS; const bf16* SG; bf16* MG;
    static __device__ __forceinline__ void run(AccRef acc, const Unit& u, int wr, int wc, int fr, int fq, const bf16* __restrict__ MS, const bf16* __restrict__ SG, bf16* __restrict__ MG) {
        const int r0 = u.pm * 256 + wr * 64 + fr;
#pragma unroll
        for (int ai = 0; ai < 2; ++ai)
#pragma unroll
            for (int m = 0; m < 4; ++m) { const int r = r0 + ai * 128 + m * 16;
#pragma unroll
                for (int bj = 0; bj < 2; ++bj) { const int c0 = u.pn * 256 + bj * 128 + wc * 32 + fq * 8;
                    const v4u ms = *(const GAS v4u*)(MS + (size_t)r * 1024 + c0);
                    const v4u sg = *(const GAS v4u*)(SG + (size_t)r * 2048 + 1024 + c0);
                    const f32x4 v0 = acc[ai][bj][m][0], v1 = acc[ai][bj][m][1];
                    v4u w; w.x = pk2(bflo(ms.x) + bflo(sg.x) * v0[0], bfhi(ms.x) + bfhi(sg.x) * v0[1]); w.y = pk2(bflo(ms.y) + bflo(sg.y) * v0[2], bfhi(ms.y) + bfhi(sg.y) * v0[3]);
                    w.z = pk2(bflo(ms.z) + bflo(sg.z) * v1[0], bfhi(ms.z) + bfhi(sg.z) * v1[1]); w.w = pk2(bflo(ms.w) + bflo(sg.w) * v1[2], bfhi(ms.w) + bfhi(sg.w) * v1[3]);
                    *(GAS v4u*)(MG + (size_t)r * 1024 + c0) = w; } }
    }
    __device__ __forceinline__ void operator()(AccRef acc, const Unit& u, int wr, int wc, int fr, int fq) const { run(acc, u, wr, wc, fr, fq, MS, SG, MG); }
};
struct EpiRes {
    const float* X; bf16* X1B; unsigned char* X1F;
    static __device__ __forceinline__ void run(AccRef acc, const Unit& u, int wr, int wc, int fr, int fq, const float* __restrict__ X, bf16* __restrict__ X1B, unsigned char* __restrict__ X1F) {
        const int r0 = u.pm * 256 + wr * 64 + fr;
#pragma unroll
        for (int ai = 0; ai < 2; ++ai)
#pragma unroll
            for (int m = 0; m < 4; ++m) { const int r = r0 + ai * 128 + m * 16;
#pragma unroll
                for (int bj = 0; bj < 2; ++bj) { const size_t o = (size_t)r * 1024 + u.pn * 256 + bj * 128 + wc * 32 + fq * 8;
                    const f32x4 x0 = *(const GAS f32x4*)(X + o) + acc[ai][bj][m][0], x1 = *(const GAS f32x4*)(X + o + 4) + acc[ai][bj][m][1];
                    v4u w; w.x = pk2(x0[0], x0[1]); w.y = pk2(x0[2], x0[3]); w.z = pk2(x1[0], x1[1]); w.w = pk2(x1[2], x1[3]);
                    *(GAS v4u*)(X1B + o) = w;
                    v2u f; f.x = pk4f8(x0[0], x0[1], x0[2], x0[3]); f.y = pk4f8(x1[0], x1[1], x1[2], x1[3]); *(GAS v2u*)(X1F + o) = f; } }
    }
    __device__ __forceinline__ void operator()(AccRef acc, const Unit& u, int wr, int wc, int fr, int fq) const { run(acc, u, wr, wc, fr, fq, X, X1B, X1F); }
};
struct EpiAct {
    bf16* ACT; const int* ltok; const float* R2;
    static __device__ __forceinline__ void run(AccRef acc, const Unit& u, int wr, int wc, int fr, int fq, bf16* __restrict__ ACT, const int* __restrict__ ltok, const float* __restrict__ R2) {
        float rr[2][4];
#pragma unroll
        for (int ai = 0; ai < 2; ++ai)
#pragma unroll
            for (int m = 0; m < 4; ++m) { const int rl = ai * 128 + wr * 64 + m * 16 + fr; const int tok = (rl < u.rows) ? ltok[u.e * NTOK + u.mt * 256 + rl] : 0; rr[ai][m] = R2[tok] * W8I; }
#pragma unroll
        for (int ai = 0; ai < 2; ++ai)
#pragma unroll
            for (int m = 0; m < 4; ++m) { const int rl = ai * 128 + wr * 64 + m * 16 + fr;
                if (rl < u.rows) {
#pragma unroll
                    for (int bj = 0; bj < 2; ++bj) { const int o0 = u.pn * 128 + bj * 64 + wc * 16 + fq * 4;
                        const f32x4 ga = acc[ai][bj][m][0] * rr[ai][m], ua = acc[ai][bj][m][1] * rr[ai][m];
                        v2u w; w.x = pk2(ga[0] * sigm(ga[0]) * ua[0], ga[1] * sigm(ga[1]) * ua[1]); w.y = pk2(ga[2] * sigm(ga[2]) * ua[2], ga[3] * sigm(ga[3]) * ua[3]);
                        *(GAS v2u*)(ACT + (size_t)(u.pm * 256 + rl) * 512 + o0) = w; } } }
    }
    __device__ __forceinline__ void operator()(AccRef acc, const Unit& u, int wr, int wc, int fr, int fq) const { run(acc, u, wr, wc, fr, fq, ACT, ltok, R2); }
};
struct EpiY {
    bf16* Y;
    __device__ __forceinline__ void operator()(AccRef acc, const Unit& u, int wr, int wc, int fr, int fq) const {
#pragma unroll
        for (int ai = 0; ai < 2; ++ai)
#pragma unroll
            for (int m = 0; m < 4; ++m) { const int rl = ai * 128 + wr * 64 + m * 16 + fr;
                if (rl < u.rows) {
#pragma unroll
                    for (int bj = 0; bj < 2; ++bj) { const f32x4 v0 = acc[ai][bj][m][0], v1 = acc[ai][bj][m][1];
                        v4u w; w.x = pk2(v0[0], v0[1]); w.y = pk2(v0[2], v0[3]); w.z = pk2(v1[0], v1[1]); w.w = pk2(v1[2], v1[3]);
                        *(GAS v4u*)(Y + (size_t)(u.cb + rl) * 1024 + u.pn * 256 + bj * 128 + wc * 32 + fq * 8) = w; } } }
    }
};
struct EpiE {
    bf16* EO;
    __device__ __forceinline__ void operator()(AccRef acc, const Unit& u, int wr, int wc, int fr, int fq) const {
        const int r0 = u.pm * 256 + wr * 64 + fr;
#pragma unroll
        for (int ai = 0; ai < 2; ++ai)
#pragma unroll
            for (int m = 0; m < 4; ++m) { const int r = r0 + ai * 128 + m * 16;
#pragma unroll
                for (int bj = 0; bj < 2; ++bj) { const size_t o = (size_t)r * 1024 + u.pn * 256 + bj * 128 + wc * 32 + fq * 8; const f32x4 v0 = acc[ai][bj][m][0], v1 = acc[ai][bj][m][1];
                    v4u w; w.x = pk2(v0[0], v0[1]); w.y = pk2(v0[2], v0[3]); w.z = pk2(v1[0], v1[1]); w.w = pk2(v1[2], v1[3]);
                    *(GAS v4u*)(EO + o) = w; } }
    }
};
struct EpiPle {
    const bf16* X2; const bf16* EO; const float* R3; bf16* X3;
    static __device__ __forceinline__ void run(AccRef acc, const Unit& u, int wr, int wc, int fr, int fq, const bf16* __restrict__ X2, const bf16* __restrict__ EO, const float* __restrict__ R3, bf16* __restrict__ X3) {
        const int r0 = u.pm * 256 + wr * 64 + fr;
#pragma unroll
        for (int ai = 0; ai < 2; ++ai)
#pragma unroll
            for (int m = 0; m < 4; ++m) { const int r = r0 + ai * 128 + m * 16; const float r3 = R3[r];
#pragma unroll
                for (int bj = 0; bj < 2; ++bj) { const size_t o = (size_t)r * 1024 + u.pn * 256 + bj * 128 + wc * 32 + fq * 8;
                    const v4u x = *(const GAS v4u*)(X2 + o), e = *(const GAS v4u*)(EO + o);
                    const f32x4 a0 = acc[ai][bj][m][0] * r3, a1 = acc[ai][bj][m][1] * r3;
                    v4u w; w.x = pk2(bflo(x.x) + sigm(a0[0]) * bflo(e.x), bfhi(x.x) + sigm(a0[1]) * bfhi(e.x)); w.y = pk2(bflo(x.y) + sigm(a0[2]) * bflo(e.y), bfhi(x.y) + sigm(a0[3]) * bfhi(e.y));
                    w.z = pk2(bflo(x.z) + sigm(a1[0]) * bflo(e.z), bfhi(x.z) + sigm(a1[1]) * bfhi(e.z)); w.w = pk2(bflo(x.w) + sigm(a1[2]) * bflo(e.w), bfhi(x.w) + sigm(a1[3]) * bfhi(e.w));
                    *(GAS v4u*)(X3 + o) = w; } }
    }
    __device__ __forceinline__ void operator()(AccRef acc, const Unit& u, int wr, int wc, int fr, int fq) const { run(acc, u, wr, wc, fr, fq, X2, EO, R3, X3); }
};
struct DenseOrder : pg8::StaticOrder {
    const char* A; const char* Bt; size_t tstep;
    __device__ __forceinline__ const char* a_base(const Unit& u) const { return A + (size_t)u.pm * tstep; }
    __device__ __forceinline__ const char* b_base(const Unit& u) const { return Bt + (size_t)u.pn * tstep; }
    __device__ __forceinline__ unsigned row_off(const Unit&, int) const { return 0u; }
};
struct GluPairOrder : DenseOrder {
    __device__ __forceinline__ bool next(int i, Unit& u) const { if (i >= 2) return false; Unit t; if (!pg8::StaticOrder::next(0, t)) return false; u = t; u.pn = 2 * t.pn + i; return true; }
};
struct MoeOrder {
    const LAS int* tb; const LAS int* cn; int G, c, K, npn;
    const char* A; const char* Bt; size_t b_estride; const int* ltok; bool gather;
    __device__ __forceinline__ bool next(int i, Unit& u) const {
        const int L = i * G + c, total = tb[NEXP] * npn; if (L >= total) return false;
        const int tile = L / npn; int e = 0;
        for (int k = 1; k < NEXP; ++k) e += (tb[k] <= tile) ? 1 : 0;
        u.e = e; u.pm = tile; u.pn = L % npn; u.mt = tile - tb[e]; const int left = cn[e] - u.mt * 256; u.rows = left < 256 ? left : 256; u.cb = cn[33 + e] + u.mt * 256; return true;
    }
    __device__ __forceinline__ const char* a_base(const Unit& u) const { return gather ? A : A + (size_t)u.pm * 256 * K * 2; }
    __device__ __forceinline__ const char* b_base(const Unit& u) const { return Bt + (size_t)u.e * b_estride + (size_t)u.pn * 256 * K * 2; }
    __device__ __forceinline__ unsigned row_off(const Unit& u, int r) const { const int tok = (r < u.rows) ? ltok[u.e * NTOK + u.mt * 256 + r] : 0; return (unsigned)tok * (unsigned)(K * 2); }
};

constexpr int SSM_AP = 1296;
__device__ __forceinline__ void ssm_unit(Frame& F, int b, int g) {
    LAS unsigned char* Al = F.lds;
    LAS float* SL = (LAS float*)(F.lds + 64 * SSM_AP);
    const int fr = F.lane & 15, fq = F.lane >> 4, w = F.wave;
    const bf16* Ug = (const bf16*)(F.ws + WS_C) + (size_t)(b * 32 + g) * 2048 * 16;
#pragma unroll 4
    for (int q = F.tid; q < 4096; q += 512) { const int row = q >> 6, cc = q & 63; const v4u v = *(const GAS v4u*)(Ug + row * 512 + cc * 8); *(LAS v4u*)(Al + row * SSM_AP + cc * 16) = v; }
    __syncthreads();
    {
        const bf16* WS = (const bf16*)(F.ws + WS_WST) + ((size_t)g * 128 + 16 * w + fr) * 512 + 8 * fq;
        f32x4 acc[4];
#pragma unroll
        for (int m = 0; m < 4; ++m) acc[m] = (f32x4){0.f, 0.f, 0.f, 0.f};
#pragma unroll 4
        for (int s = 0; s < 16; ++s) { const bf16x8 bw = *(const GAS bf16x8*)(WS + 32 * s);
#pragma unroll
            for (int m = 0; m < 4; ++m) { const bf16x8 a = *(const LAS bf16x8*)(Al + (16 * m + fr) * SSM_AP + (32 * s + 8 * fq) * 2); acc[m] = __builtin_amdgcn_mfma_f32_16x16x32_bf16(bw, a, acc[m], 0, 0, 0); } }
#pragma unroll
        for (int m = 0; m < 4; ++m) *(LAS f32x4*)(SL + (16 * m + fr) * 132 + 16 * w + 4 * fq) = acc[m];
    }
    __syncthreads();
    if (w == 0) {
        const int n = F.lane; const float* l32 = (const float*)(F.ws + WS_LAM32) + (g * 64 + n) * 2; const float lr = l32[0], li = l32[1]; float sr = 0.f, si = 0.f;
        for (int c = 0; c < NCH; ++c) { *(LAS unsigned*)(Al + c * SSM_AP + 1024 + 4 * n) = pk2(sr, si);
            const float ur = SL[c * 132 + 2 * n], ui = SL[c * 132 + 2 * n + 1]; const float nr = lr * sr - li * si + ur, ni = lr * si + li * sr + ui; sr = nr; si = ni; }
    }
    __syncthreads();
    {
        const bf16* BT = (const bf16*)(F.ws + WS_BT2) + ((size_t)g * 512 + 64 * w + fr) * 640 + 8 * fq;
        f32x4 acc[4][4];
#pragma unroll
        for (int m = 0; m < 4; ++m)
#pragma unroll
            for (int n = 0; n < 4; ++n) acc[m][n] = (f32x4){0.f, 0.f, 0.f, 0.f};
#pragma unroll 2
        for (int s = 0; s < 20; ++s) { bf16x8 bf[4], af[4];
#pragma unroll
            for (int n = 0; n < 4; ++n) bf[n] = *(const GAS bf16x8*)(BT + (size_t)n * 16 * 640 + 32 * s);
#pragma unroll
            for (int m = 0; m < 4; ++m) af[m] = *(const LAS bf16x8*)(Al + (16 * m + fr) * SSM_AP + (32 * s + 8 * fq) * 2);
#pragma unroll
            for (int m = 0; m < 4; ++m)
#pragma unroll
                for (int n = 0; n < 4; ++n) acc[m][n] = __builtin_amdgcn_mfma_f32_16x16x32_bf16(bf[n], af[m], acc[m][n], 0, 0, 0); }
        bf16* GY = (bf16*)(F.ws + WS_B);
#pragma unroll
        for (int m = 0; m < 4; ++m)
#pragma unroll
            for (int n = 0; n < 4; ++n) { const int tok = b * SEQ + LC * (16 * m + fr) + 4 * w + n; const f32x4 y = acc[m][n];
                v2u o; o.x = pk2(gelu_tanh(y[0]), gelu_tanh(y[1])); o.y = pk2(gelu_tanh(y[2]), gelu_tanh(y[3]));
                *(GAS v2u*)(GY + (size_t)tok * 512 + 16 * g + 4 * fq) = o; }
    }
    __syncthreads();
}
__device__ __forceinline__ void conv_tile(Frame& F, int tile) {
    const int tok0 = tile * 64, b = tok0 >> 11, t0 = tok0 & 2047;
    LAS unsigned* zl = (LAS unsigned*)F.lds;
    LAS float* red = (LAS float*)(F.lds + 98304);
    const bf16* Z = (const bf16*)(F.ws + WS_C + 16 * MiB);
#pragma unroll 2
    for (int q = F.tid; q < 94 * 64; q += 512) { const int rr = q >> 6, cc = q & 63, t = t0 - 30 + rr; v4u v = (v4u){0u, 0u, 0u, 0u};
        if (t >= 0) v = *(const GAS v4u*)(Z + (size_t)(b * SEQ + t) * 512 + cc * 8); *(LAS v4u*)(zl + rr * 256 + cc * 4) = v; }
    __syncthreads();
    const int wq = F.wave & 3, th = F.wave >> 2, cp = wq * 64 + F.lane;
    float dw0[31], dw1[31];
    {   const float* pw = F.in[I_CDW] + 2 * cp;
        typedef float f32x2 __attribute__((ext_vector_type(2)));
#pragma unroll
        for (int k = 0; k < 31; ++k) { const f32x2 v = *(const GAS f32x2*)pw; dw0[k] = v.x; dw1[k] = v.y; pw += 512; asm volatile("" : "+v"(pw)); } }
    const float cb0 = F.in[I_CDWB][2 * cp], cb1 = F.in[I_CDWB][2 * cp + 1], lg0 = F.in[I_CLNG][2 * cp], lg1 = F.in[I_CLNG][2 * cp + 1], lb0 = F.in[I_CLNB][2 * cp], lb1 = F.in[I_CLNB][2 * cp + 1];
    bf16* CA = (bf16*)(F.ws + WS_B + 16 * MiB);
#pragma unroll 1
    for (int ch = 0; ch < 4; ++ch) {
        float a0[8], a1[8];
#pragma unroll
        for (int o = 0; o < 8; ++o) { a0[o] = cb0; a1[o] = cb1; }
        const int rbase = th * 32 + ch * 8;
#pragma unroll
        for (int r = 0; r < 38; ++r) { const unsigned v = zl[(rbase + r) * 256 + cp]; const float x0 = bflo(v), x1 = bfhi(v);
#pragma unroll
            for (int o = 0; o < 8; ++o) { const int k = r - o; if (k >= 0 && k <= 30) { a0[o] += dw0[k] * x0; a1[o] += dw1[k] * x1; } }
            __builtin_amdgcn_sched_barrier(0); }
        LAS float* rp = red + ((ch & 1) * 2 + th) * 64;
#pragma unroll
        for (int o = 0; o < 8; ++o) { const float s = wave_sum(a0[o] + a1[o]), q = wave_sum(a0[o] * a0[o] + a1[o] * a1[o]); if (F.lane == 0) { rp[(o * 4 + wq) * 2] = s; rp[(o * 4 + wq) * 2 + 1] = q; } }
        __syncthreads();
#pragma unroll
        for (int o = 0; o < 8; ++o) { float s = 0.f, q = 0.f;
#pragma unroll
            for (int k = 0; k < 4; ++k) { s += rp[(o * 4 + k) * 2]; q += rp[(o * 4 + k) * 2 + 1]; }
            const float mean = s * (1.f / 512.f), var = q * (1.f / 512.f) - mean * mean, rstd = 1.0f / sqrtf(var + EPS);
            const float y0 = (a0[o] - mean) * rstd * lg0 + lb0, y1 = (a1[o] - mean) * rstd * lg1 + lb1;
            *(GAS unsigned*)(CA + (size_t)(tok0 + rbase + o) * 512 + 2 * cp) = pk2(y0 * sigm(y0), y1 * sigm(y1)); }
    }
    __syncthreads();
}
__device__ __forceinline__ void router_phase(Frame& F) {
    const int fr = F.lane & 15, fq = F.lane >> 4, tl = F.wave & 3, kh = F.wave >> 2;
    const bf16* XB = (const bf16*)(F.ws + WS_B); float* R2 = (float*)(F.ws + WS_R2);
    const bf16* WRT = (const bf16*)(F.ws + WS_WRT); int* ltok = (int*)(F.ws + WS_LTOK); int* tinfo = (int*)(F.ws + WS_TINFO);
    LAS float* part = (LAS float*)(F.lds + 32768);
    LAS float* lg = (LAS float*)(F.lds + tl * 4096);
    LAS unsigned* lcnt = (LAS unsigned*)(F.lds + 49152);
    LAS unsigned* lbase = lcnt + 32;
    LAS unsigned* dec = lcnt + 64;
    if (F.tid < NEXP) lcnt[F.tid] = 0u;
    __syncthreads();
    for (int tg = F.vcu; tg < NTOK / 64; tg += F.G) {
        const int tile = tg * 4 + tl, tok = tile * 16 + fr;
        const bf16* xr = XB + (size_t)tok * D + 512 * kh + 8 * fq; const bf16* wh = WRT + (size_t)fr * D + 512 * kh + 8 * fq;
        f32x4 acc[3]; float ss = 0.f;
#pragma unroll
        for (int n = 0; n < 3; ++n) acc[n] = (f32x4){0.f, 0.f, 0.f, 0.f};
#pragma unroll 4
        for (int s = 0; s < 16; ++s) {
            const v4u h = *(const GAS v4u*)(xr + 32 * s);
            const float a0 = bflo(h.x), a1 = bfhi(h.x), a2 = bflo(h.y), a3 = bfhi(h.y), a4 = bflo(h.z), a5 = bfhi(h.z), a6 = bflo(h.w), a7 = bfhi(h.w);
            ss += (a0 * a0 + a1 * a1) + (a2 * a2 + a3 * a3) + (a4 * a4 + a5 * a5) + (a6 * a6 + a7 * a7);
            const bf16x8 xh = __builtin_bit_cast(bf16x8, h);
#pragma unroll
            for (int n = 0; n < 3; ++n) { const bf16x8 whi = *(const GAS bf16x8*)(wh + (size_t)n * 16 * D + 32 * s), wlo = *(const GAS bf16x8*)(wh + (size_t)(48 + n * 16) * D + 32 * s);
                acc[n] = __builtin_amdgcn_mfma_f32_16x16x32_bf16(whi, xh, acc[n], 0, 0, 0); acc[n] = __builtin_amdgcn_mfma_f32_16x16x32_bf16(wlo, xh, acc[n], 0, 0, 0); }
        }
        ss += __shfl_xor(ss, 16); ss += __shfl_xor(ss, 32);
        if (kh == 1) { LAS float* pp = part + (tl * 64 + F.lane) * 13;
#pragma unroll
            for (int n = 0; n < 3; ++n)
#pragma unroll
                for (int j = 0; j < 4; ++j) pp[4 * n + j] = acc[n][j];
            pp[12] = ss; }
        __syncthreads();
        if (kh == 0) {
            const LAS float* pp = part + (tl * 64 + F.lane) * 13;
            ss += pp[12];
            const float r = 1.0f / sqrtf(ss * (1.f / D) + EPS);
            if (fq == 0) R2[tok] = r;
#pragma unroll
            for (int n = 0; n < 3; ++n)
#pragma unroll
                for (int j = 0; j < 4; ++j) { const int o = 16 * n + 4 * fq + j; if (o < 36) { const float bias = o < 4 ? F.in[I_BRG][o] : F.in[I_BRE2][o - 4]; lg[fr * 49 + o] = (acc[n][j] + pp[4 * n + j]) * r + bias; } }
            LDS_WAIT(); asm volatile("" ::: "memory");
            if (F.lane < 16) {
                const LAS float* l = lg + F.lane * 49;
                float gm = l[0]; int gs = 0;
#pragma unroll
                for (int i = 1; i < 4; ++i) if (l[i] > gm) { gm = l[i]; gs = i; }
                float den = 0.f;
#pragma unroll
                for (int i = 0; i < 4; ++i) den += __expf(l[i] - gm);
                const float pg = 1.0f / den;
                const LAS float* el = l + 4 + 8 * gs;
                float v1 = el[0]; int j1 = 0;
#pragma unroll
                for (int i = 1; i < 8; ++i) if (el[i] > v1) { v1 = el[i]; j1 = i; }
                float v2 = -3.0e38f; int j2 = 0;
#pragma unroll
                for (int i = 0; i < 8; ++i) if (i != j1 && el[i] > v2) { v2 = el[i]; j2 = i; }
                const float w1 = pg / (1.0f + __expf(v2 - v1)), w2 = pg - w1;
                const int e1 = gs * 8 + j1, e2 = gs * 8 + j2;
                const unsigned s1 = __hip_atomic_fetch_add(lcnt + e1, 1u, __ATOMIC_RELAXED, __HIP_MEMORY_SCOPE_WORKGROUP), s2 = __hip_atomic_fetch_add(lcnt + e2, 1u, __ATOMIC_RELAXED, __HIP_MEMORY_SCOPE_WORKGROUP);
                LAS unsigned* dd = dec + (tl * 16 + F.lane) * 6; dd[0] = (unsigned)e1; dd[1] = s1; dd[2] = (unsigned)e2; dd[3] = s2; dd[4] = __builtin_bit_cast(unsigned, w1); dd[5] = __builtin_bit_cast(unsigned, w2);
            }
        }
        __syncthreads();
        if (F.tid < NEXP) { const unsigned c = lcnt[F.tid]; lbase[F.tid] = c ? __hip_atomic_fetch_add((unsigned*)(F.ctl + CW_ECNT + 64 * F.tid), c, RLX_AGENT) : 0u; lcnt[F.tid] = 0u; }
        __syncthreads();
        if (F.tid < 64) { const LAS unsigned* dd = dec + F.tid * 6; const int token = tg * 64 + F.tid; const int e1 = (int)dd[0], e2 = (int)dd[2]; const int s1 = (int)(lbase[e1] + dd[1]), s2 = (int)(lbase[e2] + dd[3]);
            ltok[e1 * NTOK + s1] = token; ltok[e2 * NTOK + s2] = token;
            typedef int i32x4 __attribute__((ext_vector_type(4))); *(GAS i32x4*)(tinfo + 4 * token) = (i32x4){e1 * NTOK + s1, e2 * NTOK + s2, (int)dd[4], (int)dd[5]}; }
        __syncthreads();
    }
}
__device__ __forceinline__ void rows_to_bf16(Frame& F, const float* X, bf16* XB, float* RR) {
    const int gw = F.vcu * NWAVES + F.wave, NGW = F.G * NWAVES;
    for (int m = gw; m < NTOK; m += NGW) {
        const GAS f32x4* xr = (const GAS f32x4*)(X + (size_t)m * D) + F.lane; f32x4 v[4]; float s = 0.f;
#pragma unroll
        for (int j = 0; j < 4; ++j) { v[j] = xr[64 * j]; s += (v[j].x * v[j].x + v[j].y * v[j].y) + (v[j].z * v[j].z + v[j].w * v[j].w); }
        const float r = 1.0f / sqrtf(wave_sum(s) * (1.f / D) + EPS);
        if (F.lane == 0) RR[m] = r;
        GAS v2u* o8 = (GAS v2u*)(XB + (size_t)m * D) + F.lane;
#pragma unroll
        for (int j = 0; j < 4; ++j) { v2u o; o.x = pk2(v[j].x, v[j].y); o.y = pk2(v[j].z, v[j].w); o8[64 * j] = o; }
    }
}
__device__ __forceinline__ void moe_combine_rows(Frame& F, const bf16* __restrict__ XB, const bf16* __restrict__ Y, bf16* __restrict__ XO, float* __restrict__ RR) {
    const int gw = F.vcu * NWAVES + F.wave, NGW = F.G * NWAVES; const LAS int* cs = (const LAS int*)(F.lds + TB_OFF) + 66; const int* tinfo = (const int*)(F.ws + WS_TINFO);
    for (int m = gw; m < NTOK; m += NGW) {
        typedef int i32x4 __attribute__((ext_vector_type(4))); const i32x4 ti = *(const GAS i32x4*)(tinfo + 4 * m);
        const int r1 = cs[ti.x >> 14] + (ti.x & (NTOK - 1)), r2 = cs[ti.y >> 14] + (ti.y & (NTOK - 1)); const int wz = ti.z, ww = ti.w; const float w1 = __builtin_bit_cast(float, wz), w2 = __builtin_bit_cast(float, ww);
        const GAS v4u* xr = (const GAS v4u*)(XB + (size_t)m * D) + F.lane; GAS v4u* xo = (GAS v4u*)(XO + (size_t)m * D) + F.lane; const GAS v4u* y1 = (const GAS v4u*)(Y + (size_t)r1 * D) + F.lane; const GAS v4u* y2 = (const GAS v4u*)(Y + (size_t)r2 * D) + F.lane;
        v4u o[2]; float s = 0.f;
#pragma unroll
        for (int j = 0; j < 2; ++j) { const v4u x = xr[64 * j], a = y1[64 * j], b = y2[64 * j]; float v[8];
            v[0] = bflo(x.x) + w1 * bflo(a.x) + w2 * bflo(b.x); v[1] = bfhi(x.x) + w1 * bfhi(a.x) + w2 * bfhi(b.x); v[2] = bflo(x.y) + w1 * bflo(a.y) + w2 * bflo(b.y); v[3] = bfhi(x.y) + w1 * bfhi(a.y) + w2 * bfhi(b.y);
            v[4] = bflo(x.z) + w1 * bflo(a.z) + w2 * bflo(b.z); v[5] = bfhi(x.z) + w1 * bfhi(a.z) + w2 * bfhi(b.z); v[6] = bflo(x.w) + w1 * bflo(a.w) + w2 * bflo(b.w); v[7] = bfhi(x.w) + w1 * bfhi(a.w) + w2 * bfhi(b.w);
            o[j].x = pk2(v[0], v[1]); o[j].y = pk2(v[2], v[3]); o[j].z = pk2(v[4], v[5]); o[j].w = pk2(v[6], v[7]);
            const float q0 = bflo(o[j].x), q1 = bfhi(o[j].x), q2 = bflo(o[j].y), q3 = bfhi(o[j].y), q4 = bflo(o[j].z), q5 = bfhi(o[j].z), q6 = bflo(o[j].w), q7 = bfhi(o[j].w);
            s += (q0 * q0 + q1 * q1) + (q2 * q2 + q3 * q3) + (q4 * q4 + q5 * q5) + (q6 * q6 + q7 * q7); }
        const float r = 1.0f / sqrtf(wave_sum(s) * (1.f / D) + EPS);
        if (F.lane == 0) RR[m] = r;
#pragma unroll
        for (int j = 0; j < 2; ++j) xo[64 * j] = o[j];
    }
}
__device__ __forceinline__ void final_norm(Frame& F, const bf16* X, float* out, const float* gf) {
    const int gw = F.vcu * NWAVES + F.wave, NGW = F.G * NWAVES;
    f32x4 gv[2][2];
#pragma unroll
    for (int j = 0; j < 2; ++j) { gv[j][0] = *(const f32x4*)(gf + 8 * F.lane + 512 * j); gv[j][1] = *(const f32x4*)(gf + 8 * F.lane + 512 * j + 4); }
    for (int m = gw; m < NTOK; m += NGW) {
        const GAS v4u* xr = (const GAS v4u*)(X + (size_t)m * D) + F.lane; f32x4 v[2][2]; float s = 0.f;
#pragma unroll
        for (int j = 0; j < 2; ++j) { const v4u x = xr[64 * j]; v[j][0] = (f32x4){bflo(x.x), bfhi(x.x), bflo(x.y), bfhi(x.y)}; v[j][1] = (f32x4){bflo(x.z), bfhi(x.z), bflo(x.w), bfhi(x.w)};
            s += (v[j][0].x * v[j][0].x + v[j][0].y * v[j][0].y) + (v[j][0].z * v[j][0].z + v[j][0].w * v[j][0].w) + (v[j][1].x * v[j][1].x + v[j][1].y * v[j][1].y) + (v[j][1].z * v[j][1].z + v[j][1].w * v[j][1].w); }
        const float r = 1.0f / sqrtf(wave_sum(s) * (1.f / D) + EPS);
        GAS f32x4* o = (GAS f32x4*)(out + (size_t)m * D) + 2 * F.lane;
#pragma unroll
        for (int j = 0; j < 2; ++j) { o[128 * j] = v[j][0] * r * gv[j][0]; o[128 * j + 1] = v[j][1] * r * gv[j][1]; }
    }
}
__device__ __forceinline__ void moe_tables(Frame& F) {
    LAS int* tb = (LAS int*)(F.lds + TB_OFF); LAS int* cn = tb + 33; LAS int* cs = cn + 33;
    if (F.tid == 0) { int t = 0, r = 0; for (int e = 0; e < NEXP; ++e) { const int c = (int)__hip_atomic_load((unsigned*)(F.ctl + CW_ECNT + 64 * e), RLX_AGENT); cn[e] = c; tb[e] = t; cs[e] = r; t += (c + 255) >> 8; r += c; } tb[NEXP] = t; cs[NEXP] = r; }
    __syncthreads();
}

struct Args { const float* in[N_IN]; float* out; unsigned char* ws; int ph_lo, ph_hi; };
__global__ void __launch_bounds__(NWAVES * 64, 2) mk_fwd(Args args) {
    extern __shared__ __attribute__((aligned(16))) unsigned char lds[];
    Frame F;
    F.lds = (LAS unsigned char*)lds;
    F.MISC = (volatile LAS unsigned*)(F.lds + MISC_OFF);
    F.tid = threadIdx.x; F.lane = F.tid & 63; F.wave = __builtin_amdgcn_readfirstlane(F.tid >> 6);
    const int wave_s = F.wave;
    F.G = gridDim.x; { const int bx = blockIdx.x; F.vcu = (F.G % 8 == 0) ? (bx % 8) * (F.G / 8) + bx / 8 : bx; }
    F.in = args.in; F.out = args.out; F.ws = args.ws; F.ctl = (gu32*)(args.ws + WS_CTL);
    for (int u = F.tid; u < (LDS_BYTES - LDSCTL_OFF) / 4; u += NWAVES * 64) ((LAS unsigned*)(F.lds + LDSCTL_OFF))[u] = 0u;
    __syncthreads();
    if (N_LAUNCHES != PER_PHASE) (void)xcd_barrier_post((unsigned*)(F.ctl + CW_BAR), F.MISC + 8);
#define GRID_BAR() do { if (N_LAUNCHES == PER_PHASE) { if (F.tid == 0) __hip_atomic_store(F.ctl + CW_TMO, 0xBADBA0u, RLX_AGENT); } else { \
        XcdBarrier bb_; bb_.bar = (unsigned*)(F.ctl + CW_BAR); bb_.x = xb_xcc_id(); bb_.st = (volatile LAS unsigned*)(F.lds + MISC_OFF) + 8; bb_.wv = wave_s; xcd_barrier(bb_); } } while (0)
#define PHASE_BEGIN() do { int l_ = (int)__builtin_amdgcn_mbcnt_hi(~0u, __builtin_amdgcn_mbcnt_lo(~0u, 0u)); asm volatile("" : "+v"(l_)); F.lane = l_; F.wave = wave_s; F.tid = wave_s * 64 + l_; \
        unsigned long long w_ = (unsigned long long)args.ws; asm volatile("" : "+s"(w_)); ws = (unsigned char*)(GAS unsigned char*)w_; F.ws = ws; F.ctl = (gu32*)(ws + WS_CTL); } while (0)
    const int lo = args.ph_lo, hi = args.ph_hi;
#ifndef PHASE_MASK
#define PHASE_MASK 0x1FFF
#endif
#define IN(k) (lo <= (k) && (k) < hi && ((PHASE_MASK >> (k)) & 1))
#define BOTH(k) (IN(k) && IN((k) + 1))
#ifndef REP_MASK
#define REP_MASK 0
#endif
#define REPS(k) (((REP_MASK >> (k)) & 1) ? 2 : 1)
    unsigned char* ws = args.ws;
    const size_t TS1024 = (size_t)256 * 1024 * 2, TS512 = (size_t)256 * 512 * 2, TS256 = (size_t)256 * 256 * 2;

    if (IN(0)) for (int rep_ = 0; rep_ < REPS(0); ++rep_) { PHASE_BEGIN(); p0_prologue(F); if (BOTH(0)) GRID_BAR(); }
    if (IN(1)) for (int rep_ = 0; rep_ < REPS(1); ++rep_) {
        PHASE_BEGIN();
        DenseOrder S; S.init(NTOK, DIN, F.G, (int)blockIdx.x); S.A = (const char*)(ws + WS_B); S.Bt = (const char*)(ws + WS_WIN); S.tstep = TS1024;
        EpiP1 E{(bf16*)(ws + WS_C), (bf16*)(ws + WS_C + 16 * MiB), (bf16*)F.out, F.in[I_BGATE]};
        pg8::gemm_phase<EpiP1, DenseOrder>(F.lds + RING_OFF, F.tid, D, S, E);
        {
            const int nfull = (NTOK / 256) * (DIN / 256) / F.G, heavy = (NTOK / 256) * (DIN / 256) - nfull * F.G;
            const int nl = F.G - heavy; const bool spread = heavy > 0 && 2 * nl >= (NTOK / 256) * (D / 256);
            DenseOrder S2; S2.A = (const char*)(ws + WS_PB); S2.Bt = (const char*)(ws + WS_WPLE); S2.tstep = TS256;
            if (spread) S2.init(NTOK, D, nl, (int)blockIdx.x - heavy); else S2.init(NTOK, D, F.G, (int)blockIdx.x);
            EpiE E2{(bf16*)(ws + WS_E + 32 * MiB)};
            if (!spread || (int)blockIdx.x >= heavy) pg8::gemm_phase<EpiE, DenseOrder>(F.lds + RING_OFF, F.tid, DPLE, S2, E2);
        }
        if (BOTH(1)) GRID_BAR();
    }
    if (IN(2)) for (int rep_ = 0; rep_ < REPS(2); ++rep_) {
        PHASE_BEGIN();
#ifndef NO_SSM
        for (int u = F.vcu; u < 8 * NGRP; u += F.G) { const int x = u / 32, idx = u % 32; ssm_unit(F, idx & 7, 4 * x + (idx >> 3)); }
#endif
#ifndef NO_CONV
        PHASE_BEGIN();
        for (int t = blockIdx.x; t < NTOK / 64; t += F.G) conv_tile(F, t);
#endif
        if (BOTH(2)) GRID_BAR();
    }
    if (IN(3)) for (int rep_ = 0; rep_ < REPS(3); ++rep_) {
        PHASE_BEGIN();
        DenseOrder S; S.init(NTOK, 2 * D, F.G, (int)blockIdx.x); S.A = (const char*)(ws + WS_B); S.Bt = (const char*)(ws + WS_WGLU); S.tstep = TS512;
        EpiGlu E{(bf16*)(ws + WS_E), (const bf16*)F.out};
        pg8::gemm_phase<EpiGlu, DenseOrder>(F.lds + RING_OFF, F.tid, DSSM, S, E);
        if (BOTH(3)) GRID_BAR();
    }
    if (IN(4)) for (int rep_ = 0; rep_ < REPS(4); ++rep_) {
        PHASE_BEGIN();
        DenseOrder S; S.init(NTOK, D, F.G, (int)blockIdx.x); S.A = (const char*)(ws + WS_B + 16 * MiB); S.Bt = (const char*)(ws + WS_WCO); S.tstep = TS512;
        EpiCo E{(const bf16*)(ws + WS_E), (const bf16*)F.out, (bf16*)(ws + WS_C)};
        pg8::gemm_phase<EpiCo, DenseOrder>(F.lds + RING_OFF, F.tid, DCONV, S, E);
        if (BOTH(4)) GRID_BAR();
    }
    if (IN(5)) for (int rep_ = 0; rep_ < REPS(5); ++rep_) {
        PHASE_BEGIN();
        DenseOrder S; S.init(NTOK, D, F.G, (int)blockIdx.x); S.A = (const char*)(ws + WS_C); S.Bt = (const char*)(ws + WS_WO); S.tstep = TS1024;
        EpiRes E{F.in[I_X], (bf16*)(ws + WS_B), ws + WS_E};
        pg8::gemm_phase<EpiRes, DenseOrder>(F.lds + RING_OFF, F.tid, D, S, E);
        if (BOTH(5)) GRID_BAR();
    }
    if (IN(6)) for (int rep_ = 0; rep_ < REPS(6); ++rep_) { PHASE_BEGIN(); router_phase(F); if (BOTH(6)) GRID_BAR();
        if (rep_ + 1 < REPS(6)) { if (blockIdx.x == 0 && F.tid < NEXP) __hip_atomic_store((unsigned*)(F.ctl + CW_ECNT + 64 * F.tid), 0u, RLX_AGENT); GRID_BAR(); } }
    if (IN(7)) for (int rep_ = 0; rep_ < REPS(7); ++rep_) {
        PHASE_BEGIN();
        moe_tables(F);
        MoeOrder S; S.tb = (const LAS int*)(F.lds + TB_OFF); S.cn = S.tb + 33; S.G = F.G; S.c = F.vcu; S.K = D / 2; S.npn = 4;
        S.A = (const char*)(ws + WS_E); S.Bt = (const char*)(ws + WS_WGU); S.b_estride = (size_t)D * D; S.ltok = (const int*)(ws + WS_LTOK); S.gather = true;
        EpiAct E{(bf16*)(ws + WS_C), (const int*)(ws + WS_LTOK), (const float*)(ws + WS_R2)};
        pg8::gemm_phase<EpiAct, MoeOrder, true, true, true>(F.lds + RING_OFF, F.tid, D / 2, S, E);
        if (BOTH(7)) GRID_BAR();
    }
    if (IN(8)) for (int rep_ = 0; rep_ < REPS(8); ++rep_) {
        PHASE_BEGIN();
        moe_tables(F);
        MoeOrder S; S.tb = (const LAS int*)(F.lds + TB_OFF); S.cn = S.tb + 33; S.G = F.G; S.c = F.vcu; S.K = DEXP; S.npn = 4;
        S.A = (const char*)(ws + WS_C); S.Bt = (const char*)(ws + WS_WD); S.b_estride = (size_t)D * DEXP * 2; S.ltok = (const int*)(ws + WS_LTOK); S.gather = false;
        EpiY E{(bf16*)F.out};
        pg8::gemm_phase<EpiY, MoeOrder, false>(F.lds + RING_OFF, F.tid, DEXP, S, E);
        if (BOTH(8)) GRID_BAR();
    }
    if (IN(9)) for (int rep_ = 0; rep_ < REPS(9); ++rep_) { PHASE_BEGIN(); moe_tables(F); moe_combine_rows(F, (const bf16*)(ws + WS_B), (const bf16*)F.out, (bf16*)(ws + WS_E), (float*)(ws + WS_R3)); if (BOTH(9)) GRID_BAR(); }
#ifdef DBG_SG_COPY
    if (lo <= 10 && 10 < hi) { const int gt = F.vcu * 512 + (int)threadIdx.x, NGT = F.G * 512; const bf16* sgp = (const bf16*)args.out + (size_t)DBG_SG_COPY * NTOK * D; float* dst = (float*)(args.ws + WS_E);
        for (int q = gt; q < NTOK * D; q += NGT) { const float v = bflo((unsigned)sgp[q]); const int col = q & 2047;
#ifdef DBG_SG_SEL_LO
            dst[q] = (v >= 0.f && v <= 1.f) ? 0.f : ((col >= DBG_SG_SEL_LO && col < DBG_SG_SEL_HI) ? 1000.f : 0.f);
#else
            dst[q] = v;
#endif
        } }
#endif
    if (IN(11)) for (int rep_ = 0; rep_ < REPS(11); ++rep_) {
        PHASE_BEGIN();
        DenseOrder S; S.init(NTOK, D, F.G, (int)blockIdx.x); S.A = (const char*)(ws + WS_E); S.Bt = (const char*)(ws + WS_WPG); S.tstep = TS1024;
        EpiPle E{(const bf16*)(ws + WS_E), (const bf16*)(ws + WS_E + 32 * MiB), (const float*)(ws + WS_R3), (bf16*)(ws + WS_C)};
        pg8::gemm_phase<EpiPle, DenseOrder>(F.lds + RING_OFF, F.tid, D, S, E);
        if (BOTH(11)) GRID_BAR();
    }
#ifdef DBG_DUMP_OFF
    if (hi == PER_PHASE) {   PHASE_BEGIN();
        const int gt = F.vcu * 512 + F.tid, NGT = F.G * 512;
#if DBG_DUMP_BF16
        const bf16* src = (const bf16*)(ws + (size_t)DBG_DUMP_OFF);
        for (int q = gt; q < NTOK * D; q += NGT) F.out[q] = bflo((unsigned)src[q]);
#else
        const float* src = (const float*)(ws + (size_t)DBG_DUMP_OFF);
        for (int q = gt; q < NTOK * D; q += NGT) F.out[q] = src[q];
#endif
    }
#else
    if (IN(12)) for (int rep_ = 0; rep_ < REPS(12); ++rep_) { PHASE_BEGIN(); final_norm(F, (const bf16*)(ws + WS_C), F.out, F.in[I_GFIN]); }
#endif
#undef IN
#undef BOTH
}

extern "C" void kernel_launch(void* const* d_in, const int* in_sizes, int n_in, void* d_out, int out_size, void* d_ws, size_t ws_size, hipStream_t stream) {
    static int grid = 0;
    if (grid == 0) {
        if (n_in != N_IN || in_sizes[0] != NTOK * D || out_size != NTOK * D || ws_size < WS_END) { fprintf(stderr, "kernel_launch: unexpected shapes (n_in %d, in0 %d, out %d, ws %zu; need ws >= %zu); nothing launched\n", n_in, n_in > 0 ? in_sizes[0] : -1, out_size, ws_size, (size_t)WS_END); grid = -1; return; }
        int dev = 0, cus = 0, per_cu = 0;
        if (hipGetDevice(&dev) != hipSuccess || hipDeviceGetAttribute(&cus, hipDeviceAttributeMultiprocessorCount, dev) != hipSuccess) { grid = -1; return; }
        if (hipFuncSetAttribute((const void*)mk_fwd, hipFuncAttributeMaxDynamicSharedMemorySize, LDS_BYTES) != hipSuccess) { fprintf(stderr, "kernel_launch: hipFuncSetAttribute failed\n"); grid = -1; return; }
        if (hipOccupancyMaxActiveBlocksPerMultiprocessor(&per_cu, (const void*)mk_fwd, NWAVES * 64, LDS_BYTES) != hipSuccess || per_cu < 1) { fprintf(stderr, "kernel_launch: occupancy query reports %d workgroups per CU\n", per_cu); (void)hipGetLastError(); grid = -1; return; }
        grid = cus;
    }
    if (grid < 0) return;
    if (hipMemsetAsync((char*)d_ws + WS_CTL, 0, CTL_ZERO_BYTES, stream) != hipSuccess) return;
    Args a{};
    for (int i = 0; i < N_IN; ++i) a.in[i] = (const float*)d_in[i];
    a.out = (float*)d_out; a.ws = (unsigned char*)d_ws;
    for (int li = 0; li < N_LAUNCHES; ++li) {
        a.ph_lo = (N_LAUNCHES == PER_PHASE) ? li : 0; a.ph_hi = (N_LAUNCHES == PER_PHASE) ? li + 1 : PER_PHASE;
        hipLaunchKernelGGL(mk_fwd, dim3(grid), dim3(NWAVES * 64), LDS_BYTES, stream, a);
        if (hipPeekAtLastError() != hipSuccess) { fprintf(stderr, "kernel_launch: launch %d failed\n", li); break; }
    }
}
```

```cpp
#include <hip/hip_runtime.h>
#include <cstdio>
#include <cstdint>

namespace pg8 {
#define PG8_LAS __attribute__((address_space(3)))
typedef unsigned short bf16_t;
typedef short bf16x8 __attribute__((ext_vector_type(8)));
typedef float f32x4 __attribute__((ext_vector_type(4)));
typedef unsigned u32x4 __attribute__((ext_vector_type(4)));
typedef unsigned u32x2 __attribute__((ext_vector_type(2)));
constexpr int BM = 256, BK = 64, HALF = 128, HTB = HALF * BK * 2  , STAGE_BYTES = 8 * HTB, NXCD = 8, WGM = 8;

__host__ __device__ __forceinline__ int lds_byte(int r, int c) { const int st = (r >> 4) * 2 + (c >> 5), rr = r & 15, cc = c & 31, ob = rr * 64 + cc * 2; return st * 1024 + (ob ^ (((ob >> 9) & 1) << 5)); }
__host__ __device__ __forceinline__ void stage_rc(int b, int& R, int& C) { const int st = b / 1024, sb = b % 1024, swz = sb ^ (((sb >> 9) & 1) << 5); R = (st >> 1) * 16 + swz / 64; C = (st & 1) * 32 + (swz % 64) / 2; }
__host__ __device__ __forceinline__ int perm32(int rho) { const int n = rho >> 4, i = rho & 15; return 8 * (i >> 2) + 4 * n + (i & 3); }

struct Unit { int pm, pn, e, rows, mt, cb; };

typedef float cvt_f32x2 __attribute__((ext_vector_type(2)));
typedef __bf16 cvt_bf16x2 __attribute__((ext_vector_type(2)));
__device__ __forceinline__ unsigned cvt_pk_bf16(float lo, float hi) { const cvt_f32x2 v = {lo, hi}; const cvt_bf16x2 b = __builtin_convertvector(v, cvt_bf16x2); return __builtin_bit_cast(unsigned, b); }

struct StaticOrder {
    int nM, nN, nwg, G, c;
    __host__ __device__ void init(int M, int N, int G_, int c_) { nM = M / BM; nN = N / BM; nwg = nM * nN; G = G_; c = c_; }
    __host__ __device__ bool next(int i, Unit& u) const {
        const long L = (long)i * G + c; if (L >= nwg) return false;
        int wgid = (int)L; { const int q = nwg / NXCD, r = nwg % NXCD, xcd = wgid % NXCD, off = wgid / NXCD; wgid = (xcd < r ? xcd * (q + 1) : r * (q + 1) + (xcd - r) * q) + off; }
        const int nig = WGM * nN, gid = wgid / nig, fm = gid * WGM, gsz = (nM - fm) < WGM ? (nM - fm) : WGM;
        u.pm = fm + ((wgid % nig) % gsz); u.pn = (wgid % nig) / gsz; u.e = 0; u.rows = BM; u.mt = 0; u.cb = 0; return true;
    }
};

template <class Epi, class Sched, bool GATHER = false, bool ALIGN_EPI = true, bool F8 = false>
__device__ __forceinline__ void gemm_phase(PG8_LAS unsigned char* lds, const int tid, const int K_, const Sched& S, const Epi& E) {
    int K = K_; asm volatile("" : "+s"(K));
    const int wid = __builtin_amdgcn_readfirstlane(tid >> 6), lane = tid & 63, wr = wid >> 2, wc = wid & 3, fr = lane & 15, fq = lane >> 4;
    const int nt = K / BK;
    unsigned voffA[2], voffB[2]; int rowA[2], colA[2];
#pragma unroll
    for (int i = 0; i < 2; ++i) { int R, C; stage_rc(tid * 16 + i * 8192, R, C); const int Rb = (R & ~31) + perm32(R & 31);
        voffA[i] = (unsigned)(R * K + C) * 2u; voffB[i] = (unsigned)(Rb * K + C) * 2u; rowA[i] = R; colA[i] = C * 2; }
    const size_t kstep = (size_t)(BK * 2);
    const unsigned hstep = (unsigned)HALF * (unsigned)K * 2u;
    const unsigned ldsw = (unsigned)wid * 1024u;
    const int aoff = lds_byte(wr * 64 + fr, fq * 8), boff = lds_byte(wc * 32 + fr, fq * 8);
#define PG8_SA(b, h) (((b) * 2 + (h)) * HTB)
#define PG8_SB(b, h) ((4 + (b) * 2 + (h)) * HTB)
#define PG8_STAGE(bufoff, gbase, voff) do { _Pragma("unroll") for (int _i = 0; _i < 2; ++_i) \
        __builtin_amdgcn_global_load_lds((const unsigned*)((const char*)(gbase) + (voff)[_i]), (PG8_LAS unsigned*)(lds + (bufoff) + ldsw + _i * 8192), 16, 0, 0); } while (0)
#define PG8_STAGE_A(bufoff, gbase, V, h) do { _Pragma("unroll") for (int _i = 0; _i < 2; ++_i) { const unsigned _o = GATHER ? (V)[h][_i] : (voffA[_i] + (unsigned)(h) * hstep); \
        __builtin_amdgcn_global_load_lds((const unsigned*)((const char*)(gbase) + _o), (PG8_LAS unsigned*)(lds + (bufoff) + ldsw + _i * 8192), 16, 0, 0); } } while (0)
#define PG8_LDA(dst, b, h) do { _Pragma("unroll") for (int m = 0; m < 4; ++m) _Pragma("unroll") for (int k = 0; k < 2; ++k) dst[m][k] = *(const PG8_LAS bf16x8*)(lds + PG8_SA(b, h) + aoff + m * 2048 + k * 1024); } while (0)
#define PG8_LDB(dst, b, h) do { _Pragma("unroll") for (int n = 0; n < 2; ++n) _Pragma("unroll") for (int k = 0; k < 2; ++k) dst[n][k] = *(const PG8_LAS bf16x8*)(lds + PG8_SB(b, h) + boff + n * 2048 + k * 1024); } while (0)
#define PG8_MMA(ai, bj, At, Bt) do { __builtin_amdgcn_s_setprio(1); _Pragma("unroll") for (int m = 0; m < 4; ++m) _Pragma("unroll") for (int n = 0; n < 2; ++n) { \
        if constexpr (F8) { typedef int v4i_ __attribute__((ext_vector_type(4))); typedef int v8i_ __attribute__((ext_vector_type(8))); \
            const v8i_ fa_ = __builtin_shufflevector(__builtin_bit_cast(v4i_, Bt[n][0]), __builtin_bit_cast(v4i_, Bt[n][1]), 0, 1, 2, 3, 4, 5, 6, 7), fb_ = __builtin_shufflevector(__builtin_bit_cast(v4i_, At[m][0]), __builtin_bit_cast(v4i_, At[m][1]), 0, 1, 2, 3, 4, 5, 6, 7); \
            acc[ai][bj][m][n] = __builtin_amdgcn_mfma_scale_f32_16x16x128_f8f6f4(fa_, fb_, acc[ai][bj][m][n], 0, 0, 0, 0x7f7f7f7f, 0, 0x7f7f7f7f); } \
        else { _Pragma("unroll") for (int k = 0; k < 2; ++k) acc[ai][bj][m][n] = __builtin_amdgcn_mfma_f32_16x16x32_bf16(Bt[n][k], At[m][k], acc[ai][bj][m][n], 0, 0, 0); } } __builtin_amdgcn_s_setprio(0); } while (0)
#define PG8_WAIT_V(n) asm volatile("s_waitcnt vmcnt(" #n ")" ::: "memory")
#define PG8_WAIT_L(n) asm volatile("s_waitcnt lgkmcnt(" #n ")" ::: "memory")
#define PG8_BAR __builtin_amdgcn_s_barrier()
#define PG8_SCHED __builtin_amdgcn_sched_barrier(0)
    Unit cur, nxt; int ui = 0;
    if (!S.next(0, cur)) return;
    f32x4 acc[2][2][4][2];
#pragma unroll
    for (int a = 0; a < 2; ++a)
#pragma unroll
        for (int b = 0; b < 2; ++b)
#pragma unroll
            for (int m = 0; m < 4; ++m)
#pragma unroll
                for (int n = 0; n < 2; ++n) acc[a][b][m][n] = (f32x4){0.f, 0.f, 0.f, 0.f};
    bf16x8 At[4][2], B0[2][2], B1[2][2];
    unsigned cva[2][2] = {{0u, 0u}, {0u, 0u}}, nva[2][2] = {{0u, 0u}, {0u, 0u}};
    const char* cA = S.a_base(cur); const char* cB = S.b_base(cur);
    if constexpr (GATHER) {
#pragma unroll
        for (int h = 0; h < 2; ++h)
#pragma unroll
            for (int i = 0; i < 2; ++i) cva[h][i] = S.row_off(cur, h * HALF + rowA[i]) + (unsigned)colA[i];
    }
    PG8_STAGE(PG8_SB(0, 0), cB, voffB); PG8_STAGE(PG8_SB(0, 1), cB + hstep, voffB); PG8_STAGE_A(PG8_SA(0, 0), cA, cva, 0); PG8_STAGE_A(PG8_SA(0, 1), cA, cva, 1);
    if (wr == 1) PG8_BAR;
    PG8_WAIT_V(2); PG8_BAR;
    PG8_STAGE(PG8_SB(1, 0), cB + kstep, voffB); PG8_STAGE_A(PG8_SA(1, 0), cA + kstep, cva, 0); PG8_STAGE(PG8_SB(1, 1), cB + hstep + kstep, voffB);
    PG8_WAIT_V(6); PG8_BAR;
    for (;;) {
        const bool has_next = S.next(ui + 1, nxt);
        const char* nA = has_next ? S.a_base(nxt) : cA; const char* nB = has_next ? S.b_base(nxt) : cB;
        if constexpr (GATHER) {
#pragma unroll
            for (int h = 0; h < 2; ++h)
#pragma unroll
                for (int i = 0; i < 2; ++i) nva[h][i] = has_next ? (S.row_off(nxt, h * HALF + rowA[i]) + (unsigned)colA[i]) : cva[h][i];
        }
#pragma unroll 1
        for (int t = 0; t < nt; t += 2) {
            const bool last = (t == nt - 2);
            asm volatile("" : "+v"(voffA[0]), "+v"(voffA[1]), "+v"(voffB[0]), "+v"(voffB[1]));
            const char* a1 = cA + (size_t)(t + 1) * kstep;
            const char* a2 = last ? nA : cA + (size_t)(t + 2) * kstep; const char* b2 = last ? nB : cB + (size_t)(t + 2) * kstep;
            const char* a3 = a2 + kstep; const char* b3 = b2 + kstep;
            PG8_LDB(B0, 0, 0); PG8_LDB(B1, 0, 1); PG8_SCHED; PG8_LDA(At, 0, 0); PG8_STAGE_A(PG8_SA(1, 1), a1, cva, 1);
            if constexpr (GATHER) { if (last) {
#pragma unroll
                for (int h = 0; h < 2; ++h)
#pragma unroll
                    for (int i = 0; i < 2; ++i) cva[h][i] = nva[h][i]; } }
            PG8_WAIT_V(8); PG8_WAIT_L(0); PG8_BAR; PG8_MMA(0, 0, At, B0); PG8_MMA(0, 1, At, B1); PG8_BAR; PG8_SCHED;
            PG8_LDA(At, 0, 1); PG8_STAGE(PG8_SB(0, 0), b2, voffB); PG8_STAGE(PG8_SB(0, 1), b2 + hstep, voffB); PG8_STAGE_A(PG8_SA(0, 0), a2, cva, 0);
            PG8_WAIT_V(8); PG8_WAIT_L(0); PG8_BAR; PG8_MMA(1, 0, At, B0); PG8_MMA(1, 1, At, B1); PG8_BAR; PG8_SCHED;
            PG8_LDB(B0, 1, 0); PG8_LDB(B1, 1, 1); PG8_SCHED; PG8_LDA(At, 1, 0); PG8_STAGE_A(PG8_SA(0, 1), a2, cva, 1);
            PG8_WAIT_V(8); PG8_WAIT_L(0); PG8_BAR; PG8_MMA(0, 0, At, B0); PG8_MMA(0, 1, At, B1); PG8_BAR; PG8_SCHED;
            PG8_LDA(At, 1, 1); PG8_STAGE(PG8_SB(1, 0), b3, voffB); PG8_STAGE(PG8_SB(1, 1), b3 + hstep, voffB); PG8_STAGE_A(PG8_SA(1, 0), a3, cva, 0);
            PG8_WAIT_V(8); PG8_WAIT_L(0); PG8_BAR; PG8_MMA(1, 0, At, B0); PG8_MMA(1, 1, At, B1); PG8_BAR; PG8_SCHED;
        }
        if constexpr (ALIGN_EPI) { if (wr == 0) PG8_BAR; }
#ifdef DBG_EPI_NOP
        asm volatile("s_nop 15\n s_nop 15\n s_nop 15\n s_nop 15" ::: "memory");
#endif
        { int le_ = lane; asm volatile("" : "+v"(le_));
          E(acc, cur, wr, wc, le_ & 15, le_ >> 4); }
        if (!has_next) break;
#pragma unroll
        for (int a = 0; a < 2; ++a)
#pragma unroll
            for (int b = 0; b < 2; ++b)
#pragma unroll
                for (int m = 0; m < 4; ++m)
#pragma unroll
                    for (int n = 0; n < 2; ++n) acc[a][b][m][n] = (f32x4){0.f, 0.f, 0.f, 0.f};
        cur = nxt; cA = nA; cB = nB; ++ui;
        if constexpr (ALIGN_EPI) { if (wr == 1) PG8_BAR; }
    }
    PG8_WAIT_V(0);
    if constexpr (!ALIGN_EPI) { if (wr == 0) PG8_BAR; }
    PG8_BAR;
#undef PG8_SA
#undef PG8_SB
#undef PG8_STAGE
#undef PG8_STAGE_A
#undef PG8_LDA
#undef PG8_LDB
#undef PG8_MMA
#undef PG8_WAIT_V
#undef PG8_WAIT_L
#undef PG8_BAR
#undef PG8_SCHED
}
}

constexpr int NWAVES = 8;
#ifndef MK_N_LAUNCHES
#define MK_N_LAUNCHES 1
#endif
constexpr int PER_PHASE = 13;
constexpr int N_LAUNCHES = MK_N_LAUNCHES;

constexpr int NTOK = 16384, SEQ = 2048, D = 1024, DIN = 3584, DSSM = 512, DCONV = 512, NGRP = 32, NST = 64, GWID = 16, CONVW = 31;
constexpr int NEXP = 32, EPG = 8, DEXP = 512, DPLE = 256, LC = 32, NCH = 64;
constexpr float EPS = 1e-6f;
enum In { I_X = 0, I_P, I_GMIX, I_WIN, I_BGATE, I_ARE, I_AIM, I_LOGDT, I_BRE, I_BIM, I_CRE, I_CIM, I_SD, I_WGLU, I_CDW, I_CDWB, I_CLNG, I_CLNB, I_WCO, I_WOUT, I_GMOE, I_WRG, I_BRG, I_WRE, I_BRE2,
          I_WEG, I_WEU, I_WED, I_GPLE, I_WPG, I_WPLE, I_GFIN, N_IN };

constexpr size_t MiB = 1u << 20;
constexpr size_t WS_CTL = 0, CTL_ZERO_BYTES = 1 * MiB;
constexpr size_t WS_LTOK = 1 * MiB;
constexpr size_t WS_TINFO = 3 * MiB;
constexpr size_t WS_R2 = 5 * MiB, WS_R3 = WS_R2 + 65536, WS_LAM32 = WS_R3 + 65536, WS_WRT = WS_R2 + 262144;
constexpr size_t WS_WST = 6 * MiB;
constexpr size_t WS_BT2 = 10 * MiB;
constexpr size_t WS_WIN = 31 * MiB, WS_WGLU = 38 * MiB, WS_WCO = 40 * MiB, WS_WO = 41 * MiB, WS_WPG = 43 * MiB, WS_WPLE = 45 * MiB;
constexpr size_t WS_PB = 46 * MiB;
constexpr size_t WS_WGU = 54 * MiB;
constexpr size_t WS_X2F = 86 * MiB;
constexpr size_t WS_WD = 118 * MiB;
constexpr float W8S = 64.0f, W8I = 1.0f / 64.0f;
constexpr size_t WS_B = 150 * MiB;
constexpr size_t WS_C = 182 * MiB;
constexpr size_t WS_E = 224 * MiB;
constexpr size_t WS_END = 288 * MiB;
constexpr int CW_TMO = 0, CW_CODE = 1, CW_BAR = 4096, CW_ECNT = 16384;
static_assert((CW_ECNT + 64 * NEXP) * 4 <= (int)CTL_ZERO_BYTES, "CTL words inside the memset region");

constexpr int RING_OFF = 0, RING_BYTES = 131072;
constexpr int LDSCTL_OFF = RING_BYTES, MISC_OFF = LDSCTL_OFF + 320;
constexpr int TB_OFF = LDSCTL_OFF + 1024;
constexpr int LDS_BYTES = 147456;
static_assert(TB_OFF + 100 * 4 <= LDS_BYTES, "LDS map");

#define GAS __attribute__((address_space(1)))
#define LAS __attribute__((address_space(3)))
typedef unsigned short bf16;
typedef unsigned v4u __attribute__((ext_vector_type(4)));
typedef unsigned v2u __attribute__((ext_vector_type(2)));
typedef float f32x4 __attribute__((ext_vector_type(4)));
typedef short bf16x8 __attribute__((ext_vector_type(8)));
typedef GAS unsigned gu32;
#define RLX_AGENT __ATOMIC_RELAXED, __HIP_MEMORY_SCOPE_AGENT
#define LDS_WAIT() asm volatile("s_waitcnt lgkmcnt(0)" ::: "memory")
#define VM_WAIT() asm volatile("s_waitcnt vmcnt(0)" ::: "memory")
__device__ __forceinline__ unsigned f2bf(float f) { unsigned u = __builtin_bit_cast(unsigned, f); return (u + 0x7fffu + ((u >> 16) & 1u)) >> 16; }
__device__ __forceinline__ unsigned pk2(float lo, float hi) { return pg8::cvt_pk_bf16(lo, hi); }
__device__ __forceinline__ unsigned pk4f8(float a, float b, float c, float d) { int w = __builtin_amdgcn_cvt_pk_fp8_f32(a, b, 0, false); w = __builtin_amdgcn_cvt_pk_fp8_f32(c, d, w, true); return (unsigned)w; }
__device__ __forceinline__ float bflo(unsigned v) { return __builtin_bit_cast(float, v << 16); }
__device__ __forceinline__ float bfhi(unsigned v) { return __builtin_bit_cast(float, v & 0xffff0000u); }
__device__ __forceinline__ float sigm(float x) { return __builtin_amdgcn_rcpf(1.0f + __expf(-x)); }
__device__ __forceinline__ float gelu_tanh(float y) { const float t = 1.5957691216f * (y + 0.044715f * y * y * y); return y * sigm(t); }

#define XB_TMO      128
#define XB_XCNT(j)  (256  + 64 * (j))
#define XB_XSUB(j)  (1280 + 64 * (j))
#define XB_XGEN(j)  (2304 + 64 * (j))
#define XB_TOP      3328
#define XB_TOPGEN   3392
#define XCD_BAR_WORDS 3456
#define XB_SPIN_CAP (1u << 18)

__device__ __forceinline__ unsigned xb_ld(unsigned* p)              { return __hip_atomic_load(p, __ATOMIC_RELAXED, __HIP_MEMORY_SCOPE_AGENT); }
__device__ __forceinline__ unsigned xb_add(unsigned* p, unsigned v) { return __hip_atomic_fetch_add(p, v, __ATOMIC_RELAXED, __HIP_MEMORY_SCOPE_AGENT); }
__device__ __forceinline__ unsigned xb_xcc_id() { return (unsigned)__builtin_amdgcn_s_getreg((3 << 11) | 20) & 0xFu; }
#define XB_SPIN(cond, bar) do { unsigned _sp = 0; while (cond) { __builtin_amdgcn_s_sleep(1); \
    if ((++_sp & 255u) == 0u) { if (xb_ld(&(bar)[XB_TMO])) break; if (_sp > XB_SPIN_CAP) { atomicAdd(&(bar)[XB_TMO], 1u); break; } } } } while (0)

struct XcdBarrier {
    unsigned* bar; unsigned x;
    volatile LAS unsigned* st;
    int wv;
};

__device__ __forceinline__ XcdBarrier xcd_barrier_post(unsigned* bar, volatile LAS unsigned* st) {
    XcdBarrier b; b.bar = bar; b.x = xb_xcc_id(); b.st = st; b.wv = 0;
    if (threadIdx.x == 0) (void)xb_add(&bar[XB_XCNT(b.x)], 1u);
    return b;
}
__device__ __forceinline__ void xcd_barrier_complete(unsigned* bar, unsigned x, unsigned& nloc, unsigned& nx) {
    const unsigned G = gridDim.x * gridDim.y * gridDim.z;
    unsigned sum, cnt, mine, sp = 0u;
    for (;;) {
        sum = 0u; cnt = 0u; mine = 0u;
#pragma unroll
        for (unsigned j = 0; j < 16; ++j) { const unsigned c = xb_ld(&bar[XB_XCNT(j)]); sum += c; cnt += (c > 0u) ? 1u : 0u; mine = (j == x) ? c : mine; }
        if (sum == G) break;
        __builtin_amdgcn_s_sleep(1);
        if ((++sp & 255u) == 0u) { if (xb_ld(&bar[XB_TMO])) break; if (sp > XB_SPIN_CAP) { atomicAdd(&bar[XB_TMO], 1u); break; } }
    }
    nloc = mine > 0u ? mine : 1u; nx = cnt > 0u ? cnt : 1u;
}

__device__ __forceinline__ void xcd_barrier(const XcdBarrier& b) {
    asm volatile("s_waitcnt vmcnt(0)" ::: "memory");
    __syncthreads();
    if (b.wv == 0 && __builtin_amdgcn_mbcnt_hi(~0u, __builtin_amdgcn_mbcnt_lo(~0u, 0u)) == 0u) {
        unsigned* bar = b.bar;
        __builtin_amdgcn_s_waitcnt(0);
        unsigned nloc = b.st[0], nx = b.st[1];
        if (nloc == 0u) { xcd_barrier_complete(bar, b.x, nloc, nx); b.st[0] = nloc; b.st[1] = nx; }
        const unsigned old = xb_add(&bar[XB_XSUB(b.x)], 1u);
        const unsigned gen = old / nloc;
        if (old + 1u == (gen + 1u) * nloc) {
            __builtin_amdgcn_fence(__ATOMIC_RELEASE, "agent");
            asm volatile("s_waitcnt vmcnt(0)" ::: "memory");
            const unsigned og = xb_add(&bar[XB_TOP], 1u);
            const unsigned tg = og / nx;
            if (og + 1u == (tg + 1u) * nx) xb_add(&bar[XB_TOPGEN], 1u);
            else XB_SPIN(xb_ld(&bar[XB_TOPGEN]) == tg, bar);
            __builtin_amdgcn_fence(__ATOMIC_ACQUIRE, "agent");
            xb_add(&bar[XB_XGEN(b.x)], 1u);
            asm volatile("s_waitcnt vmcnt(0)" ::: "memory");
        } else {
            XB_SPIN(xb_ld(&bar[XB_XGEN(b.x)]) == gen, bar);
            __builtin_amdgcn_fence(__ATOMIC_ACQUIRE, "agent");
            asm volatile("s_waitcnt vmcnt(0)" ::: "memory");
        }
    }
    __syncthreads();
}

struct Frame {
    LAS unsigned char* lds;
    volatile LAS unsigned* MISC;
    gu32* ctl;
    int tid, lane, wave;
    int vcu, G;
    const float* const* in;
    float* out; unsigned char* ws;
};
__device__ __forceinline__ float wave_sum(float v) {
#pragma unroll
    for (int o = 1; o < 64; o <<= 1) v += __shfl_xor(v, o);
    return v;
}

__device__ __forceinline__ int map_glu(int base, int o, int gate) { return base + 8 * (o >> 2) + 4 * gate + (o & 3); }
__device__ __forceinline__ int dest_row(int mode, int n, int half) {
    if (mode == 0) return n;
    if (mode == 1) { if (n < 512) return n; if (n < 1024) return map_glu(512, n - 512, 0); if (n < 1536) return map_glu(512, n - 1024, 1); return n; }
    if (mode == 2) return n < half ? map_glu(0, n, 0) : map_glu(0, n - half, 1);
    if (mode == 3) return map_glu(0, n, 0);
    return map_glu(0, n, 1);
}
__device__ __forceinline__ void tr_item(const float* W, int K, int N, bf16* WT, int mode, int half, const float* ks, LAS unsigned* T, int item, int lane) {
    const int nblk = N / 64, kb = item / nblk, nb = item % nblk, k0 = 64 * kb, n0 = 64 * nb, nq = lane & 15, kq = lane >> 4;
    f32x4 v[8][2];
    const float* src = W + (size_t)(k0 + 2 * kq) * N + n0 + 4 * nq;
#pragma unroll
    for (int s = 0; s < 8; ++s) { v[s][0] = *(const GAS f32x4*)(src + (size_t)(8 * s) * N); v[s][1] = *(const GAS f32x4*)(src + (size_t)(8 * s + 1) * N); }
    if (ks) {
#pragma unroll
        for (int s = 0; s < 8; ++s) { const float a = ks[k0 + 8 * s + 2 * kq], b = ks[k0 + 8 * s + 2 * kq + 1]; v[s][0] *= a; v[s][1] *= b; } }
#pragma unroll
    for (int s = 0; s < 8; ++s)
#pragma unroll
        for (int jj = 0; jj < 4; ++jj) T[(4 * nq + jj) * 33 + 4 * s + kq] = pk2(v[s][0][jj], v[s][1][jj]);
    LDS_WAIT(); asm volatile("" ::: "memory");
    const int c = lane & 7;
#pragma unroll
    for (int i = 0; i < 8; ++i) { const int n = (lane >> 3) + 8 * i; const LAS unsigned* t = T + n * 33 + 4 * c;
        v4u o; o.x = t[0]; o.y = t[1]; o.z = t[2]; o.w = t[3];
        *(GAS v4u*)(WT + (size_t)dest_row(mode, n0 + n, half) * K + k0 + 8 * c) = o; }
    LDS_WAIT(); asm volatile("" ::: "memory");
}
__device__ __forceinline__ void tr_item8(const float* W, int K, int N, unsigned char* WT, int mode, int half, const float* ks, float sc, LAS unsigned* T, int item, int lane) {
    const int nblk = N / 64, kb = item / nblk, nb = item % nblk, k0 = 64 * kb, n0 = 64 * nb, nq = lane & 15, kq = lane >> 4;
    f32x4 v[4][4];
    const float* src = W + (size_t)(k0 + 4 * kq) * N + n0 + 4 * nq;
#pragma unroll
    for (int s = 0; s < 4; ++s)
#pragma unroll
        for (int r = 0; r < 4; ++r) v[s][r] = *(const GAS f32x4*)(src + (size_t)(16 * s + r) * N);
#pragma unroll
    for (int s = 0; s < 4; ++s)
#pragma unroll
        for (int r = 0; r < 4; ++r) v[s][r] *= ks ? ks[k0 + 16 * s + 4 * kq + r] * sc : sc;
#pragma unroll
    for (int s = 0; s < 4; ++s)
#pragma unroll
        for (int jj = 0; jj < 4; ++jj) T[(4 * nq + jj) * 17 + 4 * s + kq] = pk4f8(v[s][0][jj], v[s][1][jj], v[s][2][jj], v[s][3][jj]);
    LDS_WAIT(); asm volatile("" ::: "memory");
    const int c = lane & 3;
#pragma unroll
    for (int i = 0; i < 4; ++i) { const int n = (lane >> 2) + 16 * i; const LAS unsigned* t = T + n * 17 + 4 * c;
        v4u o; o.x = t[0]; o.y = t[1]; o.z = t[2]; o.w = t[3];
        *(GAS v4u*)(WT + (size_t)dest_row(mode, n0 + n, half) * K + k0 + 16 * c) = o; }
    LDS_WAIT(); asm volatile("" ::: "memory");
}
__device__ __forceinline__ void ssm_tables(Frame& F, int g) {
    LAS float* LP = (LAS float*)F.lds;
    LAS float* BB = LP + 33 * 64 * 2;
    LAS float* CC = BB + 2048;
    LAS float* KT = CC + 2048;
    const float* a_re = F.in[I_ARE]; const float* a_im = F.in[I_AIM]; const float* b_re = F.in[I_BRE]; const float* b_im = F.in[I_BIM];
    const float* c_re = F.in[I_CRE]; const float* c_im = F.in[I_CIM]; const float* sd = F.in[I_SD];
    {   const int n = F.tid & 63, tq = F.tid >> 6; const float dt = expf(F.in[I_LOGDT][g]); const float ar = a_re[g * 64 + n], ai = a_im[g * 64 + n]; const float bm = ar * dt, ba = ai * dt;
        for (int tau = tq; tau <= 32; tau += 8) { const float mag = expf(bm * (float)tau); float sn, cs; sincosf(ba * (float)tau, &sn, &cs); LP[(tau * 64 + n) * 2] = mag * cs; LP[(tau * 64 + n) * 2 + 1] = mag * sn; }
        const float mag = expf(bm); float sn, cs; sincosf(ba, &sn, &cs); const float lr = mag * cs, li = mag * sn;
        const float den = ar * ar + ai * ai, nr = lr - 1.0f, ni = li; const float zr = (nr * ar + ni * ai) / den, zi = (ni * ar - nr * ai) / den;
#pragma unroll
        for (int k = 0; k < 2; ++k) { const int ch = 2 * tq + k; const float br = b_re[(g * 64 + n) * 16 + ch], bi = b_im[(g * 64 + n) * 16 + ch];
            BB[(n * 16 + ch) * 2] = zr * br - zi * bi; BB[(n * 16 + ch) * 2 + 1] = zr * bi + zi * br; } }
    for (int e = F.tid; e < 1024; e += 512) { CC[e * 2] = c_re[g * 1024 + e]; CC[e * 2 + 1] = c_im[g * 1024 + e]; }
    __syncthreads();
    if (F.tid < 64) { float* l32 = (float*)(F.ws + WS_LAM32); l32[(g * 64 + F.tid) * 2] = LP[(32 * 64 + F.tid) * 2]; l32[(g * 64 + F.tid) * 2 + 1] = LP[(32 * 64 + F.tid) * 2 + 1]; }
    {
        const int p = F.tid & 255, cp = p >> 4, ch = p & 15, t0 = (F.tid >> 8) * 16; float kacc[16];
#pragma unroll
        for (int t = 0; t < 16; ++t) kacc[t] = 0.f;
        for (int n = 0; n < 64; ++n) {
            const float cr = CC[(cp * 64 + n) * 2], ci = CC[(cp * 64 + n) * 2 + 1], br = BB[(n * 16 + ch) * 2], bi = BB[(n * 16 + ch) * 2 + 1];
            const float pr = cr * br - ci * bi, pi = cr * bi + ci * br, l0r = LP[(t0 * 64 + n) * 2], l0i = LP[(t0 * 64 + n) * 2 + 1], lr = LP[(64 + n) * 2], li = LP[(64 + n) * 2 + 1];
            float wr_ = pr * l0r - pi * l0i, wi_ = pr * l0i + pi * l0r;
#pragma unroll
            for (int t = 0; t < 16; ++t) { kacc[t] += wr_; const float nr = wr_ * lr - wi_ * li, ni = wr_ * li + wi_ * lr; wr_ = nr; wi_ = ni; }
        }
#pragma unroll
        for (int t = 0; t < 16; ++t) KT[((t0 + t) << 8) + p] = kacc[t];
    }
    __syncthreads();
    bf16* Bt2 = (bf16*)(F.ws + WS_BT2) + (size_t)g * 512 * 640;
    for (int q = F.tid; q < 512 * 80; q += 512) {
        const int R = q / 80, cc = q % 80, t = R >> 4, cp = R & 15; float v[8];
        if (cc < 64) { const int j = cc >> 1, chb = (cc & 1) * 8;
#pragma unroll
            for (int i = 0; i < 8; ++i) { const int ch = chb + i; float x = (t >= j) ? KT[((t - j) << 8) + cp * 16 + ch] : 0.f; if (t == j && ch == cp) x += sd[g * 16 + ch]; v[i] = x; }
        } else { const int nb = (cc - 64) * 4;
#pragma unroll
            for (int i = 0; i < 4; ++i) { const int n = nb + i; const float cr = CC[(cp * 64 + n) * 2], ci = CC[(cp * 64 + n) * 2 + 1], lr = LP[((t + 1) * 64 + n) * 2], li = LP[((t + 1) * 64 + n) * 2 + 1];
                v[2 * i] = cr * lr - ci * li; v[2 * i + 1] = -(cr * li + ci * lr); }
        }
        v4u o; o.x = pk2(v[0], v[1]); o.y = pk2(v[2], v[3]); o.z = pk2(v[4], v[5]); o.w = pk2(v[6], v[7]);
        *(GAS v4u*)(Bt2 + (size_t)R * 640 + cc * 8) = o;
    }
    bf16* WsT = (bf16*)(F.ws + WS_WST) + (size_t)g * 128 * 512;
    for (int q = F.tid; q < 128 * 64; q += 512) {
        const int R = q >> 6, cc = q & 63, n = R >> 1, ri = R & 1, j = cc >> 1, chb = (cc & 1) * 8; float v[8];
        const float lr = LP[((31 - j) * 64 + n) * 2], li = LP[((31 - j) * 64 + n) * 2 + 1];
#pragma unroll
        for (int i = 0; i < 8; ++i) { const float br = BB[(n * 16 + chb + i) * 2], bi = BB[(n * 16 + chb + i) * 2 + 1]; v[i] = ri == 0 ? (lr * br - li * bi) : (lr * bi + li * br); }
        v4u o; o.x = pk2(v[0], v[1]); o.y = pk2(v[2], v[3]); o.z = pk2(v[4], v[5]); o.w = pk2(v[6], v[7]);
        *(GAS v4u*)(WsT + (size_t)R * 512 + cc * 8) = o;
    }
    __syncthreads();
}
__device__ __forceinline__ void p0_prologue(Frame& F) {
    const bool split = F.G > NGRP; const bool tabler = split && (int)blockIdx.x < NGRP;
#ifndef P0_REP_TAB
#define P0_REP_TAB 1
#define P0_REP_TR 1
#define P0_REP_ROWS 1
#endif
    for (int rp_ = 0; rp_ < P0_REP_TAB; ++rp_)
    if (!split || tabler) for (int g = blockIdx.x; g < NGRP; g += F.G) ssm_tables(F, g);
    LAS unsigned* scr = (LAS unsigned*)(F.lds + RING_OFF + F.wave * 16384);
    const int gw = F.vcu * NWAVES + F.wave, NGW = F.G * NWAVES;
    constexpr int I_IN = 16 * 56, I_GLU = 8 * 32, I_CO = 8 * 16, I_O = 16 * 16, I_PG = 16 * 16, I_PLE = 4 * 16, I_EG = 16 * 8, I_ED = 8 * 16;
    constexpr int NITEMS = I_IN + I_GLU + I_CO + I_O + I_PG + I_PLE + NEXP * (2 * I_EG + I_ED);
    const int tw = split ? ((int)blockIdx.x - NGRP) * NWAVES + F.wave : gw, NTW = split ? (F.G - NGRP) * NWAVES : NGW;
    for (int rp_ = 0; rp_ < P0_REP_TR; ++rp_)
    if (!tabler) for (int it = tw; it < NITEMS; it += NTW) {
        int r = it;
        if (r < I_IN) { tr_item(F.in[I_WIN], D, DIN, (bf16*)(F.ws + WS_WIN), 1, 0, nullptr, scr, r, F.lane); continue; } r -= I_IN;
        if (r < I_GLU) { tr_item(F.in[I_WGLU], DSSM, 2 * D, (bf16*)(F.ws + WS_WGLU), 2, D, nullptr, scr, r, F.lane); continue; } r -= I_GLU;
        if (r < I_CO) { tr_item(F.in[I_WCO], DCONV, D, (bf16*)(F.ws + WS_WCO), 0, 0, nullptr, scr, r, F.lane); continue; } r -= I_CO;
        if (r < I_O) { tr_item(F.in[I_WOUT], D, D, (bf16*)(F.ws + WS_WO), 0, 0, nullptr, scr, r, F.lane); continue; } r -= I_O;
        if (r < I_PG) { tr_item8(F.in[I_WPG], D, D, F.ws + WS_WPG, 0, 0, F.in[I_GPLE], W8S, scr, r, F.lane); continue; } r -= I_PG;
        if (r < I_PLE) { tr_item(F.in[I_WPLE], DPLE, D, (bf16*)(F.ws + WS_WPLE), 0, 0, nullptr, scr, r, F.lane); continue; } r -= I_PLE;
        const int e = r / (2 * I_EG + I_ED); r -= e * (2 * I_EG + I_ED);
        if (r < I_EG) { tr_item8(F.in[I_WEG] + (size_t)e * D * DEXP, D, DEXP, F.ws + WS_WGU + (size_t)e * D * D, 3, 0, F.in[I_GMOE], W8S, scr, r, F.lane); continue; } r -= I_EG;
        if (r < I_EG) { tr_item8(F.in[I_WEU] + (size_t)e * D * DEXP, D, DEXP, F.ws + WS_WGU + (size_t)e * D * D, 4, 0, F.in[I_GMOE], W8S, scr, r, F.lane); continue; } r -= I_EG;
        tr_item8(F.in[I_WED] + (size_t)e * DEXP * D, DEXP, D, F.ws + WS_WD + (size_t)e * D * DEXP, 0, 0, nullptr, W8S, scr, r, F.lane);
    }
    for (int rp_ = 0; rp_ < P0_REP_ROWS; ++rp_) { const float* x = F.in[I_X]; const float* gm = F.in[I_GMIX]; bf16* XN = (bf16*)(F.ws + WS_B);
      f32x4 gv[4];
#pragma unroll
      for (int j = 0; j < 4; ++j) gv[j] = *(const f32x4*)(gm + 4 * F.lane + 256 * j);
      for (int m = gw; m < NTOK; m += NGW) {
        const GAS f32x4* xr = (const GAS f32x4*)(x + (size_t)m * D) + F.lane; f32x4 v[4]; float s = 0.f;
#pragma unroll
        for (int j = 0; j < 4; ++j) { v[j] = xr[64 * j]; s += (v[j].x * v[j].x + v[j].y * v[j].y) + (v[j].z * v[j].z + v[j].w * v[j].w); }
        const float r = 1.0f / sqrtf(wave_sum(s) * (1.f / D) + EPS);
        GAS v2u* o8 = (GAS v2u*)(XN + (size_t)m * D) + F.lane;
#pragma unroll
        for (int j = 0; j < 4; ++j) { v2u o; o.x = pk2(v[j].x * r * gv[j].x, v[j].y * r * gv[j].y); o.y = pk2(v[j].z * r * gv[j].z, v[j].w * r * gv[j].w); o8[64 * j] = o; }
      } }
    { const float* p = F.in[I_P]; bf16* PB = (bf16*)(F.ws + WS_PB); const int gt = F.vcu * 512 + F.tid, NGT = F.G * 512;
      for (int q = gt; q < NTOK * DPLE / 8; q += NGT) { const f32x4 a = *(const f32x4*)(p + (size_t)q * 8), b = *(const f32x4*)(p + (size_t)q * 8 + 4);
        v4u o; o.x = pk2(a.x, a.y); o.y = pk2(a.z, a.w); o.z = pk2(b.x, b.y); o.w = pk2(b.z, b.w); *(GAS v4u*)(PB + (size_t)q * 8) = o; }
      bf16* WRT = (bf16*)(F.ws + WS_WRT); const float* gmoe = F.in[I_GMOE];
      for (int q = gt; q < 48 * 1024; q += NGT) { const int o = q >> 10, k = q & 1023; float v = 0.f;
        if (o < 4) v = F.in[I_WRG][k * 4 + o] * gmoe[k]; else if (o < 36) v = F.in[I_WRE][k * 32 + (o - 4)] * gmoe[k];
        const unsigned h = f2bf(v); const float lo = v - __builtin_bit_cast(float, h << 16); WRT[q] = (bf16)h; WRT[48 * 1024 + q] = (bf16)f2bf(lo); } }
}

using pg8::Unit;
typedef const f32x4 (&AccRef)[2][2][4][2];
struct EpiP1 {
    bf16* U; bf16* Z; bf16* SG; const float* bg;
    __device__ __forceinline__ void operator()(AccRef acc, const Unit& u, int wr, int wc, int fr, int fq) const {
        const int r0 = u.pm * 256 + wr * 64 + fr;
        if (u.pn < 2) {
#pragma unroll
            for (int ai = 0; ai < 2; ++ai)
#pragma unroll
                for (int m = 0; m < 4; ++m) { const int r = r0 + ai * 128 + m * 16, b = r >> 11, t = r & 2047;
#pragma unroll
                    for (int bj = 0; bj < 2; ++bj) { const int c0 = u.pn * 256 + bj * 128 + wc * 32 + fq * 8, g = c0 >> 4, ch0 = c0 & 15;
                        const f32x4 v0 = acc[ai][bj][m][0], v1 = acc[ai][bj][m][1];
                        v4u w; w.x = pk2(v0[0], v0[1]); w.y = pk2(v0[2], v0[3]); w.z = pk2(v1[0], v1[1]); w.w = pk2(v1[2], v1[3]);
                        *(GAS v4u*)(U + (((size_t)(b * 32 + g) * 2048 + t) * 16 + ch0)) = w; } }
        } else if (u.pn < 6) {
#pragma unroll
            for (int ai = 0; ai < 2; ++ai)
#pragma unroll
                for (int m = 0; m < 4; ++m) { const int r = r0 + ai * 128 + m * 16;
#pragma unroll
                    for (int bj = 0; bj < 2; ++bj) { const int o0 = (u.pn - 2) * 128 + bj * 64 + wc * 16 + fq * 4;
                        const f32x4 va = acc[ai][bj][m][0], ga = acc[ai][bj][m][1];
                        v2u w; w.x = pk2(va[0] * sigm(ga[0]), va[1] * sigm(ga[1])); w.y = pk2(va[2] * sigm(ga[2]), va[3] * sigm(ga[3]));
                        *(GAS v2u*)(Z + (size_t)r * 512 + o0) = w; } }
        } else {
#pragma unroll
            for (int bj = 0; bj < 2; ++bj) { const int s0 = (u.pn - 6) * 256 + bj * 128 + wc * 32 + fq * 8;
#ifdef DBG_NO_BIAS
                const f32x4 b0 = (f32x4){0.f, 0.f, 0.f, 0.f}, b1 = b0;
#else
                const f32x4 b0 = *(const f32x4*)(bg + s0), b1 = *(const f32x4*)(bg + s0 + 4);
#endif
#pragma unroll
                for (int ai = 0; ai < 2; ++ai)
#pragma unroll
                    for (int m = 0; m < 4; ++m) { const int r = r0 + ai * 128 + m * 16;
#ifdef DBG_BIAS_ONLY
                        const f32x4 v0 = b0, v1 = b1;
#else
                        const f32x4 v0 = acc[ai][bj][m][0] + b0, v1 = acc[ai][bj][m][1] + b1;
#endif
                        v4u w; w.x = pk2(sigm(v0[0]), sigm(v0[1])); w.y = pk2(sigm(v0[2]), sigm(v0[3])); w.z = pk2(sigm(v1[0]), sigm(v1[1])); w.w = pk2(sigm(v1[2]), sigm(v1[3]));
#ifdef DBG_SG_CONST
                        w.x = w.y = w.z = w.w = 0x3f003f00u;
#endif
                        *(GAS v4u*)(SG + (size_t)r * 2048 + s0) = w; } }
        }
    }
};
struct EpiGlu {
    bf16* MS; const bf16* SG;
    static __device__ __forceinline__ void run(AccRef acc, const Unit& u, int wr, int wc, int fr, int fq, bf16* __restrict__ MS, const bf16* __restrict__ SG) {
        const int r0 = u.pm * 256 + wr * 64 + fr;
#pragma unroll
        for (int ai = 0; ai < 2; ++ai)
#pragma unroll
            for (int m = 0; m < 4; ++m) { const int r = r0 + ai * 128 + m * 16;
#pragma unroll
                for (int bj = 0; bj < 2; ++bj) { const int o0 = u.pn * 128 + bj * 64 + wc * 16 + fq * 4;
                    const v2u sg = *(const GAS v2u*)(SG + (size_t)r * 2048 + o0);
                    const f32x4 va = acc[ai][bj][m][0], ga = acc[ai][bj][m][1];
                    v2u o; o.x = pk2(va[0] * sigm(ga[0]) * bflo(sg.x), va[1] * sigm(ga[1]) * bfhi(sg.x)); o.y = pk2(va[2] * sigm(ga[2]) * bflo(sg.y), va[3] * sigm(ga[3]) * bfhi(sg.y));
                    *(GAS v2u*)(MS + (size_t)r * 1024 + o0) = o; } }
    }
    __device__ __forceinline__ void operator()(AccRef acc, const Unit& u, int wr, int wc, int fr, int fq) const { run(acc, u, wr, wc, fr, fq, MS, SG); }
};
struct EpiCo {
    const bf16* MS; const bf16* SG; bf16* MG;
    static __device__ __forceinline__ void run(AccRef acc, const Unit& u, int wr, int wc, int fr, int fq, const bf16* __restrict__ MS, const bf16* __restrict__ SG, bf16* __restrict__ MG) {
        const int r0 = u.pm * 256 + wr * 64 + fr;
#pragma unroll
        for (int ai = 0; ai < 2; ++ai)
#pragma unroll
            for (int m = 0; m < 4; ++m) { const int r = r0 + ai * 128 + m * 16;
#pragma unroll
                for (int bj = 0; bj < 2; ++bj) { const int c0 = u.pn * 256 + bj * 128 + wc * 32 + fq * 8;
                    const v4u ms = *(const GAS v4u*)(MS + (size_t)r * 1024 + c0);
                    const v4u sg = *(const GAS v4u*)(SG + (size_t)r * 2048 + 1024 + c0);
                    const f32x4 v0 = acc[ai][bj][m][0], v1 = acc[ai][bj][m][1];
                    v4u w; w.x = pk2(bflo(ms.x) + bflo(sg.x) * v0[0], bfhi(ms.x) + bfhi(sg.x) * v0[1]); w.y = pk2(bflo(ms.y) + bflo(sg.y) * v0[2], bfhi(ms.y) + bfhi(sg.y) * v0[3]);
                    w.z = pk2(bflo(ms.z) + bflo(sg.z) * v1[0], bfhi(ms.z) + bfhi(sg.z) * v1[1]); w.w = pk2(bflo(ms.w) + bflo(sg.w) * v1[2], bfhi(ms.w) + bfhi(sg.w) * v1[3]);
                    *(GAS v4u*)(MG + (size_t)r * 1024 + c0) = w; } }
    }
    __device__ __forceinline__ void operator()(AccRef acc, const Unit& u, int wr, int wc, int fr, int fq) const { run(acc, u, wr, wc, fr, fq, MS, SG, MG); }
};
struct EpiRes {
    const float* X; bf16* X1B; unsigned char* X1F;
    static __device__ __forceinline__ void run(AccRef acc, const Unit& u, int wr, int wc, int fr, int fq, const float* __restrict__ X, bf16* __restrict__ X1B, unsigned char* __restrict__ X1F) {
        const int r0 = u.pm * 256 + wr * 64 + fr;
#pragma unroll
        for (int ai = 0; ai < 2; ++ai)
#pragma unroll
            for (int m = 0; m < 4; ++m) { const int r = r0 + ai * 128 + m * 16;
#pragma unroll
                for (int bj = 0; bj < 2; ++bj) { const size_t o = (size_t)r * 1024 + u.pn * 256 + bj * 128 + wc * 32 + fq * 8;
                    const f32x4 x0 = *(const GAS f32x4*)(X + o) + acc[ai][bj][m][0], x1 = *(const GAS f32x4*)(X + o + 4) + acc[ai][bj][m][1];
                    v4u w; w.x = pk2(x0[0], x0[1]); w.y = pk2(x0[2], x0[3]); w.z = pk2(x1[0], x1[1]); w.w = pk2(x1[2], x1[3]);
                    *(GAS v4u*)(X1B + o) = w;
                    v2u f; f.x = pk4f8(x0[0], x0[1], x0[2], x0[3]); f.y = pk4f8(x1[0], x1[1], x1[2], x1[3]); *(GAS v2u*)(X1F + o) = f; } }
    }
    __device__ __forceinline__ void operator()(AccRef acc, const Unit& u, int wr, int wc, int fr, int fq) const { run(acc, u, wr, wc, fr, fq, X, X1B, X1F); }
};
struct EpiAct {
    unsigned char* ACT; const int* ltok; const float* R2;
    static __device__ __forceinline__ void run(AccRef acc, const Unit& u, int wr, int wc, int fr, int fq, unsigned char* __restrict__ ACT, const int* __restrict__ ltok, const float* __restrict__ R2) {
        float rr[2][4];
#pragma unroll
        for (int ai = 0; ai < 2; ++ai)
#pragma unroll
            for (int m = 0; m < 4; ++m) { const int rl = ai * 128 + wr * 64 + m * 16 + fr; const int tok = (rl < u.rows) ? ltok[u.e * NTOK + u.mt * 256 + rl] : 0; rr[ai][m] = R2[tok] * W8I; }
#pragma unroll
        for (int ai = 0; ai < 2; ++ai)
#pragma unroll
            for (int m = 0; m < 4; ++m) { const int rl = ai * 128 + wr * 64 + m * 16 + fr;
                if (rl < u.rows) {
#pragma unroll
                    for (int bj = 0; bj < 2; ++bj) { const int o0 = u.pn * 128 + bj * 64 + wc * 16 + fq * 4;
                        const f32x4 ga = acc[ai][bj][m][0] * rr[ai][m], ua = acc[ai][bj][m][1] * rr[ai][m];
                        *(GAS unsigned*)(ACT + (size_t)(u.pm * 256 + rl) * 512 + o0) = pk4f8(ga[0] * sigm(ga[0]) * ua[0], ga[1] * sigm(ga[1]) * ua[1], ga[2] * sigm(ga[2]) * ua[2], ga[3] * sigm(ga[3]) * ua[3]); } } }
    }
    __device__ __forceinline__ void operator()(AccRef acc, const Unit& u, int wr, int wc, int fr, int fq) const { run(acc, u, wr, wc, fr, fq, ACT, ltok, R2); }
};
struct EpiY {
    bf16* Y;
    __device__ __forceinline__ void operator()(AccRef acc, const Unit& u, int wr, int wc, int fr, int fq) const {
#pragma unroll
        for (int ai = 0; ai < 2; ++ai)
#pragma unroll
            for (int m = 0; m < 4; ++m) { const int rl = ai * 128 + wr * 64 + m * 16 + fr;
                if (rl < u.rows) {
#pragma unroll
                    for (int bj = 0; bj < 2; ++bj) { const f32x4 v0 = acc[ai][bj][m][0] * W8I, v1 = acc[ai][bj][m][1] * W8I;
                        v4u w; w.x = pk2(v0[0], v0[1]); w.y = pk2(v0[2], v0[3]); w.z = pk2(v1[0], v1[1]); w.w = pk2(v1[2], v1[3]);
                        *(GAS v4u*)(Y + (size_t)(u.cb + rl) * 1024 + u.pn * 256 + bj * 128 + wc * 32 + fq * 8) = w; } } }
    }
};
struct EpiE {
    bf16* EO;
    __device__ __forceinline__ void operator()(AccRef acc, const Unit& u, int wr, int wc, int fr, int fq) const {
        const int r0 = u.pm * 256 + wr * 64 + fr;
#pragma unroll
        for (int ai = 0; ai < 2; ++ai)
#pragma unroll
            for (int m = 0; m < 4; ++m) { const int r = r0 + ai * 128 + m * 16;
#pragma unroll
                for (int bj = 0; bj < 2; ++bj) { const size_t o = (size_t)r * 1024 + u.pn * 256 + bj * 128 + wc * 32 + fq * 8; const f32x4 v0 = acc[ai][bj][m][0], v1 = acc[ai][bj][m][1];
                    v4u w; w.x = pk2(v0[0], v0[1]); w.y = pk2(v0[2], v0[3]); w.z = pk2(v1[0], v1[1]); w.w = pk2(v1[2], v1[3]);
                    *(GAS v4u*)(EO + o) = w; } }
    }
};
struct EpiPle {
    const bf16* X2; const bf16* EO; const float* R3; bf16* X3;
    static __device__ __forceinline__ void run(AccRef acc, const Unit& u, int wr, int wc, int fr, int fq, const bf16* __restrict__ X2, const bf16* __restrict__ EO, const float* __restrict__ R3, bf16* __restrict__ X3) {
        const int r0 = u.pm * 256 + wr * 64 + fr;
#pragma unroll
        for (int ai = 0; ai < 2; ++ai)
#pragma unroll
            for (int m = 0; m < 4; ++m) { const int r = r0 + ai * 128 + m * 16; const float r3 = R3[r] * W8I;
#pragma unroll
                for (int bj = 0; bj < 2; ++bj) { const size_t o = (size_t)r * 1024 + u.pn * 256 + bj * 128 + wc * 32 + fq * 8;
                    const v4u x = *(const GAS v4u*)(X2 + o), e = *(const GAS v4u*)(EO + o);
                    const f32x4 a0 = acc[ai][bj][m][0] * r3, a1 = acc[ai][bj][m][1] * r3;
                    v4u w; w.x = pk2(bflo(x.x) + sigm(a0[0]) * bflo(e.x), bfhi(x.x) + sigm(a0[1]) * bfhi(e.x)); w.y = pk2(bflo(x.y) + sigm(a0[2]) * bflo(e.y), bfhi(x.y) + sigm(a0[3]) * bfhi(e.y));
                    w.z = pk2(bflo(x.z) + sigm(a1[0]) * bflo(e.z), bfhi(x.z) + sigm(a1[1]) * bfhi(e.z)); w.w = pk2(bflo(x.w) + sigm(a1[2]) * bflo(e.w), bfhi(x.w) + sigm(a1[3]) * bfhi(e.w));
                    *(GAS v4u*)(X3 + o) = w; } }
    }
    __device__ __forceinline__ void operator()(AccRef acc, const Unit& u, int wr, int wc, int fr, int fq) const { run(acc, u, wr, wc, fr, fq, X2, EO, R3, X3); }
};
struct DenseOrder : pg8::StaticOrder {
    const char* A; const char* Bt; size_t tstep;
    __device__ __forceinline__ const char* a_base(const Unit& u) const { return A + (size_t)u.pm * tstep; }
    __device__ __forceinline__ const char* b_base(const Unit& u) const { return Bt + (size_t)u.pn * tstep; }
    __device__ __forceinline__ unsigned row_off(const Unit&, int) const { return 0u; }
};
struct DenseRowsOrder : DenseOrder {
    __device__ __forceinline__ const char* a_base(const Unit&) const { return A; }
    __device__ __forceinline__ unsigned row_off(const Unit& u, int r) const { return (unsigned)(u.pm * 256 + r) * (unsigned)(tstep / 256); }
};
struct GluPairOrder : DenseOrder {
    __device__ __forceinline__ bool next(int i, Unit& u) const { if (i >= 2) return false; Unit t; if (!pg8::StaticOrder::next(0, t)) return false; u = t; u.pn = 2 * t.pn + i; return true; }
};
struct MoeOrder {
    const LAS int* tb; const LAS int* cn; int G, c, K, npn;
    const char* A; const char* Bt; size_t b_estride; const int* ltok; bool gather;
    __device__ __forceinline__ bool next(int i, Unit& u) const {
        const int L = i * G + c, total = tb[NEXP] * npn; if (L >= total) return false;
        const int tile = L / npn; int e = 0;
        for (int k = 1; k < NEXP; ++k) e += (tb[k] <= tile) ? 1 : 0;
        u.e = e; u.pm = tile; u.pn = L % npn; u.mt = tile - tb[e]; const int left = cn[e] - u.mt * 256; u.rows = left < 256 ? left : 256; u.cb = cn[33 + e] + u.mt * 256; return true;
    }
    __device__ __forceinline__ const char* a_base(const Unit& u) const { return gather ? A : A + (size_t)u.pm * 256 * K * 2; }
    __device__ __forceinline__ const char* b_base(const Unit& u) const { return Bt + (size_t)u.e * b_estride + (size_t)u.pn * 256 * K * 2; }
    __device__ __forceinline__ unsigned row_off(const Unit& u, int r) const { if (!ltok) return (unsigned)(u.pm * 256 + r) * (unsigned)(K * 2);
        const int tok = (r < u.rows) ? ltok[u.e * NTOK + u.mt * 256 + r] : 0; return (unsigned)tok * (unsigned)(K * 2); }
};

constexpr int SSM_AP = 1296;
__device__ __forceinline__ void ssm_unit(Frame& F, int b, int g) {
    LAS unsigned char* Al = F.lds;
    LAS float* SL = (LAS float*)(F.lds + 64 * SSM_AP);
    const int fr = F.lane & 15, fq = F.lane >> 4, w = F.wave;
    const bf16* Ug = (const bf16*)(F.ws + WS_C) + (size_t)(b * 32 + g) * 2048 * 16;
#pragma unroll 4
    for (int q = F.tid; q < 4096; q += 512) { const int row = q >> 6, cc = q & 63; const v4u v = *(const GAS v4u*)(Ug + row * 512 + cc * 8); *(LAS v4u*)(Al + row * SSM_AP + cc * 16) = v; }
    __syncthreads();
    {
        const bf16* WS = (const bf16*)(F.ws + WS_WST) + ((size_t)g * 128 + 16 * w + fr) * 512 + 8 * fq;
        f32x4 acc[4];
#pragma unroll
        for (int m = 0; m < 4; ++m) acc[m] = (f32x4){0.f, 0.f, 0.f, 0.f};
#pragma unroll 4
        for (int s = 0; s < 16; ++s) { const bf16x8 bw = *(const GAS bf16x8*)(WS + 32 * s);
#pragma unroll
            for (int m = 0; m < 4; ++m) { const bf16x8 a = *(const LAS bf16x8*)(Al + (16 * m + fr) * SSM_AP + (32 * s + 8 * fq) * 2); acc[m] = __builtin_amdgcn_mfma_f32_16x16x32_bf16(bw, a, acc[m], 0, 0, 0); } }
#pragma unroll
        for (int m = 0; m < 4; ++m) *(LAS f32x4*)(SL + (16 * m + fr) * 132 + 16 * w + 4 * fq) = acc[m];
    }
    __syncthreads();
    if (w == 0) {
        const int n = F.lane; const float* l32 = (const float*)(F.ws + WS_LAM32) + (g * 64 + n) * 2; const float lr = l32[0], li = l32[1]; float sr = 0.f, si = 0.f;
        for (int c = 0; c < NCH; ++c) { *(LAS unsigned*)(Al + c * SSM_AP + 1024 + 4 * n) = pk2(sr, si);
            const float ur = SL[c * 132 + 2 * n], ui = SL[c * 132 + 2 * n + 1]; const float nr = lr * sr - li * si + ur, ni = lr * si + li * sr + ui; sr = nr; si = ni; }
    }
    __syncthreads();
    {
        const bf16* BT = (const bf16*)(F.ws + WS_BT2) + ((size_t)g * 512 + 64 * w + fr) * 640 + 8 * fq;
        f32x4 acc[4][4];
#pragma unroll
        for (int m = 0; m < 4; ++m)
#pragma unroll
            for (int n = 0; n < 4; ++n) acc[m][n] = (f32x4){0.f, 0.f, 0.f, 0.f};
#pragma unroll 2
        for (int s = 0; s < 20; ++s) { bf16x8 bf[4], af[4];
#pragma unroll
            for (int n = 0; n < 4; ++n) bf[n] = *(const GAS bf16x8*)(BT + (size_t)n * 16 * 640 + 32 * s);
#pragma unroll
            for (int m = 0; m < 4; ++m) af[m] = *(const LAS bf16x8*)(Al + (16 * m + fr) * SSM_AP + (32 * s + 8 * fq) * 2);
#pragma unroll
            for (int m = 0; m < 4; ++m)
#pragma unroll
                for (int n = 0; n < 4; ++n) acc[m][n] = __builtin_amdgcn_mfma_f32_16x16x32_bf16(bf[n], af[m], acc[m][n], 0, 0, 0); }
        bf16* GY = (bf16*)(F.ws + WS_B);
#pragma unroll
        for (int m = 0; m < 4; ++m)
#pragma unroll
            for (int n = 0; n < 4; ++n) { const int tok = b * SEQ + LC * (16 * m + fr) + 4 * w + n; const f32x4 y = acc[m][n];
                v2u o; o.x = pk2(gelu_tanh(y[0]), gelu_tanh(y[1])); o.y = pk2(gelu_tanh(y[2]), gelu_tanh(y[3]));
                *(GAS v2u*)(GY + (size_t)tok * 512 + 16 * g + 4 * fq) = o; }
    }
    __syncthreads();
}
__device__ __forceinline__ void conv_tile(Frame& F, int tile) {
    const int tok0 = tile * 64, b = tok0 >> 11, t0 = tok0 & 2047;
    LAS unsigned* zl = (LAS unsigned*)F.lds;
    LAS float* red = (LAS float*)(F.lds + 98304);
    const bf16* Z = (const bf16*)(F.ws + WS_C + 16 * MiB);
#pragma unroll 2
    for (int q = F.tid; q < 94 * 64; q += 512) { const int rr = q >> 6, cc = q & 63, t = t0 - 30 + rr; v4u v = (v4u){0u, 0u, 0u, 0u};
        if (t >= 0) v = *(const GAS v4u*)(Z + (size_t)(b * SEQ + t) * 512 + cc * 8); *(LAS v4u*)(zl + rr * 256 + cc * 4) = v; }
    __syncthreads();
    const int wq = F.wave & 3, th = F.wave >> 2, cp = wq * 64 + F.lane;
    float dw0[31], dw1[31];
    {   const float* pw = F.in[I_CDW] + 2 * cp;
        typedef float f32x2 __attribute__((ext_vector_type(2)));
#pragma unroll
        for (int k = 0; k < 31; ++k) { const f32x2 v = *(const GAS f32x2*)pw; dw0[k] = v.x; dw1[k] = v.y; pw += 512; asm volatile("" : "+v"(pw)); } }
    const float cb0 = F.in[I_CDWB][2 * cp], cb1 = F.in[I_CDWB][2 * cp + 1], lg0 = F.in[I_CLNG][2 * cp], lg1 = F.in[I_CLNG][2 * cp + 1], lb0 = F.in[I_CLNB][2 * cp], lb1 = F.in[I_CLNB][2 * cp + 1];
    bf16* CA = (bf16*)(F.ws + WS_B + 16 * MiB);
#pragma unroll 1
    for (int ch = 0; ch < 4; ++ch) {
        float a0[8], a1[8];
#pragma unroll
        for (int o = 0; o < 8; ++o) { a0[o] = cb0; a1[o] = cb1; }
        const int rbase = th * 32 + ch * 8;
#pragma unroll
        for (int r = 0; r < 38; ++r) { const unsigned v = zl[(rbase + r) * 256 + cp]; const float x0 = bflo(v), x1 = bfhi(v);
#pragma unroll
            for (int o = 0; o < 8; ++o) { const int k = r - o; if (k >= 0 && k <= 30) { a0[o] += dw0[k] * x0; a1[o] += dw1[k] * x1; } }
            __builtin_amdgcn_sched_barrier(0); }
        LAS float* rp = red + ((ch & 1) * 2 + th) * 64;
#pragma unroll
        for (int o = 0; o < 8; ++o) { const float s = wave_sum(a0[o] + a1[o]), q = wave_sum(a0[o] * a0[o] + a1[o] * a1[o]); if (F.lane == 0) { rp[(o * 4 + wq) * 2] = s; rp[(o * 4 + wq) * 2 + 1] = q; } }
        __syncthreads();
#pragma unroll
        for (int o = 0; o < 8; ++o) { float s = 0.f, q = 0.f;
#pragma unroll
            for (int k = 0; k < 4; ++k) { s += rp[(o * 4 + k) * 2]; q += rp[(o * 4 + k) * 2 + 1]; }
            const float mean = s * (1.f / 512.f), var = q * (1.f / 512.f) - mean * mean, rstd = 1.0f / sqrtf(var + EPS);
            const float y0 = (a0[o] - mean) * rstd * lg0 + lb0, y1 = (a1[o] - mean) * rstd * lg1 + lb1;
            *(GAS unsigned*)(CA + (size_t)(tok0 + rbase + o) * 512 + 2 * cp) = pk2(y0 * sigm(y0), y1 * sigm(y1)); }
    }
    __syncthreads();
}
__device__ __forceinline__ void router_phase(Frame& F) {
    const int fr = F.lane & 15, fq = F.lane >> 4, tl = F.wave & 3, kh = F.wave >> 2;
    const bf16* XB = (const bf16*)(F.ws + WS_B); float* R2 = (float*)(F.ws + WS_R2);
    const bf16* WRT = (const bf16*)(F.ws + WS_WRT); int* ltok = (int*)(F.ws + WS_LTOK); int* tinfo = (int*)(F.ws + WS_TINFO);
    LAS float* part = (LAS float*)(F.lds + 32768);
    LAS float* lg = (LAS float*)(F.lds + tl * 4096);
    LAS unsigned* lcnt = (LAS unsigned*)(F.lds + 49152);
    LAS unsigned* lbase = lcnt + 32;
    LAS unsigned* dec = lcnt + 64;
    if (F.tid < NEXP) lcnt[F.tid] = 0u;
    __syncthreads();
    for (int tg = F.vcu; tg < NTOK / 64; tg += F.G) {
        const int tile = tg * 4 + tl, tok = tile * 16 + fr;
        const bf16* xr = XB + (size_t)tok * D + 512 * kh + 8 * fq; const bf16* wh = WRT + (size_t)fr * D + 512 * kh + 8 * fq;
        f32x4 acc[3]; float ss = 0.f;
#pragma unroll
        for (int n = 0; n < 3; ++n) acc[n] = (f32x4){0.f, 0.f, 0.f, 0.f};
#pragma unroll 4
        for (int s = 0; s < 16; ++s) {
            const v4u h = *(const GAS v4u*)(xr + 32 * s);
            const float a0 = bflo(h.x), a1 = bfhi(h.x), a2 = bflo(h.y), a3 = bfhi(h.y), a4 = bflo(h.z), a5 = bfhi(h.z), a6 = bflo(h.w), a7 = bfhi(h.w);
            ss += (a0 * a0 + a1 * a1) + (a2 * a2 + a3 * a3) + (a4 * a4 + a5 * a5) + (a6 * a6 + a7 * a7);
            const bf16x8 xh = __builtin_bit_cast(bf16x8, h);
#pragma unroll
            for (int n = 0; n < 3; ++n) { const bf16x8 whi = *(const GAS bf16x8*)(wh + (size_t)n * 16 * D + 32 * s), wlo = *(const GAS bf16x8*)(wh + (size_t)(48 + n * 16) * D + 32 * s);
                acc[n] = __builtin_amdgcn_mfma_f32_16x16x32_bf16(whi, xh, acc[n], 0, 0, 0); acc[n] = __builtin_amdgcn_mfma_f32_16x16x32_bf16(wlo, xh, acc[n], 0, 0, 0); }
        }
        ss += __shfl_xor(ss, 16); ss += __shfl_xor(ss, 32);
        if (kh == 1) { LAS float* pp = part + (tl * 64 + F.lane) * 13;
#pragma unroll
            for (int n = 0; n < 3; ++n)
#pragma unroll
                for (int j = 0; j < 4; ++j) pp[4 * n + j] = acc[n][j];
            pp[12] = ss; }
        __syncthreads();
        if (kh == 0) {
            const LAS float* pp = part + (tl * 64 + F.lane) * 13;
            ss += pp[12];
            const float r = 1.0f / sqrtf(ss * (1.f / D) + EPS);
            if (fq == 0) R2[tok] = r;
#pragma unroll
            for (int n = 0; n < 3; ++n)
#pragma unroll
                for (int j = 0; j < 4; ++j) { const int o = 16 * n + 4 * fq + j; if (o < 36) { const float bias = o < 4 ? F.in[I_BRG][o] : F.in[I_BRE2][o - 4]; lg[fr * 49 + o] = (acc[n][j] + pp[4 * n + j]) * r + bias; } }
            LDS_WAIT(); asm volatile("" ::: "memory");
            if (F.lane < 16) {
                const LAS float* l = lg + F.lane * 49;
                float gm = l[0]; int gs = 0;
#pragma unroll
                for (int i = 1; i < 4; ++i) if (l[i] > gm) { gm = l[i]; gs = i; }
                float den = 0.f;
#pragma unroll
                for (int i = 0; i < 4; ++i) den += __expf(l[i] - gm);
                const float pg = 1.0f / den;
                const LAS float* el = l + 4 + 8 * gs;
                float v1 = el[0]; int j1 = 0;
#pragma unroll
                for (int i = 1; i < 8; ++i) if (el[i] > v1) { v1 = el[i]; j1 = i; }
                float v2 = -3.0e38f; int j2 = 0;
#pragma unroll
                for (int i = 0; i < 8; ++i) if (i != j1 && el[i] > v2) { v2 = el[i]; j2 = i; }
                const float w1 = pg / (1.0f + __expf(v2 - v1)), w2 = pg - w1;
                const int e1 = gs * 8 + j1, e2 = gs * 8 + j2;
                const unsigned s1 = __hip_atomic_fetch_add(lcnt + e1, 1u, __ATOMIC_RELAXED, __HIP_MEMORY_SCOPE_WORKGROUP), s2 = __hip_atomic_fetch_add(lcnt + e2, 1u, __ATOMIC_RELAXED, __HIP_MEMORY_SCOPE_WORKGROUP);
                LAS unsigned* dd = dec + (tl * 16 + F.lane) * 6; dd[0] = (unsigned)e1; dd[1] = s1; dd[2] = (unsigned)e2; dd[3] = s2; dd[4] = __builtin_bit_cast(unsigned, w1); dd[5] = __builtin_bit_cast(unsigned, w2);
            }
        }
        __syncthreads();
        if (F.tid < NEXP) { const unsigned c = lcnt[F.tid]; lbase[F.tid] = c ? __hip_atomic_fetch_add((unsigned*)(F.ctl + CW_ECNT + 64 * F.tid), c, RLX_AGENT) : 0u; lcnt[F.tid] = 0u; }
        __syncthreads();
        if (F.tid < 64) { const LAS unsigned* dd = dec + F.tid * 6; const int token = tg * 64 + F.tid; const int e1 = (int)dd[0], e2 = (int)dd[2]; const int s1 = (int)(lbase[e1] + dd[1]), s2 = (int)(lbase[e2] + dd[3]);
            ltok[e1 * NTOK + s1] = token; ltok[e2 * NTOK + s2] = token;
            typedef int i32x4 __attribute__((ext_vector_type(4))); *(GAS i32x4*)(tinfo + 4 * token) = (i32x4){e1 * NTOK + s1, e2 * NTOK + s2, (int)dd[4], (int)dd[5]}; }
        __syncthreads();
    }
}
__device__ __forceinline__ void rows_to_bf16(Frame& F, const float* X, bf16* XB, float* RR) {
    const int gw = F.vcu * NWAVES + F.wave, NGW = F.G * NWAVES;
    for (int m = gw; m < NTOK; m += NGW) {
        const GAS f32x4* xr = (const GAS f32x4*)(X + (size_t)m * D) + F.lane; f32x4 v[4]; float s = 0.f;
#pragma unroll
        for (int j = 0; j < 4; ++j) { v[j] = xr[64 * j]; s += (v[j].x * v[j].x + v[j].y * v[j].y) + (v[j].z * v[j].z + v[j].w * v[j].w); }
        const float r = 1.0f / sqrtf(wave_sum(s) * (1.f / D) + EPS);
        if (F.lane == 0) RR[m] = r;
        GAS v2u* o8 = (GAS v2u*)(XB + (size_t)m * D) + F.lane;
#pragma unroll
        for (int j = 0; j < 4; ++j) { v2u o; o.x = pk2(v[j].x, v[j].y); o.y = pk2(v[j].z, v[j].w); o8[64 * j] = o; }
    }
}
__device__ __forceinline__ void moe_combine_rows(Frame& F, const bf16* __restrict__ XB, const bf16* __restrict__ Y, bf16* __restrict__ XO, unsigned char* __restrict__ XF, float* __restrict__ RR) {
    const int gw = F.vcu * NWAVES + F.wave, NGW = F.G * NWAVES; const LAS int* cs = (const LAS int*)(F.lds + TB_OFF) + 66; const int* tinfo = (const int*)(F.ws + WS_TINFO);
    for (int m = gw; m < NTOK; m += NGW) {
        typedef int i32x4 __attribute__((ext_vector_type(4))); const i32x4 ti = *(const GAS i32x4*)(tinfo + 4 * m);
        const int r1 = cs[ti.x >> 14] + (ti.x & (NTOK - 1)), r2 = cs[ti.y >> 14] + (ti.y & (NTOK - 1)); const int wz = ti.z, ww = ti.w; const float w1 = __builtin_bit_cast(float, wz), w2 = __builtin_bit_cast(float, ww);
        const GAS v4u* xr = (const GAS v4u*)(XB + (size_t)m * D) + F.lane; GAS v4u* xo = (GAS v4u*)(XO + (size_t)m * D) + F.lane; const GAS v4u* y1 = (const GAS v4u*)(Y + (size_t)r1 * D) + F.lane; const GAS v4u* y2 = (const GAS v4u*)(Y + (size_t)r2 * D) + F.lane;
        v4u o[2]; float s = 0.f;
#pragma unroll
        for (int j = 0; j < 2; ++j) { const v4u x = xr[64 * j], a = y1[64 * j], b = y2[64 * j]; float v[8];
            v[0] = bflo(x.x) + w1 * bflo(a.x) + w2 * bflo(b.x); v[1] = bfhi(x.x) + w1 * bfhi(a.x) + w2 * bfhi(b.x); v[2] = bflo(x.y) + w1 * bflo(a.y) + w2 * bflo(b.y); v[3] = bfhi(x.y) + w1 * bfhi(a.y) + w2 * bfhi(b.y);
            v[4] = bflo(x.z) + w1 * bflo(a.z) + w2 * bflo(b.z); v[5] = bfhi(x.z) + w1 * bfhi(a.z) + w2 * bfhi(b.z); v[6] = bflo(x.w) + w1 * bflo(a.w) + w2 * bflo(b.w); v[7] = bfhi(x.w) + w1 * bfhi(a.w) + w2 * bfhi(b.w);
            o[j].x = pk2(v[0], v[1]); o[j].y = pk2(v[2], v[3]); o[j].z = pk2(v[4], v[5]); o[j].w = pk2(v[6], v[7]);
            { v2u f; f.x = pk4f8(v[0], v[1], v[2], v[3]); f.y = pk4f8(v[4], v[5], v[6], v[7]); *((GAS v2u*)(XF + (size_t)m * D) + F.lane + 64 * j) = f; }
            const float q0 = bflo(o[j].x), q1 = bfhi(o[j].x), q2 = bflo(o[j].y), q3 = bfhi(o[j].y), q4 = bflo(o[j].z), q5 = bfhi(o[j].z), q6 = bflo(o[j].w), q7 = bfhi(o[j].w);
            s += (q0 * q0 + q1 * q1) + (q2 * q2 + q3 * q3) + (q4 * q4 + q5 * q5) + (q6 * q6 + q7 * q7); }
        const float r = 1.0f / sqrtf(wave_sum(s) * (1.f / D) + EPS);
        if (F.lane == 0) RR[m] = r;
#pragma unroll
        for (int j = 0; j < 2; ++j) xo[64 * j] = o[j];
    }
}
__device__ __forceinline__ void final_norm(Frame& F, const bf16* X, float* out, const float* gf) {
    const int gw = F.vcu * NWAVES + F.wave, NGW = F.G * NWAVES;
    f32x4 gv[2][2];
#pragma unroll
    for (int j = 0; j < 2; ++j) { gv[j][0] = *(const f32x4*)(gf + 8 * F.lane + 512 * j); gv[j][1] = *(const f32x4*)(gf + 8 * F.lane + 512 * j + 4); }
    for (int m = gw; m < NTOK; m += NGW) {
        const GAS v4u* xr = (const GAS v4u*)(X + (size_t)m * D) + F.lane; f32x4 v[2][2]; float s = 0.f;
#pragma unroll
        for (int j = 0; j < 2; ++j) { const v4u x = xr[64 * j]; v[j][0] = (f32x4){bflo(x.x), bfhi(x.x), bflo(x.y), bfhi(x.y)}; v[j][1] = (f32x4){bflo(x.z), bfhi(x.z), bflo(x.w), bfhi(x.w)};
            s += (v[j][0].x * v[j][0].x + v[j][0].y * v[j][0].y) + (v[j][0].z * v[j][0].z + v[j][0].w * v[j][0].w) + (v[j][1].x * v[j][1].x + v[j][1].y * v[j][1].y) + (v[j][1].z * v[j][1].z + v[j][1].w * v[j][1].w); }
        const float r = 1.0f / sqrtf(wave_sum(s) * (1.f / D) + EPS);
        GAS f32x4* o = (GAS f32x4*)(out + (size_t)m * D) + 2 * F.lane;
#pragma unroll
        for (int j = 0; j < 2; ++j) { o[128 * j] = v[j][0] * r * gv[j][0]; o[128 * j + 1] = v[j][1] * r * gv[j][1]; }
    }
}
__device__ __forceinline__ void moe_tables(Frame& F) {
    LAS int* tb = (LAS int*)(F.lds + TB_OFF); LAS int* cn = tb + 33; LAS int* cs = cn + 33;
    if (F.tid == 0) { int t = 0, r = 0; for (int e = 0; e < NEXP; ++e) { const int c = (int)__hip_atomic_load((unsigned*)(F.ctl + CW_ECNT + 64 * e), RLX_AGENT); cn[e] = c; tb[e] = t; cs[e] = r; t += (c + 255) >> 8; r += c; } tb[NEXP] = t; cs[NEXP] = r; }
    __syncthreads();
}

struct Args { const float* in[N_IN]; float* out; unsigned char* ws; int ph_lo, ph_hi; };
__global__ void __launch_bounds__(NWAVES * 64, 2) mk_fwd(Args args) {
    extern __shared__ __attribute__((aligned(16))) unsigned char lds[];
    Frame F;
    F.lds = (LAS unsigned char*)lds;
    F.MISC = (volatile LAS unsigned*)(F.lds + MISC_OFF);
    F.tid = threadIdx.x; F.lane = F.tid & 63; F.wave = __builtin_amdgcn_readfirstlane(F.tid >> 6);
    const int wave_s = F.wave;
    F.G = gridDim.x; { const int bx = blockIdx.x; F.vcu = (F.G % 8 == 0) ? (bx % 8) * (F.G / 8) + bx / 8 : bx; }
    F.in = args.in; F.out = args.out; F.ws = args.ws; F.ctl = (gu32*)(args.ws + WS_CTL);
    for (int u = F.tid; u < (LDS_BYTES - LDSCTL_OFF) / 4; u += NWAVES * 64) ((LAS unsigned*)(F.lds + LDSCTL_OFF))[u] = 0u;
    __syncthreads();
    if (N_LAUNCHES != PER_PHASE) (void)xcd_barrier_post((unsigned*)(F.ctl + CW_BAR), F.MISC + 8);
#define GRID_BAR() do { if (N_LAUNCHES == PER_PHASE) { if (F.tid == 0) __hip_atomic_store(F.ctl + CW_TMO, 0xBADBA0u, RLX_AGENT); } else { \
        XcdBarrier bb_; bb_.bar = (unsigned*)(F.ctl + CW_BAR); bb_.x = xb_xcc_id(); bb_.st = (volatile LAS unsigned*)(F.lds + MISC_OFF) + 8; bb_.wv = wave_s; xcd_barrier(bb_); } } while (0)
#define PHASE_BEGIN() do { int l_ = (int)__builtin_amdgcn_mbcnt_hi(~0u, __builtin_amdgcn_mbcnt_lo(~0u, 0u)); asm volatile("" : "+v"(l_)); F.lane = l_; F.wave = wave_s; F.tid = wave_s * 64 + l_; \
        unsigned long long w_ = (unsigned long long)args.ws; asm volatile("" : "+s"(w_)); ws = (unsigned char*)(GAS unsigned char*)w_; F.ws = ws; F.ctl = (gu32*)(ws + WS_CTL); } while (0)
    const int lo = args.ph_lo, hi = args.ph_hi;
#ifndef PHASE_MASK
#define PHASE_MASK 0x1FFF
#endif
#define IN(k) (lo <= (k) && (k) < hi && ((PHASE_MASK >> (k)) & 1))
#define BOTH(k) (IN(k) && IN((k) + 1))
#ifndef REP_MASK
#define REP_MASK 0
#endif
#define REPS(k) (((REP_MASK >> (k)) & 1) ? 2 : 1)
    unsigned char* ws = args.ws;
    const size_t TS1024 = (size_t)256 * 1024 * 2, TS512 = (size_t)256 * 512 * 2, TS256 = (size_t)256 * 256 * 2;

    if (IN(0)) for (int rep_ = 0; rep_ < REPS(0); ++rep_) { PHASE_BEGIN(); p0_prologue(F); if (BOTH(0)) GRID_BAR(); }
    if (IN(1)) for (int rep_ = 0; rep_ < REPS(1); ++rep_) {
        PHASE_BEGIN();
        DenseOrder S; S.init(NTOK, DIN, F.G, (int)blockIdx.x); S.A = (const char*)(ws + WS_B); S.Bt = (const char*)(ws + WS_WIN); S.tstep = TS1024;
        EpiP1 E{(bf16*)(ws + WS_C), (bf16*)(ws + WS_C + 16 * MiB), (bf16*)F.out, F.in[I_BGATE]};
        pg8::gemm_phase<EpiP1, DenseOrder>(F.lds + RING_OFF, F.tid, D, S, E);
        {
            const int nfull = (NTOK / 256) * (DIN / 256) / F.G, heavy = (NTOK / 256) * (DIN / 256) - nfull * F.G;
            const int nl = F.G - heavy; const bool spread = heavy > 0 && 2 * nl >= (NTOK / 256) * (D / 256);
            DenseOrder S2; S2.A = (const char*)(ws + WS_PB); S2.Bt = (const char*)(ws + WS_WPLE); S2.tstep = TS256;
            if (spread) S2.init(NTOK, D, nl, (int)blockIdx.x - heavy); else S2.init(NTOK, D, F.G, (int)blockIdx.x);
            EpiE E2{(bf16*)(ws + WS_E + 32 * MiB)};
            if (!spread || (int)blockIdx.x >= heavy) pg8::gemm_phase<EpiE, DenseOrder>(F.lds + RING_OFF, F.tid, DPLE, S2, E2);
        }
        if (BOTH(1)) GRID_BAR();
    }
    if (IN(2)) for (int rep_ = 0; rep_ < REPS(2); ++rep_) {
        PHASE_BEGIN();
#ifndef NO_SSM
        for (int u = F.vcu; u < 8 * NGRP; u += F.G) { const int x = u / 32, idx = u % 32; ssm_unit(F, idx & 7, 4 * x + (idx >> 3)); }
#endif
#ifndef NO_CONV
        PHASE_BEGIN();
        for (int t = blockIdx.x; t < NTOK / 64; t += F.G) conv_tile(F, t);
#endif
        if (BOTH(2)) GRID_BAR();
    }
    if (IN(3)) for (int rep_ = 0; rep_ < REPS(3); ++rep_) {
        PHASE_BEGIN();
        DenseOrder S; S.init(NTOK, 2 * D, F.G, (int)blockIdx.x); S.A = (const char*)(ws + WS_B); S.Bt = (const char*)(ws + WS_WGLU); S.tstep = TS512;
        EpiGlu E{(bf16*)(ws + WS_E), (const bf16*)F.out};
        pg8::gemm_phase<EpiGlu, DenseOrder>(F.lds + RING_OFF, F.tid, DSSM, S, E);
        if (BOTH(3)) GRID_BAR();
    }
    if (IN(4)) for (int rep_ = 0; rep_ < REPS(4); ++rep_) {
        PHASE_BEGIN();
        DenseOrder S; S.init(NTOK, D, F.G, (int)blockIdx.x); S.A = (const char*)(ws + WS_B + 16 * MiB); S.Bt = (const char*)(ws + WS_WCO); S.tstep = TS512;
        EpiCo E{(const bf16*)(ws + WS_E), (const bf16*)F.out, (bf16*)(ws + WS_C)};
        pg8::gemm_phase<EpiCo, DenseOrder>(F.lds + RING_OFF, F.tid, DCONV, S, E);
        if (BOTH(4)) GRID_BAR();
    }
    if (IN(5)) for (int rep_ = 0; rep_ < REPS(5); ++rep_) {
        PHASE_BEGIN();
        DenseOrder S; S.init(NTOK, D, F.G, (int)blockIdx.x); S.A = (const char*)(ws + WS_C); S.Bt = (const char*)(ws + WS_WO); S.tstep = TS1024;
        EpiRes E{F.in[I_X], (bf16*)(ws + WS_B), ws + WS_E};
        pg8::gemm_phase<EpiRes, DenseOrder>(F.lds + RING_OFF, F.tid, D, S, E);
        if (BOTH(5)) GRID_BAR();
    }
    if (IN(6)) for (int rep_ = 0; rep_ < REPS(6); ++rep_) { PHASE_BEGIN(); router_phase(F); if (BOTH(6)) GRID_BAR();
        if (rep_ + 1 < REPS(6)) { if (blockIdx.x == 0 && F.tid < NEXP) __hip_atomic_store((unsigned*)(F.ctl + CW_ECNT + 64 * F.tid), 0u, RLX_AGENT); GRID_BAR(); } }
    if (IN(7)) for (int rep_ = 0; rep_ < REPS(7); ++rep_) {
        PHASE_BEGIN();
        moe_tables(F);
        MoeOrder S; S.tb = (const LAS int*)(F.lds + TB_OFF); S.cn = S.tb + 33; S.G = F.G; S.c = F.vcu; S.K = D / 2; S.npn = 4;
        S.A = (const char*)(ws + WS_E); S.Bt = (const char*)(ws + WS_WGU); S.b_estride = (size_t)D * D; S.ltok = (const int*)(ws + WS_LTOK); S.gather = true;
        EpiAct E{ws + WS_C, (const int*)(ws + WS_LTOK), (const float*)(ws + WS_R2)};
        pg8::gemm_phase<EpiAct, MoeOrder, true, true, true>(F.lds + RING_OFF, F.tid, D / 2, S, E);
        if (BOTH(7)) GRID_BAR();
    }
    if (IN(8)) for (int rep_ = 0; rep_ < REPS(8); ++rep_) {
        PHASE_BEGIN();
        moe_tables(F);
        MoeOrder S; S.tb = (const LAS int*)(F.lds + TB_OFF); S.cn = S.tb + 33; S.G = F.G; S.c = F.vcu; S.K = DEXP / 2; S.npn = 4;
        S.A = (const char*)(ws + WS_C); S.Bt = (const char*)(ws + WS_WD); S.b_estride = (size_t)D * DEXP; S.ltok = nullptr; S.gather = true;
        EpiY E{(bf16*)F.out};
        pg8::gemm_phase<EpiY, MoeOrder, true, true, true>(F.lds + RING_OFF, F.tid, DEXP / 2, S, E);
        if (BOTH(8)) GRID_BAR();
    }
    if (IN(9)) for (int rep_ = 0; rep_ < REPS(9); ++rep_) { PHASE_BEGIN(); moe_tables(F); moe_combine_rows(F, (const bf16*)(ws + WS_B), (const bf16*)F.out, (bf16*)(ws + WS_E), ws + WS_X2F, (float*)(ws + WS_R3)); if (BOTH(9)) GRID_BAR(); }
#ifdef DBG_SG_COPY
    if (lo <= 10 && 10 < hi) { const int gt = F.vcu * 512 + (int)threadIdx.x, NGT = F.G * 512; const bf16* sgp = (const bf16*)args.out + (size_t)DBG_SG_COPY * NTOK * D; float* dst = (float*)(args.ws + WS_E);
        for (int q = gt; q < NTOK * D; q += NGT) { const float v = bflo((unsigned)sgp[q]); const int col = q & 2047;
#ifdef DBG_SG_SEL_LO
            dst[q] = (v >= 0.f && v <= 1.f) ? 0.f : ((col >= DBG_SG_SEL_LO && col < DBG_SG_SEL_HI) ? 1000.f : 0.f);
#else
            dst[q] = v;
#endif
        } }
#endif
    if (IN(11)) for (int rep_ = 0; rep_ < REPS(11); ++rep_) {
        PHASE_BEGIN();
        DenseRowsOrder S; S.init(NTOK, D, F.G, (int)blockIdx.x); S.A = (const char*)(ws + WS_X2F); S.Bt = (const char*)(ws + WS_WPG); S.tstep = TS512;
        EpiPle E{(const bf16*)(ws + WS_E), (const bf16*)(ws + WS_E + 32 * MiB), (const float*)(ws + WS_R3), (bf16*)(ws + WS_C)};
        pg8::gemm_phase<EpiPle, DenseRowsOrder, true, true, true>(F.lds + RING_OFF, F.tid, D / 2, S, E);
        if (BOTH(11)) GRID_BAR();
    }
#ifdef DBG_DUMP_OFF
    if (hi == PER_PHASE) {   PHASE_BEGIN();
        const int gt = F.vcu * 512 + F.tid, NGT = F.G * 512;
#if DBG_DUMP_BF16
        const bf16* src = (const bf16*)(ws + (size_t)DBG_DUMP_OFF);
        for (int q = gt; q < NTOK * D; q += NGT) F.out[q] = bflo((unsigned)src[q]);
#else
        const float* src = (const float*)(ws + (size_t)DBG_DUMP_OFF);
        for (int q = gt; q < NTOK * D; q += NGT) F.out[q] = src[q];
#endif
    }
#else
    if (IN(12)) for (int rep_ = 0; rep_ < REPS(12); ++rep_) { PHASE_BEGIN(); final_norm(F, (const bf16*)(ws + WS_C), F.out, F.in[I_GFIN]); }
#endif
#undef IN
#undef BOTH
}

extern "C" void kernel_launch(void* const* d_in, const int* in_sizes, int n_in, void* d_out, int out_size, void* d_ws, size_t ws_size, hipStream_t stream) {
    static int grid = 0;
    if (grid == 0) {
        if (n_in != N_IN || in_sizes[0] != NTOK * D || out_size != NTOK * D || ws_size < WS_END) { fprintf(stderr, "kernel_launch: unexpected shapes (n_in %d, in0 %d, out %d, ws %zu; need ws >= %zu); nothing launched\n", n_in, n_in > 0 ? in_sizes[0] : -1, out_size, ws_size, (size_t)WS_END); grid = -1; return; }
        int dev = 0, cus = 0, per_cu = 0;
        if (hipGetDevice(&dev) != hipSuccess || hipDeviceGetAttribute(&cus, hipDeviceAttributeMultiprocessorCount, dev) != hipSuccess) { grid = -1; return; }
        if (hipFuncSetAttribute((const void*)mk_fwd, hipFuncAttributeMaxDynamicSharedMemorySize, LDS_BYTES) != hipSuccess) { fprintf(stderr, "kernel_launch: hipFuncSetAttribute failed\n"); grid = -1; return; }
        if (hipOccupancyMaxActiveBlocksPerMultiprocessor(&per_cu, (const void*)mk_fwd, NWAVES * 64, LDS_BYTES) != hipSuccess || per_cu < 1) { fprintf(stderr, "kernel_launch: occupancy query reports %d workgroups per CU\n", per_cu); (void)hipGetLastError(); grid = -1; return; }
        grid = cus;
    }
    if (grid < 0) return;
    if (hipMemsetAsync((char*)d_ws + WS_CTL, 0, CTL_ZERO_BYTES, stream) != hipSuccess) return;
    Args a{};
    for (int i = 0; i < N_IN; ++i) a.in[i] = (const float*)d_in[i];
    a.out = (float*)d_out; a.ws = (unsigned char*)d_ws;
    for (int li = 0; li < N_LAUNCHES; ++li) {
        a.ph_lo = (N_LAUNCHES == PER_PHASE) ? li : 0; a.ph_hi = (N_LAUNCHES == PER_PHASE) ? li + 1 : PER_PHASE;
        hipLaunchKernelGGL(mk_fwd, dim3(grid), dim3(NWAVES * 64), LDS_BYTES, stream, a);
        if (hipPeekAtLastError() != hipSuccess) { fprintf(stderr, "kernel_launch: launch %d failed\n", li); break; }
    }
}
```

```cpp
#include <hip/hip_runtime.h>
#include <cstdio>
#include <cstdint>

namespace pg8 {
#define PG8_LAS __attribute__((address_space(3)))
typedef unsigned short bf16_t;
typedef short bf16x8 __attribute__((ext_vector_type(8)));
typedef float f32x4 __attribute__((ext_vector_type(4)));
typedef unsigned u32x4 __attribute__((ext_vector_type(4)));
typedef unsigned u32x2 __attribute__((ext_vector_type(2)));
constexpr int BM = 256, BK = 64, HALF = 128, HTB = HALF * BK * 2  , STAGE_BYTES = 8 * HTB, NXCD = 8, WGM = 8;

__host__ __device__ __forceinline__ int lds_byte(int r, int c) { const int st = (r >> 4) * 2 + (c >> 5), rr = r & 15, cc = c & 31, ob = rr * 64 + cc * 2; return st * 1024 + (ob ^ (((ob >> 9) & 1) << 5)); }
__host__ __device__ __forceinline__ void stage_rc(int b, int& R, int& C) { const int st = b / 1024, sb = b % 1024, swz = sb ^ (((sb >> 9) & 1) << 5); R = (st >> 1) * 16 + swz / 64; C = (st & 1) * 32 + (swz % 64) / 2; }
__host__ __device__ __forceinline__ int perm32(int rho) { const int n = rho >> 4, i = rho & 15; return 8 * (i >> 2) + 4 * n + (i & 3); }

struct Unit { int pm, pn, e, rows, mt, cb; };

typedef float cvt_f32x2 __attribute__((ext_vector_type(2)));
typedef __bf16 cvt_bf16x2 __attribute__((ext_vector_type(2)));
__device__ __forceinline__ unsigned cvt_pk_bf16(float lo, float hi) { const cvt_f32x2 v = {lo, hi}; const cvt_bf16x2 b = __builtin_convertvector(v, cvt_bf16x2); return __builtin_bit_cast(unsigned, b); }

struct StaticOrder {
    int nM, nN, nwg, G, c;
    __host__ __device__ void init(int M, int N, int G_, int c_) { nM = M / BM; nN = N / BM; nwg = nM * nN; G = G_; c = c_; }
    __host__ __device__ bool next(int i, Unit& u) const {
        const long L = (long)i * G + c; if (L >= nwg) return false;
        int wgid = (int)L; { const int q = nwg / NXCD, r = nwg % NXCD, xcd = wgid % NXCD, off = wgid / NXCD; wgid = (xcd < r ? xcd * (q + 1) : r * (q + 1) + (xcd - r) * q) + off; }
        const int nig = WGM * nN, gid = wgid / nig, fm = gid * WGM, gsz = (nM - fm) < WGM ? (nM - fm) : WGM;
        u.pm = fm + ((wgid % nig) % gsz); u.pn = (wgid % nig) / gsz; u.e = 0; u.rows = BM; u.mt = 0; u.cb = 0; return true;
    }
};

template <class Epi, class Sched, bool GATHER = false, bool ALIGN_EPI = true, bool F8 = false>
__device__ __forceinline__ void gemm_phase(PG8_LAS unsigned char* lds, const int tid, const int K_, const Sched& S, const Epi& E) {
    int K = K_; asm volatile("" : "+s"(K));
    const int wid = __builtin_amdgcn_readfirstlane(tid >> 6), lane = tid & 63, wr = wid >> 2, wc = wid & 3, fr = lane & 15, fq = lane >> 4;
    const int nt = K / BK;
    unsigned voffA[2], voffB[2]; int rowA[2], colA[2];
#pragma unroll
    for (int i = 0; i < 2; ++i) { int R, C; stage_rc(tid * 16 + i * 8192, R, C); const int Rb = (R & ~31) + perm32(R & 31);
        voffA[i] = (unsigned)(R * K + C) * 2u; voffB[i] = (unsigned)(Rb * K + C) * 2u; rowA[i] = R; colA[i] = C * 2; }
    const size_t kstep = (size_t)(BK * 2);
    const unsigned hstep = (unsigned)HALF * (unsigned)K * 2u;
    const unsigned ldsw = (unsigned)wid * 1024u;
    const int aoff = lds_byte(wr * 64 + fr, fq * 8), boff = lds_byte(wc * 32 + fr, fq * 8);
#define PG8_SA(b, h) (((b) * 2 + (h)) * HTB)
#define PG8_SB(b, h) ((4 + (b) * 2 + (h)) * HTB)
#define PG8_STAGE(bufoff, gbase, voff) do { _Pragma("unroll") for (int _i = 0; _i < 2; ++_i) \
        __builtin_amdgcn_global_load_lds((const unsigned*)((const char*)(gbase) + (voff)[_i]), (PG8_LAS unsigned*)(lds + (bufoff) + ldsw + _i * 8192), 16, 0, 0); } while (0)
#define PG8_STAGE_A(bufoff, gbase, V, h) do { _Pragma("unroll") for (int _i = 0; _i < 2; ++_i) { const unsigned _o = GATHER ? (V)[h][_i] : (voffA[_i] + (unsigned)(h) * hstep); \
        __builtin_amdgcn_global_load_lds((const unsigned*)((const char*)(gbase) + _o), (PG8_LAS unsigned*)(lds + (bufoff) + ldsw + _i * 8192), 16, 0, 0); } } while (0)
#define PG8_LDA(dst, b, h) do { _Pragma("unroll") for (int m = 0; m < 4; ++m) _Pragma("unroll") for (int k = 0; k < 2; ++k) dst[m][k] = *(const PG8_LAS bf16x8*)(lds + PG8_SA(b, h) + aoff + m * 2048 + k * 1024); } while (0)
#define PG8_LDB(dst, b, h) do { _Pragma("unroll") for (int n = 0; n < 2; ++n) _Pragma("unroll") for (int k = 0; k < 2; ++k) dst[n][k] = *(const PG8_LAS bf16x8*)(lds + PG8_SB(b, h) + boff + n * 2048 + k * 1024); } while (0)
#define PG8_MMA(ai, bj, At, Bt) do { __builtin_amdgcn_s_setprio(1); _Pragma("unroll") for (int m = 0; m < 4; ++m) _Pragma("unroll") for (int n = 0; n < 2; ++n) { \
        if constexpr (F8) { typedef int v4i_ __attribute__((ext_vector_type(4))); typedef int v8i_ __attribute__((ext_vector_type(8))); \
            const v8i_ fa_ = __builtin_shufflevector(__builtin_bit_cast(v4i_, Bt[n][0]), __builtin_bit_cast(v4i_, Bt[n][1]), 0, 1, 2, 3, 4, 5, 6, 7), fb_ = __builtin_shufflevector(__builtin_bit_cast(v4i_, At[m][0]), __builtin_bit_cast(v4i_, At[m][1]), 0, 1, 2, 3, 4, 5, 6, 7); \
            acc[ai][bj][m][n] = __builtin_amdgcn_mfma_scale_f32_16x16x128_f8f6f4(fa_, fb_, acc[ai][bj][m][n], 0, 0, 0, 0x7f7f7f7f, 0, 0x7f7f7f7f); } \
        else { _Pragma("unroll") for (int k = 0; k < 2; ++k) acc[ai][bj][m][n] = __builtin_amdgcn_mfma_f32_16x16x32_bf16(Bt[n][k], At[m][k], acc[ai][bj][m][n], 0, 0, 0); } } __builtin_amdgcn_s_setprio(0); } while (0)
#define PG8_WAIT_V(n) asm volatile("s_waitcnt vmcnt(" #n ")" ::: "memory")
#define PG8_WAIT_L(n) asm volatile("s_waitcnt lgkmcnt(" #n ")" ::: "memory")
#define PG8_BAR __builtin_amdgcn_s_barrier()
#define PG8_SCHED __builtin_amdgcn_sched_barrier(0)
    Unit cur, nxt; int ui = 0;
    if (!S.next(0, cur)) return;
    f32x4 acc[2][2][4][2];
#pragma unroll
    for (int a = 0; a < 2; ++a)
#pragma unroll
        for (int b = 0; b < 2; ++b)
#pragma unroll
            for (int m = 0; m < 4; ++m)
#pragma unroll
                for (int n = 0; n < 2; ++n) acc[a][b][m][n] = (f32x4){0.f, 0.f, 0.f, 0.f};
    bf16x8 At[4][2], B0[2][2], B1[2][2];
    unsigned cva[2][2] = {{0u, 0u}, {0u, 0u}}, nva[2][2] = {{0u, 0u}, {0u, 0u}};
    const char* cA = S.a_base(cur); const char* cB = S.b_base(cur);
    if constexpr (GATHER) {
#pragma unroll
        for (int h = 0; h < 2; ++h)
#pragma unroll
            for (int i = 0; i < 2; ++i) cva[h][i] = S.row_off(cur, h * HALF + rowA[i]) + (unsigned)colA[i];
    }
    PG8_STAGE(PG8_SB(0, 0), cB, voffB); PG8_STAGE(PG8_SB(0, 1), cB + hstep, voffB); PG8_STAGE_A(PG8_SA(0, 0), cA, cva, 0); PG8_STAGE_A(PG8_SA(0, 1), cA, cva, 1);
    if (wr == 1) PG8_BAR;
    PG8_WAIT_V(2); PG8_BAR;
    PG8_STAGE(PG8_SB(1, 0), cB + kstep, voffB); PG8_STAGE_A(PG8_SA(1, 0), cA + kstep, cva, 0); PG8_STAGE(PG8_SB(1, 1), cB + hstep + kstep, voffB);
    PG8_WAIT_V(6); PG8_BAR;
    for (;;) {
        const bool has_next = S.next(ui + 1, nxt);
        const char* nA = has_next ? S.a_base(nxt) : cA; const char* nB = has_next ? S.b_base(nxt) : cB;
        if constexpr (GATHER) {
#pragma unroll
            for (int h = 0; h < 2; ++h)
#pragma unroll
                for (int i = 0; i < 2; ++i) nva[h][i] = has_next ? (S.row_off(nxt, h * HALF + rowA[i]) + (unsigned)colA[i]) : cva[h][i];
        }
#pragma unroll 1
        for (int t = 0; t < nt; t += 2) {
            const bool last = (t == nt - 2);
            asm volatile("" : "+v"(voffA[0]), "+v"(voffA[1]), "+v"(voffB[0]), "+v"(voffB[1]));
            const char* a1 = cA + (size_t)(t + 1) * kstep;
            const char* a2 = last ? nA : cA + (size_t)(t + 2) * kstep; const char* b2 = last ? nB : cB + (size_t)(t + 2) * kstep;
            const char* a3 = a2 + kstep; const char* b3 = b2 + kstep;
            PG8_LDB(B0, 0, 0); PG8_LDB(B1, 0, 1); PG8_SCHED; PG8_LDA(At, 0, 0); PG8_STAGE_A(PG8_SA(1, 1), a1, cva, 1);
            if constexpr (GATHER) { if (last) {
#pragma unroll
                for (int h = 0; h < 2; ++h)
#pragma unroll
                    for (int i = 0; i < 2; ++i) cva[h][i] = nva[h][i]; } }
            PG8_WAIT_V(8); PG8_WAIT_L(0); PG8_BAR; PG8_MMA(0, 0, At, B0); PG8_MMA(0, 1, At, B1); PG8_BAR; PG8_SCHED;
            PG8_LDA(At, 0, 1); PG8_STAGE(PG8_SB(0, 0), b2, voffB); PG8_STAGE(PG8_SB(0, 1), b2 + hstep, voffB); PG8_STAGE_A(PG8_SA(0, 0), a2, cva, 0);
            PG8_WAIT_V(8); PG8_WAIT_L(0); PG8_BAR; PG8_MMA(1, 0, At, B0); PG8_MMA(1, 1, At, B1); PG8_BAR; PG8_SCHED;
            PG8_LDB(B0, 1, 0); PG8_LDB(B1, 1, 1); PG8_SCHED; PG8_LDA(At, 1, 0); PG8_STAGE_A(PG8_SA(0, 1), a2, cva, 1);
            PG8_WAIT_V(8); PG8_WAIT_L(0); PG8_BAR; PG8_MMA(0, 0, At, B0); PG8_MMA(0, 1, At, B1); PG8_BAR; PG8_SCHED;
            PG8_LDA(At, 1, 1); PG8_STAGE(PG8_SB(1, 0), b3, voffB); PG8_STAGE(PG8_SB(1, 1), b3 + hstep, voffB); PG8_STAGE_A(PG8_SA(1, 0), a3, cva, 0);
            PG8_WAIT_V(8); PG8_WAIT_L(0); PG8_BAR; PG8_MMA(1, 0, At, B0); PG8_MMA(1, 1, At, B1); PG8_BAR; PG8_SCHED;
        }
        if constexpr (ALIGN_EPI) { if (wr == 0) PG8_BAR; }
#ifdef DBG_EPI_NOP
        asm volatile("s_nop 15\n s_nop 15\n s_nop 15\n s_nop 15" ::: "memory");
#endif
        { int le_ = lane; asm volatile("" : "+v"(le_));
          E(acc, cur, wr, wc, le_ & 15, le_ >> 4); }
        if (!has_next) break;
#pragma unroll
        for (int a = 0; a < 2; ++a)
#pragma unroll
            for (int b = 0; b < 2; ++b)
#pragma unroll
                for (int m = 0; m < 4; ++m)
#pragma unroll
                    for (int n = 0; n < 2; ++n) acc[a][b][m][n] = (f32x4){0.f, 0.f, 0.f, 0.f};
        cur = nxt; cA = nA; cB = nB; ++ui;
        if constexpr (ALIGN_EPI) { if (wr == 1) PG8_BAR; }
    }
    PG8_WAIT_V(0);
    if constexpr (!ALIGN_EPI) { if (wr == 0) PG8_BAR; }
    PG8_BAR;
#undef PG8_SA
#undef PG8_SB
#undef PG8_STAGE
#undef PG8_STAGE_A
#undef PG8_LDA
#undef PG8_LDB
#undef PG8_MMA
#undef PG8_WAIT_V
#undef PG8_WAIT_L
#undef PG8_BAR
#undef PG8_SCHED
}
}

constexpr int NWAVES = 8;
#ifndef MK_N_LAUNCHES
#define MK_N_LAUNCHES 1
#endif
constexpr int PER_PHASE = 13;
constexpr int N_LAUNCHES = MK_N_LAUNCHES;

constexpr int NTOK = 16384, SEQ = 2048, D = 1024, DIN = 3584, DSSM = 512, DCONV = 512, NGRP = 32, NST = 64, GWID = 16, CONVW = 31;
constexpr int NEXP = 32, EPG = 8, DEXP = 512, DPLE = 256, LC = 32, NCH = 64;
constexpr float EPS = 1e-6f;
enum In { I_X = 0, I_P, I_GMIX, I_WIN, I_BGATE, I_ARE, I_AIM, I_LOGDT, I_BRE, I_BIM, I_CRE, I_CIM, I_SD, I_WGLU, I_CDW, I_CDWB, I_CLNG, I_CLNB, I_WCO, I_WOUT, I_GMOE, I_WRG, I_BRG, I_WRE, I_BRE2,
          I_WEG, I_WEU, I_WED, I_GPLE, I_WPG, I_WPLE, I_GFIN, N_IN };

constexpr size_t MiB = 1u << 20;
constexpr size_t WS_CTL = 0, CTL_ZERO_BYTES = 1 * MiB;
constexpr size_t WS_LTOK = 1 * MiB;
constexpr size_t WS_TINFO = 3 * MiB;
constexpr size_t WS_R2 = 5 * MiB, WS_R3 = WS_R2 + 65536, WS_LAM32 = WS_R3 + 65536, WS_WRT = WS_R2 + 262144;
constexpr size_t WS_WST = 6 * MiB;
constexpr size_t WS_BT2 = 10 * MiB;
constexpr size_t WS_WING = 35 * MiB;
constexpr size_t WS_WIN = 31 * MiB, WS_WGLU = 38 * MiB, WS_WCO = 40 * MiB, WS_WO = 41 * MiB, WS_WPG = 43 * MiB, WS_WPLE = 45 * MiB;
constexpr size_t WS_PB = 46 * MiB;
constexpr size_t WS_WGU = 54 * MiB;
constexpr size_t WS_X2F = 86 * MiB;
constexpr size_t WS_WD = 118 * MiB;
constexpr float W8S = 64.0f, W8I = 1.0f / 64.0f;
constexpr size_t WS_B = 150 * MiB;
constexpr size_t WS_C = 182 * MiB;
constexpr size_t WS_E = 224 * MiB;
constexpr size_t WS_END = 288 * MiB;
constexpr int CW_TMO = 0, CW_CODE = 1, CW_BAR = 4096, CW_ECNT = 16384;
static_assert((CW_ECNT + 64 * NEXP) * 4 <= (int)CTL_ZERO_BYTES, "CTL words inside the memset region");

constexpr int RING_OFF = 0, RING_BYTES = 131072;
constexpr int LDSCTL_OFF = RING_BYTES, MISC_OFF = LDSCTL_OFF + 320;
constexpr int TB_OFF = LDSCTL_OFF + 1024;
constexpr int LDS_BYTES = 147456;
static_assert(TB_OFF + 100 * 4 <= LDS_BYTES, "LDS map");

#define GAS __attribute__((address_space(1)))
#define LAS __attribute__((address_space(3)))
typedef unsigned short bf16;
typedef unsigned v4u __attribute__((ext_vector_type(4)));
typedef unsigned v2u __attribute__((ext_vector_type(2)));
typedef float f32x4 __attribute__((ext_vector_type(4)));
typedef short bf16x8 __attribute__((ext_vector_type(8)));
typedef GAS unsigned gu32;
#define RLX_AGENT __ATOMIC_RELAXED, __HIP_MEMORY_SCOPE_AGENT
#define LDS_WAIT() asm volatile("s_waitcnt lgkmcnt(0)" ::: "memory")
#define VM_WAIT() asm volatile("s_waitcnt vmcnt(0)" ::: "memory")
__device__ __forceinline__ unsigned f2bf(float f) { unsigned u = __builtin_bit_cast(unsigned, f); return (u + 0x7fffu + ((u >> 16) & 1u)) >> 16; }
__device__ __forceinline__ unsigned pk2(float lo, float hi) { return pg8::cvt_pk_bf16(lo, hi); }
__device__ __forceinline__ unsigned pk4f8(float a, float b, float c, float d) { int w = __builtin_amdgcn_cvt_pk_fp8_f32(a, b, 0, false); w = __builtin_amdgcn_cvt_pk_fp8_f32(c, d, w, true); return (unsigned)w; }
__device__ __forceinline__ float bflo(unsigned v) { return __builtin_bit_cast(float, v << 16); }
__device__ __forceinline__ float bfhi(unsigned v) { return __builtin_bit_cast(float, v & 0xffff0000u); }
__device__ __forceinline__ float sigm(float x) { return __builtin_amdgcn_rcpf(1.0f + __expf(-x)); }
__device__ __forceinline__ float gelu_tanh(float y) { const float t = 1.5957691216f * (y + 0.044715f * y * y * y); return y * sigm(t); }

#define XB_TMO      128
#define XB_XCNT(j)  (256  + 64 * (j))
#define XB_XSUB(j)  (1280 + 64 * (j))
#define XB_XGEN(j)  (2304 + 64 * (j))
#define XB_TOP      3328
#define XB_TOPGEN   3392
#define XCD_BAR_WORDS 3456
#define XB_SPIN_CAP (1u << 18)

__device__ __forceinline__ unsigned xb_ld(unsigned* p)              { return __hip_atomic_load(p, __ATOMIC_RELAXED, __HIP_MEMORY_SCOPE_AGENT); }
__device__ __forceinline__ unsigned xb_add(unsigned* p, unsigned v) { return __hip_atomic_fetch_add(p, v, __ATOMIC_RELAXED, __HIP_MEMORY_SCOPE_AGENT); }
__device__ __forceinline__ unsigned xb_xcc_id() { return (unsigned)__builtin_amdgcn_s_getreg((3 << 11) | 20) & 0xFu; }
#define XB_SPIN(cond, bar) do { unsigned _sp = 0; while (cond) { __builtin_amdgcn_s_sleep(1); \
    if ((++_sp & 255u) == 0u) { if (xb_ld(&(bar)[XB_TMO])) break; if (_sp > XB_SPIN_CAP) { atomicAdd(&(bar)[XB_TMO], 1u); break; } } } } while (0)

struct XcdBarrier {
    unsigned* bar; unsigned x;
    volatile LAS unsigned* st;
    int wv;
};

__device__ __forceinline__ XcdBarrier xcd_barrier_post(unsigned* bar, volatile LAS unsigned* st) {
    XcdBarrier b; b.bar = bar; b.x = xb_xcc_id(); b.st = st; b.wv = 0;
    if (threadIdx.x == 0) (void)xb_add(&bar[XB_XCNT(b.x)], 1u);
    return b;
}
__device__ __forceinline__ void xcd_barrier_complete(unsigned* bar, unsigned x, unsigned& nloc, unsigned& nx) {
    const unsigned G = gridDim.x * gridDim.y * gridDim.z;
    unsigned sum, cnt, mine, sp = 0u;
    for (;;) {
        sum = 0u; cnt = 0u; mine = 0u;
#pragma unroll
        for (unsigned j = 0; j < 16; ++j) { const unsigned c = xb_ld(&bar[XB_XCNT(j)]); sum += c; cnt += (c > 0u) ? 1u : 0u; mine = (j == x) ? c : mine; }
        if (sum == G) break;
        __builtin_amdgcn_s_sleep(1);
        if ((++sp & 255u) == 0u) { if (xb_ld(&bar[XB_TMO])) break; if (sp > XB_SPIN_CAP) { atomicAdd(&bar[XB_TMO], 1u); break; } }
    }
    nloc = mine > 0u ? mine : 1u; nx = cnt > 0u ? cnt : 1u;
}

__device__ __forceinline__ void xcd_barrier(const XcdBarrier& b) {
    asm volatile("s_waitcnt vmcnt(0)" ::: "memory");
    __syncthreads();
    if (b.wv == 0 && __builtin_amdgcn_mbcnt_hi(~0u, __builtin_amdgcn_mbcnt_lo(~0u, 0u)) == 0u) {
        unsigned* bar = b.bar;
        __builtin_amdgcn_s_waitcnt(0);
        unsigned nloc = b.st[0], nx = b.st[1];
        if (nloc == 0u) { xcd_barrier_complete(bar, b.x, nloc, nx); b.st[0] = nloc; b.st[1] = nx; }
        const unsigned old = xb_add(&bar[XB_XSUB(b.x)], 1u);
        const unsigned gen = old / nloc;
        if (old + 1u == (gen + 1u) * nloc) {
            __builtin_amdgcn_fence(__ATOMIC_RELEASE, "agent");
            asm volatile("s_waitcnt vmcnt(0)" ::: "memory");
            const unsigned og = xb_add(&bar[XB_TOP], 1u);
            const unsigned tg = og / nx;
            if (og + 1u == (tg + 1u) * nx) xb_add(&bar[XB_TOPGEN], 1u);
            else XB_SPIN(xb_ld(&bar[XB_TOPGEN]) == tg, bar);
            __builtin_amdgcn_fence(__ATOMIC_ACQUIRE, "agent");
            xb_add(&bar[XB_XGEN(b.x)], 1u);
            asm volatile("s_waitcnt vmcnt(0)" ::: "memory");
        } else {
            XB_SPIN(xb_ld(&bar[XB_XGEN(b.x)]) == gen, bar);
            __builtin_amdgcn_fence(__ATOMIC_ACQUIRE, "agent");
            asm volatile("s_waitcnt vmcnt(0)" ::: "memory");
        }
    }
    __syncthreads();
}

struct Frame {
    LAS unsigned char* lds;
    volatile LAS unsigned* MISC;
    gu32* ctl;
    int tid, lane, wave;
    int vcu, G;
    const float* const* in;
    float* out; unsigned char* ws;
};
__device__ __forceinline__ float wave_sum(float v) {
#pragma unroll
    for (int o = 1; o < 64; o <<= 1) v += __shfl_xor(v, o);
    return v;
}

__device__ __forceinline__ int map_glu(int base, int o, int gate) { return base + 8 * (o >> 2) + 4 * gate + (o & 3); }
__device__ __forceinline__ int dest_row(int mode, int n, int half) {
    if (mode == 0) return n;
    if (mode == 1) { if (n < 512) return n; if (n < 1024) return map_glu(512, n - 512, 0); if (n < 1536) return map_glu(512, n - 1024, 1); return n; }
    if (mode == 2) return n < half ? map_glu(0, n, 0) : map_glu(0, n - half, 1);
    if (mode == 3) return map_glu(0, n, 0);
    if (mode == 5) return n - 1536;
    return map_glu(0, n, 1);
}
__device__ __forceinline__ void tr_item(const float* W, int K, int N, bf16* WT, int mode, int half, const float* ks, LAS unsigned* T, int item, int lane) {
    const int nblk = N / 64, kb = item / nblk, nb = item % nblk, k0 = 64 * kb, n0 = 64 * nb, nq = lane & 15, kq = lane >> 4;
    f32x4 v[8][2];
    const float* src = W + (size_t)(k0 + 2 * kq) * N + n0 + 4 * nq;
#pragma unroll
    for (int s = 0; s < 8; ++s) { v[s][0] = *(const GAS f32x4*)(src + (size_t)(8 * s) * N); v[s][1] = *(const GAS f32x4*)(src + (size_t)(8 * s + 1) * N); }
    if (ks) {
#pragma unroll
        for (int s = 0; s < 8; ++s) { const float a = ks[k0 + 8 * s + 2 * kq], b = ks[k0 + 8 * s + 2 * kq + 1]; v[s][0] *= a; v[s][1] *= b; } }
#pragma unroll
    for (int s = 0; s < 8; ++s)
#pragma unroll
        for (int jj = 0; jj < 4; ++jj) T[(4 * nq + jj) * 33 + 4 * s + kq] = pk2(v[s][0][jj], v[s][1][jj]);
    LDS_WAIT(); asm volatile("" ::: "memory");
    const int c = lane & 7;
#pragma unroll
    for (int i = 0; i < 8; ++i) { const int n = (lane >> 3) + 8 * i; const LAS unsigned* t = T + n * 33 + 4 * c;
        v4u o; o.x = t[0]; o.y = t[1]; o.z = t[2]; o.w = t[3];
        *(GAS v4u*)(WT + (size_t)dest_row(mode, n0 + n, half) * K + k0 + 8 * c) = o; }
    LDS_WAIT(); asm volatile("" ::: "memory");
}
__device__ __forceinline__ void tr_item8(const float* W, int K, int N, unsigned char* WT, int mode, int half, const float* ks, float sc, LAS unsigned* T, int item, int lane) {
    const int nblk = N / 64, kb = item / nblk, nb = item % nblk, k0 = 64 * kb, n0 = 64 * nb, nq = lane & 15, kq = lane >> 4;
    f32x4 v[4][4];
    const float* src = W + (size_t)(k0 + 4 * kq) * N + n0 + 4 * nq;
#pragma unroll
    for (int s = 0; s < 4; ++s)
#pragma unroll
        for (int r = 0; r < 4; ++r) v[s][r] = *(const GAS f32x4*)(src + (size_t)(16 * s + r) * N);
#pragma unroll
    for (int s = 0; s < 4; ++s)
#pragma unroll
        for (int r = 0; r < 4; ++r) v[s][r] *= ks ? ks[k0 + 16 * s + 4 * kq + r] * sc : sc;
#pragma unroll
    for (int s = 0; s < 4; ++s)
#pragma unroll
        for (int jj = 0; jj < 4; ++jj) T[(4 * nq + jj) * 17 + 4 * s + kq] = pk4f8(v[s][0][jj], v[s][1][jj], v[s][2][jj], v[s][3][jj]);
    LDS_WAIT(); asm volatile("" ::: "memory");
    const int c = lane & 3;
#pragma unroll
    for (int i = 0; i < 4; ++i) { const int n = (lane >> 2) + 16 * i; const LAS unsigned* t = T + n * 17 + 4 * c;
        v4u o; o.x = t[0]; o.y = t[1]; o.z = t[2]; o.w = t[3];
        *(GAS v4u*)(WT + (size_t)dest_row(mode, n0 + n, half) * K + k0 + 16 * c) = o; }
    LDS_WAIT(); asm volatile("" ::: "memory");
}
__device__ __forceinline__ void ssm_tables(Frame& F, int g) {
    LAS float* LP = (LAS float*)F.lds;
    LAS float* BB = LP + 33 * 64 * 2;
    LAS float* CC = BB + 2048;
    LAS float* KT = CC + 2048;
    const float* a_re = F.in[I_ARE]; const float* a_im = F.in[I_AIM]; const float* b_re = F.in[I_BRE]; const float* b_im = F.in[I_BIM];
    const float* c_re = F.in[I_CRE]; const float* c_im = F.in[I_CIM]; const float* sd = F.in[I_SD];
    {   const int n = F.tid & 63, tq = F.tid >> 6; const float dt = expf(F.in[I_LOGDT][g]); const float ar = a_re[g * 64 + n], ai = a_im[g * 64 + n]; const float bm = ar * dt, ba = ai * dt;
        for (int tau = tq; tau <= 32; tau += 8) { const float mag = expf(bm * (float)tau); float sn, cs; sincosf(ba * (float)tau, &sn, &cs); LP[(tau * 64 + n) * 2] = mag * cs; LP[(tau * 64 + n) * 2 + 1] = mag * sn; }
        const float mag = expf(bm); float sn, cs; sincosf(ba, &sn, &cs); const float lr = mag * cs, li = mag * sn;
        const float den = ar * ar + ai * ai, nr = lr - 1.0f, ni = li; const float zr = (nr * ar + ni * ai) / den, zi = (ni * ar - nr * ai) / den;
#pragma unroll
        for (int k = 0; k < 2; ++k) { const int ch = 2 * tq + k; const float br = b_re[(g * 64 + n) * 16 + ch], bi = b_im[(g * 64 + n) * 16 + ch];
            BB[(n * 16 + ch) * 2] = zr * br - zi * bi; BB[(n * 16 + ch) * 2 + 1] = zr * bi + zi * br; } }
    for (int e = F.tid; e < 1024; e += 512) { CC[e * 2] = c_re[g * 1024 + e]; CC[e * 2 + 1] = c_im[g * 1024 + e]; }
    __syncthreads();
    if (F.tid < 64) { float* l32 = (float*)(F.ws + WS_LAM32); l32[(g * 64 + F.tid) * 2] = LP[(32 * 64 + F.tid) * 2]; l32[(g * 64 + F.tid) * 2 + 1] = LP[(32 * 64 + F.tid) * 2 + 1]; }
    {
        const int p = F.tid & 255, cp = p >> 4, ch = p & 15, t0 = (F.tid >> 8) * 16; float kacc[16];
#pragma unroll
        for (int t = 0; t < 16; ++t) kacc[t] = 0.f;
        for (int n = 0; n < 64; ++n) {
            const float cr = CC[(cp * 64 + n) * 2], ci = CC[(cp * 64 + n) * 2 + 1], br = BB[(n * 16 + ch) * 2], bi = BB[(n * 16 + ch) * 2 + 1];
            const float pr = cr * br - ci * bi, pi = cr * bi + ci * br, l0r = LP[(t0 * 64 + n) * 2], l0i = LP[(t0 * 64 + n) * 2 + 1], lr = LP[(64 + n) * 2], li = LP[(64 + n) * 2 + 1];
            float wr_ = pr * l0r - pi * l0i, wi_ = pr * l0i + pi * l0r;
#pragma unroll
            for (int t = 0; t < 16; ++t) { kacc[t] += wr_; const float nr = wr_ * lr - wi_ * li, ni = wr_ * li + wi_ * lr; wr_ = nr; wi_ = ni; }
        }
#pragma unroll
        for (int t = 0; t < 16; ++t) KT[((t0 + t) << 8) + p] = kacc[t];
    }
    __syncthreads();
    bf16* Bt2 = (bf16*)(F.ws + WS_BT2) + (size_t)g * 512 * 640;
    for (int q = F.tid; q < 512 * 80; q += 512) {
        const int R = q / 80, cc = q % 80, t = R >> 4, cp = R & 15; float v[8];
        if (cc < 64) { const int j = cc >> 1, chb = (cc & 1) * 8;
#pragma unroll
            for (int i = 0; i < 8; ++i) { const int ch = chb + i; float x = (t >= j) ? KT[((t - j) << 8) + cp * 16 + ch] : 0.f; if (t == j && ch == cp) x += sd[g * 16 + ch]; v[i] = x; }
        } else { const int nb = (cc - 64) * 4;
#pragma unroll
            for (int i = 0; i < 4; ++i) { const int n = nb + i; const float cr = CC[(cp * 64 + n) * 2], ci = CC[(cp * 64 + n) * 2 + 1], lr = LP[((t + 1) * 64 + n) * 2], li = LP[((t + 1) * 64 + n) * 2 + 1];
                v[2 * i] = cr * lr - ci * li; v[2 * i + 1] = -(cr * li + ci * lr); }
        }
        v4u o; o.x = pk2(v[0], v[1]); o.y = pk2(v[2], v[3]); o.z = pk2(v[4], v[5]); o.w = pk2(v[6], v[7]);
        *(GAS v4u*)(Bt2 + (size_t)R * 640 + cc * 8) = o;
    }
    bf16* WsT = (bf16*)(F.ws + WS_WST) + (size_t)g * 128 * 512;
    for (int q = F.tid; q < 128 * 64; q += 512) {
        const int R = q >> 6, cc = q & 63, n = R >> 1, ri = R & 1, j = cc >> 1, chb = (cc & 1) * 8; float v[8];
        const float lr = LP[((31 - j) * 64 + n) * 2], li = LP[((31 - j) * 64 + n) * 2 + 1];
#pragma unroll
        for (int i = 0; i < 8; ++i) { const float br = BB[(n * 16 + chb + i) * 2], bi = BB[(n * 16 + chb + i) * 2 + 1]; v[i] = ri == 0 ? (lr * br - li * bi) : (lr * bi + li * br); }
        v4u o; o.x = pk2(v[0], v[1]); o.y = pk2(v[2], v[3]); o.z = pk2(v[4], v[5]); o.w = pk2(v[6], v[7]);
        *(GAS v4u*)(WsT + (size_t)R * 512 + cc * 8) = o;
    }
    __syncthreads();
}
__device__ __forceinline__ void p0_prologue(Frame& F) {
    const bool split = F.G > NGRP; const bool tabler = split && (int)blockIdx.x < NGRP;
#ifndef P0_REP_TAB
#define P0_REP_TAB 1
#define P0_REP_TR 1
#define P0_REP_ROWS 1
#endif
    for (int rp_ = 0; rp_ < P0_REP_TAB; ++rp_)
    if (!split || tabler) for (int g = blockIdx.x; g < NGRP; g += F.G) ssm_tables(F, g);
    LAS unsigned* scr = (LAS unsigned*)(F.lds + RING_OFF + F.wave * 16384);
    const int gw = F.vcu * NWAVES + F.wave, NGW = F.G * NWAVES;
    constexpr int I_IN = 16 * 56, I_GLU = 8 * 32, I_CO = 8 * 16, I_O = 16 * 16, I_PG = 16 * 16, I_PLE = 4 * 16, I_EG = 16 * 8, I_ED = 8 * 16;
    constexpr int NITEMS = I_IN + I_GLU + I_CO + I_O + I_PG + I_PLE + NEXP * (2 * I_EG + I_ED);
    const int tw = split ? ((int)blockIdx.x - NGRP) * NWAVES + F.wave : gw, NTW = split ? (F.G - NGRP) * NWAVES : NGW;
    for (int rp_ = 0; rp_ < P0_REP_TR; ++rp_)
    if (!tabler) for (int it = tw; it < NITEMS; it += NTW) {
        int r = it;
        if (r < I_IN) { if (r % (DIN / 64) < 24) tr_item(F.in[I_WIN], D, DIN, (bf16*)(F.ws + WS_WIN), 1, 0, nullptr, scr, r, F.lane);
                        else tr_item8(F.in[I_WIN], D, DIN, F.ws + WS_WING, 5, 0, nullptr, W8S, scr, r, F.lane); continue; } r -= I_IN;
        if (r < I_GLU) { tr_item(F.in[I_WGLU], DSSM, 2 * D, (bf16*)(F.ws + WS_WGLU), 2, D, nullptr, scr, r, F.lane); continue; } r -= I_GLU;
        if (r < I_CO) { tr_item(F.in[I_WCO], DCONV, D, (bf16*)(F.ws + WS_WCO), 0, 0, nullptr, scr, r, F.lane); continue; } r -= I_CO;
        if (r < I_O) { tr_item(F.in[I_WOUT], D, D, (bf16*)(F.ws + WS_WO), 0, 0, nullptr, scr, r, F.lane); continue; } r -= I_O;
        if (r < I_PG) { tr_item8(F.in[I_WPG], D, D, F.ws + WS_WPG, 0, 0, F.in[I_GPLE], W8S, scr, r, F.lane); continue; } r -= I_PG;
        if (r < I_PLE) { tr_item(F.in[I_WPLE], DPLE, D, (bf16*)(F.ws + WS_WPLE), 0, 0, nullptr, scr, r, F.lane); continue; } r -= I_PLE;
        const int e = r / (2 * I_EG + I_ED); r -= e * (2 * I_EG + I_ED);
        if (r < I_EG) { tr_item8(F.in[I_WEG] + (size_t)e * D * DEXP, D, DEXP, F.ws + WS_WGU + (size_t)e * D * D, 3, 0, F.in[I_GMOE], W8S, scr, r, F.lane); continue; } r -= I_EG;
        if (r < I_EG) { tr_item8(F.in[I_WEU] + (size_t)e * D * DEXP, D, DEXP, F.ws + WS_WGU + (size_t)e * D * D, 4, 0, F.in[I_GMOE], W8S, scr, r, F.lane); continue; } r -= I_EG;
        tr_item8(F.in[I_WED] + (size_t)e * DEXP * D, DEXP, D, F.ws + WS_WD + (size_t)e * D * DEXP, 0, 0, nullptr, W8S, scr, r, F.lane);
    }
    for (int rp_ = 0; rp_ < P0_REP_ROWS; ++rp_) { const float* x = F.in[I_X]; const float* gm = F.in[I_GMIX]; bf16* XN = (bf16*)(F.ws + WS_B);
      f32x4 gv[4];
#pragma unroll
      for (int j = 0; j < 4; ++j) gv[j] = *(const f32x4*)(gm + 4 * F.lane + 256 * j);
      for (int m = gw; m < NTOK; m += NGW) {
        const GAS f32x4* xr = (const GAS f32x4*)(x + (size_t)m * D) + F.lane; f32x4 v[4]; float s = 0.f;
#pragma unroll
        for (int j = 0; j < 4; ++j) { v[j] = xr[64 * j]; s += (v[j].x * v[j].x + v[j].y * v[j].y) + (v[j].z * v[j].z + v[j].w * v[j].w); }
        const float r = 1.0f / sqrtf(wave_sum(s) * (1.f / D) + EPS);
        GAS v2u* o8 = (GAS v2u*)(XN + (size_t)m * D) + F.lane;
#pragma unroll
        for (int j = 0; j < 4; ++j) { const f32x4 h = v[j] * r * gv[j]; v2u o; o.x = pk2(h.x, h.y); o.y = pk2(h.z, h.w); o8[64 * j] = o;
            *((GAS unsigned*)(F.ws + WS_E + (size_t)m * D) + F.lane + 64 * j) = pk4f8(h.x, h.y, h.z, h.w); }
      } }
    { const float* p = F.in[I_P]; bf16* PB = (bf16*)(F.ws + WS_PB); const int gt = F.vcu * 512 + F.tid, NGT = F.G * 512;
      for (int q = gt; q < NTOK * DPLE / 8; q += NGT) { const f32x4 a = *(const f32x4*)(p + (size_t)q * 8), b = *(const f32x4*)(p + (size_t)q * 8 + 4);
        v4u o; o.x = pk2(a.x, a.y); o.y = pk2(a.z, a.w); o.z = pk2(b.x, b.y); o.w = pk2(b.z, b.w); *(GAS v4u*)(PB + (size_t)q * 8) = o; }
      bf16* WRT = (bf16*)(F.ws + WS_WRT); const float* gmoe = F.in[I_GMOE];
      for (int q = gt; q < 48 * 1024; q += NGT) { const int o = q >> 10, k = q & 1023; float v = 0.f;
        if (o < 4) v = F.in[I_WRG][k * 4 + o] * gmoe[k]; else if (o < 36) v = F.in[I_WRE][k * 32 + (o - 4)] * gmoe[k];
        const unsigned h = f2bf(v); const float lo = v - __builtin_bit_cast(float, h << 16); WRT[q] = (bf16)h; WRT[48 * 1024 + q] = (bf16)f2bf(lo); } }
}

using pg8::Unit;
typedef const f32x4 (&AccRef)[2][2][4][2];
struct EpiP1 {
    bf16* U; bf16* Z;
    __device__ __forceinline__ void operator()(AccRef acc, const Unit& u, int wr, int wc, int fr, int fq) const {
        const int r0 = u.pm * 256 + wr * 64 + fr;
        if (u.pn < 2) {
#pragma unroll
            for (int ai = 0; ai < 2; ++ai)
#pragma unroll
                for (int m = 0; m < 4; ++m) { const int r = r0 + ai * 128 + m * 16, b = r >> 11, t = r & 2047;
#pragma unroll
                    for (int bj = 0; bj < 2; ++bj) { const int c0 = u.pn * 256 + bj * 128 + wc * 32 + fq * 8, g = c0 >> 4, ch0 = c0 & 15;
                        const f32x4 v0 = acc[ai][bj][m][0], v1 = acc[ai][bj][m][1];
                        v4u w; w.x = pk2(v0[0], v0[1]); w.y = pk2(v0[2], v0[3]); w.z = pk2(v1[0], v1[1]); w.w = pk2(v1[2], v1[3]);
                        *(GAS v4u*)(U + (((size_t)(b * 32 + g) * 2048 + t) * 16 + ch0)) = w; } }
        } else {
#pragma unroll
            for (int ai = 0; ai < 2; ++ai)
#pragma unroll
                for (int m = 0; m < 4; ++m) { const int r = r0 + ai * 128 + m * 16;
#pragma unroll
                    for (int bj = 0; bj < 2; ++bj) { const int o0 = (u.pn - 2) * 128 + bj * 64 + wc * 16 + fq * 4;
                        const f32x4 va = acc[ai][bj][m][0], ga = acc[ai][bj][m][1];
                        v2u w; w.x = pk2(va[0] * sigm(ga[0]), va[1] * sigm(ga[1])); w.y = pk2(va[2] * sigm(ga[2]), va[3] * sigm(ga[3]));
                        *(GAS v2u*)(Z + (size_t)r * 512 + o0) = w; } }
        }
    }
};
struct EpiGate {
    bf16* SG; const float* bg;
    __device__ __forceinline__ void operator()(AccRef acc, const Unit& u, int wr, int wc, int fr, int fq) const {
        const int r0 = u.pm * 256 + wr * 64 + fr;
#pragma unroll
        for (int bj = 0; bj < 2; ++bj) { const int s0 = u.pn * 256 + bj * 128 + wc * 32 + fq * 8;
            const f32x4 b0 = *(const f32x4*)(bg + s0), b1 = *(const f32x4*)(bg + s0 + 4);
#pragma unroll
            for (int ai = 0; ai < 2; ++ai)
#pragma unroll
                for (int m = 0; m < 4; ++m) { const int r = r0 + ai * 128 + m * 16;
                    const f32x4 v0 = acc[ai][bj][m][0] * W8I + b0, v1 = acc[ai][bj][m][1] * W8I + b1;
                    v4u w; w.x = pk2(sigm(v0[0]), sigm(v0[1])); w.y = pk2(sigm(v0[2]), sigm(v0[3])); w.z = pk2(sigm(v1[0]), sigm(v1[1])); w.w = pk2(sigm(v1[2]), sigm(v1[3]));
                    *(GAS v4u*)(SG + (size_t)r * 2048 + s0) = w; } }
    }
};
struct EpiGlu {
    bf16* MS; const bf16* SG;
    static __device__ __forceinline__ void run(AccRef acc, const Unit& u, int wr, int wc, int fr, int fq, bf16* __restrict__ MS, const bf16* __restrict__ SG) {
        const int r0 = u.pm * 256 + wr * 64 + fr;
#pragma unroll
        for (int ai = 0; ai < 2; ++ai)
#pragma unroll
            for (int m = 0; m < 4; ++m) { const int r = r0 + ai * 128 + m * 16;
#pragma unroll
                for (int bj = 0; bj < 2; ++bj) { const int o0 = u.pn * 128 + bj * 64 + wc * 16 + fq * 4;
                    const v2u sg = *(const GAS v2u*)(SG + (size_t)r * 2048 + o0);
                    const f32x4 va = acc[ai][bj][m][0], ga = acc[ai][bj][m][1];
                    v2u o; o.x = pk2(va[0] * sigm(ga[0]) * bflo(sg.x), va[1] * sigm(ga[1]) * bfhi(sg.x)); o.y = pk2(va[2] * sigm(ga[2]) * bflo(sg.y), va[3] * sigm(ga[3]) * bfhi(sg.y));
                    *(GAS v2u*)(MS + (size_t)r * 1024 + o0) = o; } }
    }
    __device__ __forceinline__ void operator()(AccRef acc, const Unit& u, int wr, int wc, int fr, int fq) const { run(acc, u, wr, wc, fr, fq, MS, SG); }
};
struct EpiCo {
    const bf16* MS; const bf16* SG; bf16* MG;
    static __device__ __forceinline__ void run(AccRef acc, const Unit& u, int wr, int wc, int fr, int fq, const bf16* __restrict__ MS, const bf16* __restrict__ SG, bf16* __restrict__ MG) {
        const int r0 = u.pm * 256 + wr * 64 + fr;
#pragma unroll
        for (int ai = 0; ai < 2; ++ai)
#pragma unroll
            for (int m = 0; m < 4; ++m) { const int r = r0 + ai * 128 + m * 16;
#pragma unroll
                for (int bj = 0; bj < 2; ++bj) { const int c0 = u.pn * 256 + bj * 128 + wc * 32 + fq * 8;
                    const v4u ms = *(const GAS v4u*)(MS + (size_t)r * 1024 + c0);
                    const v4u sg = *(const GAS v4u*)(SG + (size_t)r * 2048 + 1024 + c0);
                    const f32x4 v0 = acc[ai][bj][m][0], v1 = acc[ai][bj][m][1];
                    v4u w; w.x = pk2(bflo(ms.x) + bflo(sg.x) * v0[0], bfhi(ms.x) + bfhi(sg.x) * v0[1]); w.y = pk2(bflo(ms.y) + bflo(sg.y) * v0[2], bfhi(ms.y) + bfhi(sg.y) * v0[3]);
                    w.z = pk2(bflo(ms.z) + bflo(sg.z) * v1[0], bfhi(ms.z) + bfhi(sg.z) * v1[1]); w.w = pk2(bflo(ms.w) + bflo(sg.w) * v1[2], bfhi(ms.w) + bfhi(sg.w) * v1[3]);
                    *(GAS v4u*)(MG + (size_t)r * 1024 + c0) = w; } }
    }
    __device__ __forceinline__ void operator()(AccRef acc, const Unit& u, int wr, int wc, int fr, int fq) const { run(acc, u, wr, wc, fr, fq, MS, SG, MG); }
};
struct EpiRes {
    const float* X; bf16* X1B; unsigned char* X1F;
    static __device__ __forceinline__ void run(AccRef acc, const Unit& u, int wr, int wc, int fr, int fq, const float* __restrict__ X, bf16* __restrict__ X1B, unsigned char* __restrict__ X1F) {
        const int r0 = u.pm * 256 + wr * 64 + fr;
#pragma unroll
        for (int ai = 0; ai < 2; ++ai)
#pragma unroll
            for (int m = 0; m < 4; ++m) { const int r = r0 + ai * 128 + m * 16;
#pragma unroll
                for (int bj = 0; bj < 2; ++bj) { const size_t o = (size_t)r * 1024 + u.pn * 256 + bj * 128 + wc * 32 + fq * 8;
                    const f32x4 x0 = *(const GAS f32x4*)(X + o) + acc[ai][bj][m][0], x1 = *(const GAS f32x4*)(X + o + 4) + acc[ai][bj][m][1];
                    v4u w; w.x = pk2(x0[0], x0[1]); w.y = pk2(x0[2], x0[3]); w.z = pk2(x1[0], x1[1]); w.w = pk2(x1[2], x1[3]);
                    *(GAS v4u*)(X1B + o) = w;
                    v2u f; f.x = pk4f8(x0[0], x0[1], x0[2], x0[3]); f.y = pk4f8(x1[0], x1[1], x1[2], x1[3]); *(GAS v2u*)(X1F + o) = f; } }
    }
    __device__ __forceinline__ void operator()(AccRef acc, const Unit& u, int wr, int wc, int fr, int fq) const { run(acc, u, wr, wc, fr, fq, X, X1B, X1F); }
};
struct EpiAct {
    unsigned char* ACT; const int* ltok; const float* R2;
    static __device__ __forceinline__ void run(AccRef acc, const Unit& u, int wr, int wc, int fr, int fq, unsigned char* __restrict__ ACT, const int* __restrict__ ltok, const float* __restrict__ R2) {
        float rr[2][4];
#pragma unroll
        for (int ai = 0; ai < 2; ++ai)
#pragma unroll
            for (int m = 0; m < 4; ++m) { const int rl = ai * 128 + wr * 64 + m * 16 + fr; const int tok = (rl < u.rows) ? ltok[u.e * NTOK + u.mt * 256 + rl] : 0; rr[ai][m] = R2[tok] * W8I; }
#pragma unroll
        for (int ai = 0; ai < 2; ++ai)
#pragma unroll
            for (int m = 0; m < 4; ++m) { const int rl = ai * 128 + wr * 64 + m * 16 + fr;
                if (rl < u.rows) {
#pragma unroll
                    for (int bj = 0; bj < 2; ++bj) { const int o0 = u.pn * 128 + bj * 64 + wc * 16 + fq * 4;
                        const f32x4 ga = acc[ai][bj][m][0] * rr[ai][m], ua = acc[ai][bj][m][1] * rr[ai][m];
                        *(GAS unsigned*)(ACT + (size_t)(u.pm * 256 + rl) * 512 + o0) = pk4f8(ga[0] * sigm(ga[0]) * ua[0], ga[1] * sigm(ga[1]) * ua[1], ga[2] * sigm(ga[2]) * ua[2], ga[3] * sigm(ga[3]) * ua[3]); } } }
    }
    __device__ __forceinline__ void operator()(AccRef acc, const Unit& u, int wr, int wc, int fr, int fq) const { run(acc, u, wr, wc, fr, fq, ACT, ltok, R2); }
};
struct EpiY {
    bf16* Y;
    __device__ __forceinline__ void operator()(AccRef acc, const Unit& u, int wr, int wc, int fr, int fq) const {
#pragma unroll
        for (int ai = 0; ai < 2; ++ai)
#pragma unroll
            for (int m = 0; m < 4; ++m) { const int rl = ai * 128 + wr * 64 + m * 16 + fr;
                if (rl < u.rows) {
#pragma unroll
                    for (int bj = 0; bj < 2; ++bj) { const f32x4 v0 = acc[ai][bj][m][0] * W8I, v1 = acc[ai][bj][m][1] * W8I;
                        v4u w; w.x = pk2(v0[0], v0[1]); w.y = pk2(v0[2], v0[3]); w.z = pk2(v1[0], v1[1]); w.w = pk2(v1[2], v1[3]);
                        *(GAS v4u*)(Y + (size_t)(u.cb + rl) * 1024 + u.pn * 256 + bj * 128 + wc * 32 + fq * 8) = w; } } }
    }
};
struct EpiE {
    bf16* EO;
    __device__ __forceinline__ void operator()(AccRef acc, const Unit& u, int wr, int wc, int fr, int fq) const {
        const int r0 = u.pm * 256 + wr * 64 + fr;
#pragma unroll
        for (int ai = 0; ai < 2; ++ai)
#pragma unroll
            for (int m = 0; m < 4; ++m) { const int r = r0 + ai * 128 + m * 16;
#pragma unroll
                for (int bj = 0; bj < 2; ++bj) { const size_t o = (size_t)r * 1024 + u.pn * 256 + bj * 128 + wc * 32 + fq * 8; const f32x4 v0 = acc[ai][bj][m][0], v1 = acc[ai][bj][m][1];
                    v4u w; w.x = pk2(v0[0], v0[1]); w.y = pk2(v0[2], v0[3]); w.z = pk2(v1[0], v1[1]); w.w = pk2(v1[2], v1[3]);
                    *(GAS v4u*)(EO + o) = w; } }
    }
};
struct EpiPle {
    const bf16* X2; const bf16* EO; const float* R3; bf16* X3;
    static __device__ __forceinline__ void run(AccRef acc, const Unit& u, int wr, int wc, int fr, int fq, const bf16* __restrict__ X2, const bf16* __restrict__ EO, const float* __restrict__ R3, bf16* __restrict__ X3) {
        const int r0 = u.pm * 256 + wr * 64 + fr;
#pragma unroll
        for (int ai = 0; ai < 2; ++ai)
#pragma unroll
            for (int m = 0; m < 4; ++m) { const int r = r0 + ai * 128 + m * 16; const float r3 = R3[r] * W8I;
#pragma unroll
                for (int bj = 0; bj < 2; ++bj) { const size_t o = (size_t)r * 1024 + u.pn * 256 + bj * 128 + wc * 32 + fq * 8;
                    const v4u x = *(const GAS v4u*)(X2 + o), e = *(const GAS v4u*)(EO + o);
                    const f32x4 a0 = acc[ai][bj][m][0] * r3, a1 = acc[ai][bj][m][1] * r3;
                    v4u w; w.x = pk2(bflo(x.x) + sigm(a0[0]) * bflo(e.x), bfhi(x.x) + sigm(a0[1]) * bfhi(e.x)); w.y = pk2(bflo(x.y) + sigm(a0[2]) * bflo(e.y), bfhi(x.y) + sigm(a0[3]) * bfhi(e.y));
                    w.z = pk2(bflo(x.z) + sigm(a1[0]) * bflo(e.z), bfhi(x.z) + sigm(a1[1]) * bfhi(e.z)); w.w = pk2(bflo(x.w) + sigm(a1[2]) * bflo(e.w), bfhi(x.w) + sigm(a1[3]) * bfhi(e.w));
                    *(GAS v4u*)(X3 + o) = w; } }
    }
    __device__ __forceinline__ void operator()(AccRef acc, const Unit& u, int wr, int wc, int fr, int fq) const { run(acc, u, wr, wc, fr, fq, X2, EO, R3, X3); }
};
struct DenseOrder : pg8::StaticOrder {
    const char* A; const char* Bt; size_t tstep;
    __device__ __forceinline__ const char* a_base(const Unit& u) const { return A + (size_t)u.pm * tstep; }
    __device__ __forceinline__ const char* b_base(const Unit& u) const { return Bt + (size_t)u.pn * tstep; }
    __device__ __forceinline__ unsigned row_off(const Unit&, int) const { return 0u; }
};
struct DenseRowsOrder : DenseOrder {
    __device__ __forceinline__ const char* a_base(const Unit&) const { return A; }
    __device__ __forceinline__ unsigned row_off(const Unit& u, int r) const { return (unsigned)(u.pm * 256 + r) * (unsigned)(tstep / 256); }
};
struct GluPairOrder : DenseOrder {
    __device__ __forceinline__ bool next(int i, Unit& u) const { if (i >= 2) return false; Unit t; if (!pg8::StaticOrder::next(0, t)) return false; u = t; u.pn = 2 * t.pn + i; return true; }
};
struct MoeOrder {
    const LAS int* tb; const LAS int* cn; int G, c, K, npn;
    const char* A; const char* Bt; size_t b_estride; const int* ltok; bool gather;
    __device__ __forceinline__ bool next(int i, Unit& u) const {
        const int L = i * G + c, total = tb[NEXP] * npn; if (L >= total) return false;
        const int tile = L / npn; int e = 0;
        for (int k = 1; k < NEXP; ++k) e += (tb[k] <= tile) ? 1 : 0;
        u.e = e; u.pm = tile; u.pn = L % npn; u.mt = tile - tb[e]; const int left = cn[e] - u.mt * 256; u.rows = left < 256 ? left : 256; u.cb = cn[33 + e] + u.mt * 256; return true;
    }
    __device__ __forceinline__ const char* a_base(const Unit& u) const { return gather ? A : A + (size_t)u.pm * 256 * K * 2; }
    __device__ __forceinline__ const char* b_base(const Unit& u) const { return Bt + (size_t)u.e * b_estride + (size_t)u.pn * 256 * K * 2; }
    __device__ __forceinline__ unsigned row_off(const Unit& u, int r) const { if (!ltok) return (unsigned)(u.pm * 256 + r) * (unsigned)(K * 2);
        const int tok = (r < u.rows) ? ltok[u.e * NTOK + u.mt * 256 + r] : 0; return (unsigned)tok * (unsigned)(K * 2); }
};

constexpr int SSM_AP = 1296;
__device__ __forceinline__ void ssm_unit(Frame& F, int b, int g) {
    LAS unsigned char* Al = F.lds;
    LAS float* SL = (LAS float*)(F.lds + 64 * SSM_AP);
    const int fr = F.lane & 15, fq = F.lane >> 4, w = F.wave;
    const bf16* Ug = (const bf16*)(F.ws + WS_C) + (size_t)(b * 32 + g) * 2048 * 16;
#pragma unroll 4
    for (int q = F.tid; q < 4096; q += 512) { const int row = q >> 6, cc = q & 63; const v4u v = *(const GAS v4u*)(Ug + row * 512 + cc * 8); *(LAS v4u*)(Al + row * SSM_AP + cc * 16) = v; }
    __syncthreads();
    {
        const bf16* WS = (const bf16*)(F.ws + WS_WST) + ((size_t)g * 128 + 16 * w + fr) * 512 + 8 * fq;
        f32x4 acc[4];
#pragma unroll
        for (int m = 0; m < 4; ++m) acc[m] = (f32x4){0.f, 0.f, 0.f, 0.f};
#pragma unroll 4
        for (int s = 0; s < 16; ++s) { const bf16x8 bw = *(const GAS bf16x8*)(WS + 32 * s);
#pragma unroll
            for (int m = 0; m < 4; ++m) { const bf16x8 a = *(const LAS bf16x8*)(Al + (16 * m + fr) * SSM_AP + (32 * s + 8 * fq) * 2); acc[m] = __builtin_amdgcn_mfma_f32_16x16x32_bf16(bw, a, acc[m], 0, 0, 0); } }
#pragma unroll
        for (int m = 0; m < 4; ++m) *(LAS f32x4*)(SL + (16 * m + fr) * 132 + 16 * w + 4 * fq) = acc[m];
    }
    __syncthreads();
    if (w == 0) {
        const int n = F.lane; const float* l32 = (const float*)(F.ws + WS_LAM32) + (g * 64 + n) * 2; const float lr = l32[0], li = l32[1]; float sr = 0.f, si = 0.f;
        for (int c = 0; c < NCH; ++c) { *(LAS unsigned*)(Al + c * SSM_AP + 1024 + 4 * n) = pk2(sr, si);
            const float ur = SL[c * 132 + 2 * n], ui = SL[c * 132 + 2 * n + 1]; const float nr = lr * sr - li * si + ur, ni = lr * si + li * sr + ui; sr = nr; si = ni; }
    }
    __syncthreads();
    {
        const bf16* BT = (const bf16*)(F.ws + WS_BT2) + ((size_t)g * 512 + 64 * w + fr) * 640 + 8 * fq;
        f32x4 acc[4][4];
#pragma unroll
        for (int m = 0; m < 4; ++m)
#pragma unroll
            for (int n = 0; n < 4; ++n) acc[m][n] = (f32x4){0.f, 0.f, 0.f, 0.f};
#pragma unroll 2
        for (int s = 0; s < 20; ++s) { bf16x8 bf[4], af[4];
#pragma unroll
            for (int n = 0; n < 4; ++n) bf[n] = *(const GAS bf16x8*)(BT + (size_t)n * 16 * 640 + 32 * s);
#pragma unroll
            for (int m = 0; m < 4; ++m) af[m] = *(const LAS bf16x8*)(Al + (16 * m + fr) * SSM_AP + (32 * s + 8 * fq) * 2);
#pragma unroll
            for (int m = 0; m < 4; ++m)
#pragma unroll
                for (int n = 0; n < 4; ++n) acc[m][n] = __builtin_amdgcn_mfma_f32_16x16x32_bf16(bf[n], af[m], acc[m][n], 0, 0, 0); }
        bf16* GY = (bf16*)(F.ws + WS_B);
#pragma unroll
        for (int m = 0; m < 4; ++m)
#pragma unroll
            for (int n = 0; n < 4; ++n) { const int tok = b * SEQ + LC * (16 * m + fr) + 4 * w + n; const f32x4 y = acc[m][n];
                v2u o; o.x = pk2(gelu_tanh(y[0]), gelu_tanh(y[1])); o.y = pk2(gelu_tanh(y[2]), gelu_tanh(y[3]));
                *(GAS v2u*)(GY + (size_t)tok * 512 + 16 * g + 4 * fq) = o; }
    }
    __syncthreads();
}
__device__ __forceinline__ void conv_tile(Frame& F, int tile) {
    const int tok0 = tile * 64, b = tok0 >> 11, t0 = tok0 & 2047;
    LAS unsigned* zl = (LAS unsigned*)F.lds;
    LAS float* red = (LAS float*)(F.lds + 98304);
    const bf16* Z = (const bf16*)(F.ws + WS_C + 16 * MiB);
#pragma unroll 2
    for (int q = F.tid; q < 94 * 64; q += 512) { const int rr = q >> 6, cc = q & 63, t = t0 - 30 + rr; v4u v = (v4u){0u, 0u, 0u, 0u};
        if (t >= 0) v = *(const GAS v4u*)(Z + (size_t)(b * SEQ + t) * 512 + cc * 8); *(LAS v4u*)(zl + rr * 256 + cc * 4) = v; }
    __syncthreads();
    const int wq = F.wave & 3, th = F.wave >> 2, cp = wq * 64 + F.lane;
    float dw0[31], dw1[31];
    {   const float* pw = F.in[I_CDW] + 2 * cp;
        typedef float f32x2 __attribute__((ext_vector_type(2)));
#pragma unroll
        for (int k = 0; k < 31; ++k) { const f32x2 v = *(const GAS f32x2*)pw; dw0[k] = v.x; dw1[k] = v.y; pw += 512; asm volatile("" : "+v"(pw)); } }
    const float cb0 = F.in[I_CDWB][2 * cp], cb1 = F.in[I_CDWB][2 * cp + 1], lg0 = F.in[I_CLNG][2 * cp], lg1 = F.in[I_CLNG][2 * cp + 1], lb0 = F.in[I_CLNB][2 * cp], lb1 = F.in[I_CLNB][2 * cp + 1];
    bf16* CA = (bf16*)(F.ws + WS_B + 16 * MiB);
#pragma unroll 1
    for (int ch = 0; ch < 4; ++ch) {
        float a0[8], a1[8];
#pragma unroll
        for (int o = 0; o < 8; ++o) { a0[o] = cb0; a1[o] = cb1; }
        const int rbase = th * 32 + ch * 8;
#pragma unroll
        for (int r = 0; r < 38; ++r) { const unsigned v = zl[(rbase + r) * 256 + cp]; const float x0 = bflo(v), x1 = bfhi(v);
#pragma unroll
            for (int o = 0; o < 8; ++o) { const int k = r - o; if (k >= 0 && k <= 30) { a0[o] += dw0[k] * x0; a1[o] += dw1[k] * x1; } }
            __builtin_amdgcn_sched_barrier(0); }
        LAS float* rp = red + ((ch & 1) * 2 + th) * 64;
#pragma unroll
        for (int o = 0; o < 8; ++o) { const float s = wave_sum(a0[o] + a1[o]), q = wave_sum(a0[o] * a0[o] + a1[o] * a1[o]); if (F.lane == 0) { rp[(o * 4 + wq) * 2] = s; rp[(o * 4 + wq) * 2 + 1] = q; } }
        __syncthreads();
#pragma unroll
        for (int o = 0; o < 8; ++o) { float s = 0.f, q = 0.f;
#pragma unroll
            for (int k = 0; k < 4; ++k) { s += rp[(o * 4 + k) * 2]; q += rp[(o * 4 + k) * 2 + 1]; }
            const float mean = s * (1.f / 512.f), var = q * (1.f / 512.f) - mean * mean, rstd = 1.0f / sqrtf(var + EPS);
            const float y0 = (a0[o] - mean) * rstd * lg0 + lb0, y1 = (a1[o] - mean) * rstd * lg1 + lb1;
            *(GAS unsigned*)(CA + (size_t)(tok0 + rbase + o) * 512 + 2 * cp) = pk2(y0 * sigm(y0), y1 * sigm(y1)); }
    }
    __syncthreads();
}
__device__ __forceinline__ void router_phase(Frame& F) {
    const int fr = F.lane & 15, fq = F.lane >> 4, tl = F.wave & 3, kh = F.wave >> 2;
    const bf16* XB = (const bf16*)(F.ws + WS_B); float* R2 = (float*)(F.ws + WS_R2);
    const bf16* WRT = (const bf16*)(F.ws + WS_WRT); int* ltok = (int*)(F.ws + WS_LTOK); int* tinfo = (int*)(F.ws + WS_TINFO);
    LAS float* part = (LAS float*)(F.lds + 32768);
    LAS float* lg = (LAS float*)(F.lds + tl * 4096);
    LAS unsigned* lcnt = (LAS unsigned*)(F.lds + 49152);
    LAS unsigned* lbase = lcnt + 32;
    LAS unsigned* dec = lcnt + 64;
    if (F.tid < NEXP) lcnt[F.tid] = 0u;
    __syncthreads();
    for (int tg = F.vcu; tg < NTOK / 64; tg += F.G) {
        const int tile = tg * 4 + tl, tok = tile * 16 + fr;
        const bf16* xr = XB + (size_t)tok * D + 512 * kh + 8 * fq; const bf16* wh = WRT + (size_t)fr * D + 512 * kh + 8 * fq;
        f32x4 acc[3]; float ss = 0.f;
#pragma unroll
        for (int n = 0; n < 3; ++n) acc[n] = (f32x4){0.f, 0.f, 0.f, 0.f};
#pragma unroll 4
        for (int s = 0; s < 16; ++s) {
            const v4u h = *(const GAS v4u*)(xr + 32 * s);
            const float a0 = bflo(h.x), a1 = bfhi(h.x), a2 = bflo(h.y), a3 = bfhi(h.y), a4 = bflo(h.z), a5 = bfhi(h.z), a6 = bflo(h.w), a7 = bfhi(h.w);
            ss += (a0 * a0 + a1 * a1) + (a2 * a2 + a3 * a3) + (a4 * a4 + a5 * a5) + (a6 * a6 + a7 * a7);
            const bf16x8 xh = __builtin_bit_cast(bf16x8, h);
#pragma unroll
            for (int n = 0; n < 3; ++n) { const bf16x8 whi = *(const GAS bf16x8*)(wh + (size_t)n * 16 * D + 32 * s), wlo = *(const GAS bf16x8*)(wh + (size_t)(48 + n * 16) * D + 32 * s);
                acc[n] = __builtin_amdgcn_mfma_f32_16x16x32_bf16(whi, xh, acc[n], 0, 0, 0); acc[n] = __builtin_amdgcn_mfma_f32_16x16x32_bf16(wlo, xh, acc[n], 0, 0, 0); }
        }
        ss += __shfl_xor(ss, 16); ss += __shfl_xor(ss, 32);
        if (kh == 1) { LAS float* pp = part + (tl * 64 + F.lane) * 13;
#pragma unroll
            for (int n = 0; n < 3; ++n)
#pragma unroll
                for (int j = 0; j < 4; ++j) pp[4 * n + j] = acc[n][j];
            pp[12] = ss; }
        __syncthreads();
        if (kh == 0) {
            const LAS float* pp = part + (tl * 64 + F.lane) * 13;
            ss += pp[12];
            const float r = 1.0f / sqrtf(ss * (1.f / D) + EPS);
            if (fq == 0) R2[tok] = r;
#pragma unroll
            for (int n = 0; n < 3; ++n)
#pragma unroll
                for (int j = 0; j < 4; ++j) { const int o = 16 * n + 4 * fq + j; if (o < 36) { const float bias = o < 4 ? F.in[I_BRG][o] : F.in[I_BRE2][o - 4]; lg[fr * 49 + o] = (acc[n][j] + pp[4 * n + j]) * r + bias; } }
            LDS_WAIT(); asm volatile("" ::: "memory");
            if (F.lane < 16) {
                const LAS float* l = lg + F.lane * 49;
                float gm = l[0]; int gs = 0;
#pragma unroll
                for (int i = 1; i < 4; ++i) if (l[i] > gm) { gm = l[i]; gs = i; }
                float den = 0.f;
#pragma unroll
                for (int i = 0; i < 4; ++i) den += __expf(l[i] - gm);
                const float pg = 1.0f / den;
                const LAS float* el = l + 4 + 8 * gs;
                float v1 = el[0]; int j1 = 0;
#pragma unroll
                for (int i = 1; i < 8; ++i) if (el[i] > v1) { v1 = el[i]; j1 = i; }
                float v2 = -3.0e38f; int j2 = 0;
#pragma unroll
                for (int i = 0; i < 8; ++i) if (i != j1 && el[i] > v2) { v2 = el[i]; j2 = i; }
                const float w1 = pg / (1.0f + __expf(v2 - v1)), w2 = pg - w1;
                const int e1 = gs * 8 + j1, e2 = gs * 8 + j2;
                const unsigned s1 = __hip_atomic_fetch_add(lcnt + e1, 1u, __ATOMIC_RELAXED, __HIP_MEMORY_SCOPE_WORKGROUP), s2 = __hip_atomic_fetch_add(lcnt + e2, 1u, __ATOMIC_RELAXED, __HIP_MEMORY_SCOPE_WORKGROUP);
                LAS unsigned* dd = dec + (tl * 16 + F.lane) * 6; dd[0] = (unsigned)e1; dd[1] = s1; dd[2] = (unsigned)e2; dd[3] = s2; dd[4] = __builtin_bit_cast(unsigned, w1); dd[5] = __builtin_bit_cast(unsigned, w2);
            }
        }
        __syncthreads();
        if (F.tid < NEXP) { const unsigned c = lcnt[F.tid]; lbase[F.tid] = c ? __hip_atomic_fetch_add((unsigned*)(F.ctl + CW_ECNT + 64 * F.tid), c, RLX_AGENT) : 0u; lcnt[F.tid] = 0u; }
        __syncthreads();
        if (F.tid < 64) { const LAS unsigned* dd = dec + F.tid * 6; const int token = tg * 64 + F.tid; const int e1 = (int)dd[0], e2 = (int)dd[2]; const int s1 = (int)(lbase[e1] + dd[1]), s2 = (int)(lbase[e2] + dd[3]);
            ltok[e1 * NTOK + s1] = token; ltok[e2 * NTOK + s2] = token;
            typedef int i32x4 __attribute__((ext_vector_type(4))); *(GAS i32x4*)(tinfo + 4 * token) = (i32x4){e1 * NTOK + s1, e2 * NTOK + s2, (int)dd[4], (int)dd[5]}; }
        __syncthreads();
    }
}
__device__ __forceinline__ void rows_to_bf16(Frame& F, const float* X, bf16* XB, float* RR) {
    const int gw = F.vcu * NWAVES + F.wave, NGW = F.G * NWAVES;
    for (int m = gw; m < NTOK; m += NGW) {
        const GAS f32x4* xr = (const GAS f32x4*)(X + (size_t)m * D) + F.lane; f32x4 v[4]; float s = 0.f;
#pragma unroll
        for (int j = 0; j < 4; ++j) { v[j] = xr[64 * j]; s += (v[j].x * v[j].x + v[j].y * v[j].y) + (v[j].z * v[j].z + v[j].w * v[j].w); }
        const float r = 1.0f / sqrtf(wave_sum(s) * (1.f / D) + EPS);
        if (F.lane == 0) RR[m] = r;
        GAS v2u* o8 = (GAS v2u*)(XB + (size_t)m * D) + F.lane;
#pragma unroll
        for (int j = 0; j < 4; ++j) { v2u o; o.x = pk2(v[j].x, v[j].y); o.y = pk2(v[j].z, v[j].w); o8[64 * j] = o; }
    }
}
__device__ __forceinline__ void moe_combine_rows(Frame& F, const bf16* __restrict__ XB, const bf16* __restrict__ Y, bf16* __restrict__ XO, unsigned char* __restrict__ XF, float* __restrict__ RR) {
    const int gw = F.vcu * NWAVES + F.wave, NGW = F.G * NWAVES; const LAS int* cs = (const LAS int*)(F.lds + TB_OFF) + 66; const int* tinfo = (const int*)(F.ws + WS_TINFO);
    for (int m = gw; m < NTOK; m += NGW) {
        typedef int i32x4 __attribute__((ext_vector_type(4))); const i32x4 ti = *(const GAS i32x4*)(tinfo + 4 * m);
        const int r1 = cs[ti.x >> 14] + (ti.x & (NTOK - 1)), r2 = cs[ti.y >> 14] + (ti.y & (NTOK - 1)); const int wz = ti.z, ww = ti.w; const float w1 = __builtin_bit_cast(float, wz), w2 = __builtin_bit_cast(float, ww);
        const GAS v4u* xr = (const GAS v4u*)(XB + (size_t)m * D) + F.lane; GAS v4u* xo = (GAS v4u*)(XO + (size_t)m * D) + F.lane; const GAS v4u* y1 = (const GAS v4u*)(Y + (size_t)r1 * D) + F.lane; const GAS v4u* y2 = (const GAS v4u*)(Y + (size_t)r2 * D) + F.lane;
        v4u o[2]; float s = 0.f;
#pragma unroll
        for (int j = 0; j < 2; ++j) { const v4u x = xr[64 * j], a = y1[64 * j], b = y2[64 * j]; float v[8];
            v[0] = bflo(x.x) + w1 * bflo(a.x) + w2 * bflo(b.x); v[1] = bfhi(x.x) + w1 * bfhi(a.x) + w2 * bfhi(b.x); v[2] = bflo(x.y) + w1 * bflo(a.y) + w2 * bflo(b.y); v[3] = bfhi(x.y) + w1 * bfhi(a.y) + w2 * bfhi(b.y);
            v[4] = bflo(x.z) + w1 * bflo(a.z) + w2 * bflo(b.z); v[5] = bfhi(x.z) + w1 * bfhi(a.z) + w2 * bfhi(b.z); v[6] = bflo(x.w) + w1 * bflo(a.w) + w2 * bflo(b.w); v[7] = bfhi(x.w) + w1 * bfhi(a.w) + w2 * bfhi(b.w);
            o[j].x = pk2(v[0], v[1]); o[j].y = pk2(v[2], v[3]); o[j].z = pk2(v[4], v[5]); o[j].w = pk2(v[6], v[7]);
            { v2u f; f.x = pk4f8(v[0], v[1], v[2], v[3]); f.y = pk4f8(v[4], v[5], v[6], v[7]); *((GAS v2u*)(XF + (size_t)m * D) + F.lane + 64 * j) = f; }
            const float q0 = bflo(o[j].x), q1 = bfhi(o[j].x), q2 = bflo(o[j].y), q3 = bfhi(o[j].y), q4 = bflo(o[j].z), q5 = bfhi(o[j].z), q6 = bflo(o[j].w), q7 = bfhi(o[j].w);
            s += (q0 * q0 + q1 * q1) + (q2 * q2 + q3 * q3) + (q4 * q4 + q5 * q5) + (q6 * q6 + q7 * q7); }
        const float r = 1.0f / sqrtf(wave_sum(s) * (1.f / D) + EPS);
        if (F.lane == 0) RR[m] = r;
#pragma unroll
        for (int j = 0; j < 2; ++j) xo[64 * j] = o[j];
    }
}
__device__ __forceinline__ void final_norm(Frame& F, const bf16* X, float* out, const float* gf) {
    const int gw = F.vcu * NWAVES + F.wave, NGW = F.G * NWAVES;
    f32x4 gv[2][2];
#pragma unroll
    for (int j = 0; j < 2; ++j) { gv[j][0] = *(const f32x4*)(gf + 8 * F.lane + 512 * j); gv[j][1] = *(const f32x4*)(gf + 8 * F.lane + 512 * j + 4); }
    for (int m = gw; m < NTOK; m += NGW) {
        const GAS v4u* xr = (const GAS v4u*)(X + (size_t)m * D) + F.lane; f32x4 v[2][2]; float s = 0.f;
#pragma unroll
        for (int j = 0; j < 2; ++j) { const v4u x = xr[64 * j]; v[j][0] = (f32x4){bflo(x.x), bfhi(x.x), bflo(x.y), bfhi(x.y)}; v[j][1] = (f32x4){bflo(x.z), bfhi(x.z), bflo(x.w), bfhi(x.w)};
            s += (v[j][0].x * v[j][0].x + v[j][0].y * v[j][0].y) + (v[j][0].z * v[j][0].z + v[j][0].w * v[j][0].w) + (v[j][1].x * v[j][1].x + v[j][1].y * v[j][1].y) + (v[j][1].z * v[j][1].z + v[j][1].w * v[j][1].w); }
        const float r = 1.0f / sqrtf(wave_sum(s) * (1.f / D) + EPS);
        GAS f32x4* o = (GAS f32x4*)(out + (size_t)m * D) + 2 * F.lane;
#pragma unroll
        for (int j = 0; j < 2; ++j) { o[128 * j] = v[j][0] * r * gv[j][0]; o[128 * j + 1] = v[j][1] * r * gv[j][1]; }
    }
}
__device__ __forceinline__ void moe_tables(Frame& F) {
    LAS int* tb = (LAS int*)(F.lds + TB_OFF); LAS int* cn = tb + 33; LAS int* cs = cn + 33;
    if (F.tid == 0) { int t = 0, r = 0; for (int e = 0; e < NEXP; ++e) { const int c = (int)__hip_atomic_load((unsigned*)(F.ctl + CW_ECNT + 64 * e), RLX_AGENT); cn[e] = c; tb[e] = t; cs[e] = r; t += (c + 255) >> 8; r += c; } tb[NEXP] = t; cs[NEXP] = r; }
    __syncthreads();
}

struct Args { const float* in[N_IN]; float* out; unsigned char* ws; int ph_lo, ph_hi; };
__global__ void __launch_bounds__(NWAVES * 64, 2) mk_fwd(Args args) {
    extern __shared__ __attribute__((aligned(16))) unsigned char lds[];
    Frame F;
    F.lds = (LAS unsigned char*)lds;
    F.MISC = (volatile LAS unsigned*)(F.lds + MISC_OFF);
    F.tid = threadIdx.x; F.lane = F.tid & 63; F.wave = __builtin_amdgcn_readfirstlane(F.tid >> 6);
    const int wave_s = F.wave;
    F.G = gridDim.x; { const int bx = blockIdx.x; F.vcu = (F.G % 8 == 0) ? (bx % 8) * (F.G / 8) + bx / 8 : bx; }
    F.in = args.in; F.out = args.out; F.ws = args.ws; F.ctl = (gu32*)(args.ws + WS_CTL);
    for (int u = F.tid; u < (LDS_BYTES - LDSCTL_OFF) / 4; u += NWAVES * 64) ((LAS unsigned*)(F.lds + LDSCTL_OFF))[u] = 0u;
    __syncthreads();
    if (N_LAUNCHES != PER_PHASE) (void)xcd_barrier_post((unsigned*)(F.ctl + CW_BAR), F.MISC + 8);
#define GRID_BAR() do { if (N_LAUNCHES == PER_PHASE) { if (F.tid == 0) __hip_atomic_store(F.ctl + CW_TMO, 0xBADBA0u, RLX_AGENT); } else { \
        XcdBarrier bb_; bb_.bar = (unsigned*)(F.ctl + CW_BAR); bb_.x = xb_xcc_id(); bb_.st = (volatile LAS unsigned*)(F.lds + MISC_OFF) + 8; bb_.wv = wave_s; xcd_barrier(bb_); } } while (0)
#define PHASE_BEGIN() do { int l_ = (int)__builtin_amdgcn_mbcnt_hi(~0u, __builtin_amdgcn_mbcnt_lo(~0u, 0u)); asm volatile("" : "+v"(l_)); F.lane = l_; F.wave = wave_s; F.tid = wave_s * 64 + l_; \
        unsigned long long w_ = (unsigned long long)args.ws; asm volatile("" : "+s"(w_)); ws = (unsigned char*)(GAS unsigned char*)w_; F.ws = ws; F.ctl = (gu32*)(ws + WS_CTL); } while (0)
    const int lo = args.ph_lo, hi = args.ph_hi;
#ifndef PHASE_MASK
#define PHASE_MASK 0x1FFF
#endif
#define IN(k) (lo <= (k) && (k) < hi && ((PHASE_MASK >> (k)) & 1))
#define BOTH(k) (IN(k) && IN((k) + 1))
#ifndef REP_MASK
#define REP_MASK 0
#endif
#define REPS(k) (((REP_MASK >> (k)) & 1) ? 2 : 1)
    unsigned char* ws = args.ws;
    const size_t TS1024 = (size_t)256 * 1024 * 2, TS512 = (size_t)256 * 512 * 2, TS256 = (size_t)256 * 256 * 2;

    if (IN(0)) for (int rep_ = 0; rep_ < REPS(0); ++rep_) { PHASE_BEGIN(); p0_prologue(F); if (BOTH(0)) GRID_BAR(); }
    if (IN(1)) for (int rep_ = 0; rep_ < REPS(1); ++rep_) {
        PHASE_BEGIN();
        {
            DenseRowsOrder S; S.init(NTOK, 2 * D, F.G, (int)blockIdx.x); S.A = (const char*)(ws + WS_E); S.Bt = (const char*)(ws + WS_WING); S.tstep = TS512;
            EpiGate E{(bf16*)F.out, F.in[I_BGATE]};
            pg8::gemm_phase<EpiGate, DenseRowsOrder, true, true, true>(F.lds + RING_OFF, F.tid, D / 2, S, E); }
        {
            DenseOrder S; S.init(NTOK, 1536, F.G, (int)blockIdx.x); S.A = (const char*)(ws + WS_B); S.Bt = (const char*)(ws + WS_WIN); S.tstep = TS1024;
            EpiP1 E{(bf16*)(ws + WS_C), (bf16*)(ws + WS_C + 16 * MiB)};
            pg8::gemm_phase<EpiP1, DenseOrder>(F.lds + RING_OFF, F.tid, D, S, E); }
        {
            const int nfull = (NTOK / 256) * (1536 / 256) / F.G, heavy = (NTOK / 256) * (1536 / 256) - nfull * F.G;
            const int nl = F.G - heavy; const bool spread = heavy > 0 && 2 * nl >= (NTOK / 256) * (D / 256);
            DenseOrder S2; S2.A = (const char*)(ws + WS_PB); S2.Bt = (const char*)(ws + WS_WPLE); S2.tstep = TS256;
            if (spread) S2.init(NTOK, D, nl, (int)blockIdx.x - heavy); else S2.init(NTOK, D, F.G, (int)blockIdx.x);
            EpiE E2{(bf16*)(ws + WS_E + 32 * MiB)};
            if (!spread || (int)blockIdx.x >= heavy) pg8::gemm_phase<EpiE, DenseOrder>(F.lds + RING_OFF, F.tid, DPLE, S2, E2);
        }
        if (BOTH(1)) GRID_BAR();
    }
    if (IN(2)) for (int rep_ = 0; rep_ < REPS(2); ++rep_) {
        PHASE_BEGIN();
#ifndef NO_SSM
        for (int u = F.vcu; u < 8 * NGRP; u += F.G) { const int x = u / 32, idx = u % 32; ssm_unit(F, idx & 7, 4 * x + (idx >> 3)); }
#endif
#ifndef NO_CONV
        PHASE_BEGIN();
        for (int t = blockIdx.x; t < NTOK / 64; t += F.G) conv_tile(F, t);
#endif
        if (BOTH(2)) GRID_BAR();
    }
    if (IN(3)) for (int rep_ = 0; rep_ < REPS(3); ++rep_) {
        PHASE_BEGIN();
        DenseOrder S; S.init(NTOK, 2 * D, F.G, (int)blockIdx.x); S.A = (const char*)(ws + WS_B); S.Bt = (const char*)(ws + WS_WGLU); S.tstep = TS512;
        EpiGlu E{(bf16*)(ws + WS_E), (const bf16*)F.out};
        pg8::gemm_phase<EpiGlu, DenseOrder>(F.lds + RING_OFF, F.tid, DSSM, S, E);
        if (BOTH(3)) GRID_BAR();
    }
    if (IN(4)) for (int rep_ = 0; rep_ < REPS(4); ++rep_) {
        PHASE_BEGIN();
        DenseOrder S; S.init(NTOK, D, F.G, (int)blockIdx.x); S.A = (const char*)(ws + WS_B + 16 * MiB); S.Bt = (const char*)(ws + WS_WCO); S.tstep = TS512;
        EpiCo E{(const bf16*)(ws + WS_E), (const bf16*)F.out, (bf16*)(ws + WS_C)};
        pg8::gemm_phase<EpiCo, DenseOrder>(F.lds + RING_OFF, F.tid, DCONV, S, E);
        if (BOTH(4)) GRID_BAR();
    }
    if (IN(5)) for (int rep_ = 0; rep_ < REPS(5); ++rep_) {
        PHASE_BEGIN();
        DenseOrder S; S.init(NTOK, D, F.G, (int)blockIdx.x); S.A = (const char*)(ws + WS_C); S.Bt = (const char*)(ws + WS_WO); S.tstep = TS1024;
        EpiRes E{F.in[I_X], (bf16*)(ws + WS_B), ws + WS_E};
        pg8::gemm_phase<EpiRes, DenseOrder>(F.lds + RING_OFF, F.tid, D, S, E);
        if (BOTH(5)) GRID_BAR();
    }
    if (IN(6)) for (int rep_ = 0; rep_ < REPS(6); ++rep_) { PHASE_BEGIN(); router_phase(F); if (BOTH(6)) GRID_BAR();
        if (rep_ + 1 < REPS(6)) { if (blockIdx.x == 0 && F.tid < NEXP) __hip_atomic_store((unsigned*)(F.ctl + CW_ECNT + 64 * F.tid), 0u, RLX_AGENT); GRID_BAR(); } }
    if (IN(7)) for (int rep_ = 0; rep_ < REPS(7); ++rep_) {
        PHASE_BEGIN();
        moe_tables(F);
        MoeOrder S; S.tb = (const LAS int*)(F.lds + TB_OFF); S.cn = S.tb + 33; S.G = F.G; S.c = F.vcu; S.K = D / 2; S.npn = 4;
        S.A = (const char*)(ws + WS_E); S.Bt = (const char*)(ws + WS_WGU); S.b_estride = (size_t)D * D; S.ltok = (const int*)(ws + WS_LTOK); S.gather = true;
        EpiAct E{ws + WS_C, (const int*)(ws + WS_LTOK), (const float*)(ws + WS_R2)};
        pg8::gemm_phase<EpiAct, MoeOrder, true, true, true>(F.lds + RING_OFF, F.tid, D / 2, S, E);
        if (BOTH(7)) GRID_BAR();
    }
    if (IN(8)) for (int rep_ = 0; rep_ < REPS(8); ++rep_) {
        PHASE_BEGIN();
        moe_tables(F);
        MoeOrder S; S.tb = (const LAS int*)(F.lds + TB_OFF); S.cn = S.tb + 33; S.G = F.G; S.c = F.vcu; S.K = DEXP / 2; S.npn = 4;
        S.A = (const char*)(ws + WS_C); S.Bt = (const char*)(ws + WS_WD); S.b_estride = (size_t)D * DEXP; S.ltok = nullptr; S.gather = true;
        EpiY E{(bf16*)F.out};
        pg8::gemm_phase<EpiY, MoeOrder, true, true, true>(F.lds + RING_OFF, F.tid, DEXP / 2, S, E);
        if (BOTH(8)) GRID_BAR();
    }
    if (IN(9)) for (int rep_ = 0; rep_ < REPS(9); ++rep_) { PHASE_BEGIN(); moe_tables(F); moe_combine_rows(F, (const bf16*)(ws + WS_B), (const bf16*)F.out, (bf16*)(ws + WS_E), ws + WS_X2F, (float*)(ws + WS_R3)); if (BOTH(9)) GRID_BAR(); }
#ifdef DBG_SG_COPY
    if (lo <= 10 && 10 < hi) { const int gt = F.vcu * 512 + (int)threadIdx.x, NGT = F.G * 512; const bf16* sgp = (const bf16*)args.out + (size_t)DBG_SG_COPY * NTOK * D; float* dst = (float*)(args.ws + WS_E);
        for (int q = gt; q < NTOK * D; q += NGT) { const float v = bflo((unsigned)sgp[q]); const int col = q & 2047;
#ifdef DBG_SG_SEL_LO
            dst[q] = (v >= 0.f && v <= 1.f) ? 0.f : ((col >= DBG_SG_SEL_LO && col < DBG_SG_SEL_HI) ? 1000.f : 0.f);
#else
            dst[q] = v;
#endif
        } }
#endif
    if (IN(11)) for (int rep_ = 0; rep_ < REPS(11); ++rep_) {
        PHASE_BEGIN();
        DenseRowsOrder S; S.init(NTOK, D, F.G, (int)blockIdx.x); S.A = (const char*)(ws + WS_X2F); S.Bt = (const char*)(ws + WS_WPG); S.tstep = TS512;
        EpiPle E{(const bf16*)(ws + WS_E), (const bf16*)(ws + WS_E + 32 * MiB), (const float*)(ws + WS_R3), (bf16*)(ws + WS_C)};
        pg8::gemm_phase<EpiPle, DenseRowsOrder, true, true, true>(F.lds + RING_OFF, F.tid, D / 2, S, E);
        if (BOTH(11)) GRID_BAR();
    }
#ifdef DBG_DUMP_OFF
    if (hi == PER_PHASE) {   PHASE_BEGIN();
        const int gt = F.vcu * 512 + F.tid, NGT = F.G * 512;
#if DBG_DUMP_BF16
        const bf16* src = (const bf16*)(ws + (size_t)DBG_DUMP_OFF);
        for (int q = gt; q < NTOK * D; q += NGT) F.out[q] = bflo((unsigned)src[q]);
#else
        const float* src = (const float*)(ws + (size_t)DBG_DUMP_OFF);
        for (int q = gt; q < NTOK * D; q += NGT) F.out[q] = src[q];
#endif
    }
#else
    if (IN(12)) for (int rep_ = 0; rep_ < REPS(12); ++rep_) { PHASE_BEGIN(); final_norm(F, (const bf16*)(ws + WS_C), F.out, F.in[I_GFIN]); }
#endif
#undef IN
#undef BOTH
}

extern "C" void kernel_launch(void* const* d_in, const int* in_sizes, int n_in, void* d_out, int out_size, void* d_ws, size_t ws_size, hipStream_t stream) {
    static int grid = 0;
    if (grid == 0) {
        if (n_in != N_IN || in_sizes[0] != NTOK * D || out_size != NTOK * D || ws_size < WS_END) { fprintf(stderr, "kernel_launch: unexpected shapes (n_in %d, in0 %d, out %d, ws %zu; need ws >= %zu); nothing launched\n", n_in, n_in > 0 ? in_sizes[0] : -1, out_size, ws_size, (size_t)WS_END); grid = -1; return; }
        int dev = 0, cus = 0, per_cu = 0;
        if (hipGetDevice(&dev) != hipSuccess || hipDeviceGetAttribute(&cus, hipDeviceAttributeMultiprocessorCount, dev) != hipSuccess) { grid = -1; return; }
        if (hipFuncSetAttribute((const void*)mk_fwd, hipFuncAttributeMaxDynamicSharedMemorySize, LDS_BYTES) != hipSuccess) { fprintf(stderr, "kernel_launch: hipFuncSetAttribute failed\n"); grid = -1; return; }
        if (hipOccupancyMaxActiveBlocksPerMultiprocessor(&per_cu, (const void*)mk_fwd, NWAVES * 64, LDS_BYTES) != hipSuccess || per_cu < 1) { fprintf(stderr, "kernel_launch: occupancy query reports %d workgroups per CU\n", per_cu); (void)hipGetLastError(); grid = -1; return; }
        grid = cus;
    }
    if (grid < 0) return;
    if (hipMemsetAsync((char*)d_ws + WS_CTL, 0, CTL_ZERO_BYTES, stream) != hipSuccess) return;
    Args a{};
    for (int i = 0; i < N_IN; ++i) a.in[i] = (const float*)d_in[i];
    a.out = (float*)d_out; a.ws = (unsigned char*)d_ws;
    for (int li = 0; li < N_LAUNCHES; ++li) {
        a.ph_lo = (N_LAUNCHES == PER_PHASE) ? li : 0; a.ph_hi = (N_LAUNCHES == PER_PHASE) ? li + 1 : PER_PHASE;
        hipLaunchKernelGGL(mk_fwd, dim3(grid), dim3(NWAVES * 64), LDS_BYTES, stream, a);
        if (hipPeekAtLastError() != hipSuccess) { fprintf(stderr, "kernel_launch: launch %d failed\n", li); break; }
    }
}
```

```cpp
#include <hip/hip_runtime.h>
#include <cstdio>
#include <cstdint>

namespace pg8 {
#define PG8_LAS __attribute__((address_space(3)))
typedef unsigned short bf16_t;
typedef short bf16x8 __attribute__((ext_vector_type(8)));
typedef float f32x4 __attribute__((ext_vector_type(4)));
typedef unsigned u32x4 __attribute__((ext_vector_type(4)));
typedef unsigned u32x2 __attribute__((ext_vector_type(2)));
constexpr int BM = 256, BK = 64, HALF = 128, HTB = HALF * BK * 2  , STAGE_BYTES = 8 * HTB, NXCD = 8, WGM = 8;

__host__ __device__ __forceinline__ int lds_byte(int r, int c) { const int st = (r >> 4) * 2 + (c >> 5), rr = r & 15, cc = c & 31, ob = rr * 64 + cc * 2; return st * 1024 + (ob ^ (((ob >> 9) & 1) << 5)); }
__host__ __device__ __forceinline__ void stage_rc(int b, int& R, int& C) { const int st = b / 1024, sb = b % 1024, swz = sb ^ (((sb >> 9) & 1) << 5); R = (st >> 1) * 16 + swz / 64; C = (st & 1) * 32 + (swz % 64) / 2; }
__host__ __device__ __forceinline__ int perm32(int rho) { const int n = rho >> 4, i = rho & 15; return 8 * (i >> 2) + 4 * n + (i & 3); }

struct Unit { int pm, pn, e, rows, mt, cb; };

typedef float cvt_f32x2 __attribute__((ext_vector_type(2)));
typedef __bf16 cvt_bf16x2 __attribute__((ext_vector_type(2)));
__device__ __forceinline__ unsigned cvt_pk_bf16(float lo, float hi) { const cvt_f32x2 v = {lo, hi}; const cvt_bf16x2 b = __builtin_convertvector(v, cvt_bf16x2); return __builtin_bit_cast(unsigned, b); }

struct StaticOrder {
    int nM, nN, nwg, G, c;
    __host__ __device__ void init(int M, int N, int G_, int c_) { nM = M / BM; nN = N / BM; nwg = nM * nN; G = G_; c = c_; }
    __host__ __device__ bool next(int i, Unit& u) const {
        const long L = (long)i * G + c; if (L >= nwg) return false;
        int wgid = (int)L; { const int q = nwg / NXCD, r = nwg % NXCD, xcd = wgid % NXCD, off = wgid / NXCD; wgid = (xcd < r ? xcd * (q + 1) : r * (q + 1) + (xcd - r) * q) + off; }
        const int nig = WGM * nN, gid = wgid / nig, fm = gid * WGM, gsz = (nM - fm) < WGM ? (nM - fm) : WGM;
        u.pm = fm + ((wgid % nig) % gsz); u.pn = (wgid % nig) / gsz; u.e = 0; u.rows = BM; u.mt = 0; u.cb = 0; return true;
    }
};

template <class Epi, class Sched, bool GATHER = false, bool ALIGN_EPI = true, bool F8 = false>
__device__ __forceinline__ void gemm_phase(PG8_LAS unsigned char* lds, const int tid, const int K_, const Sched& S, const Epi& E) {
    int K = K_; asm volatile("" : "+s"(K));
    const int wid = __builtin_amdgcn_readfirstlane(tid >> 6), lane = tid & 63, wr = wid >> 2, wc = wid & 3, fr = lane & 15, fq = lane >> 4;
    const int nt = K / BK;
    unsigned voffA[2], voffB[2]; int rowA[2], colA[2];
#pragma unroll
    for (int i = 0; i < 2; ++i) { int R, C; stage_rc(tid * 16 + i * 8192, R, C); const int Rb = (R & ~31) + perm32(R & 31);
        voffA[i] = (unsigned)(R * K + C) * 2u; voffB[i] = (unsigned)(Rb * K + C) * 2u; rowA[i] = R; colA[i] = C * 2; }
    const size_t kstep = (size_t)(BK * 2);
    const unsigned hstep = (unsigned)HALF * (unsigned)K * 2u;
    const unsigned ldsw = (unsigned)wid * 1024u;
    const int aoff = lds_byte(wr * 64 + fr, fq * 8), boff = lds_byte(wc * 32 + fr, fq * 8);
#define PG8_SA(b, h) (((b) * 2 + (h)) * HTB)
#define PG8_SB(b, h) ((4 + (b) * 2 + (h)) * HTB)
#define PG8_STAGE(bufoff, gbase, voff) do { _Pragma("unroll") for (int _i = 0; _i < 2; ++_i) \
        __builtin_amdgcn_global_load_lds((const unsigned*)((const char*)(gbase) + (voff)[_i]), (PG8_LAS unsigned*)(lds + (bufoff) + ldsw + _i * 8192), 16, 0, 0); } while (0)
#define PG8_STAGE_A(bufoff, gbase, V, h) do { _Pragma("unroll") for (int _i = 0; _i < 2; ++_i) { const unsigned _o = GATHER ? (V)[h][_i] : (voffA[_i] + (unsigned)(h) * hstep); \
        __builtin_amdgcn_global_load_lds((const unsigned*)((const char*)(gbase) + _o), (PG8_LAS unsigned*)(lds + (bufoff) + ldsw + _i * 8192), 16, 0, 0); } } while (0)
#define PG8_LDA(dst, b, h) do { _Pragma("unroll") for (int m = 0; m < 4; ++m) _Pragma("unroll") for (int k = 0; k < 2; ++k) dst[m][k] = *(const PG8_LAS bf16x8*)(lds + PG8_SA(b, h) + aoff + m * 2048 + k * 1024); } while (0)
#define PG8_LDB(dst, b, h) do { _Pragma("unroll") for (int n = 0; n < 2; ++n) _Pragma("unroll") for (int k = 0; k < 2; ++k) dst[n][k] = *(const PG8_LAS bf16x8*)(lds + PG8_SB(b, h) + boff + n * 2048 + k * 1024); } while (0)
#define PG8_MMA(ai, bj, At, Bt) do { __builtin_amdgcn_s_setprio(1); _Pragma("unroll") for (int m = 0; m < 4; ++m) _Pragma("unroll") for (int n = 0; n < 2; ++n) { \
        if constexpr (F8) { typedef int v4i_ __attribute__((ext_vector_type(4))); typedef int v8i_ __attribute__((ext_vector_type(8))); \
            const v8i_ fa_ = __builtin_shufflevector(__builtin_bit_cast(v4i_, Bt[n][0]), __builtin_bit_cast(v4i_, Bt[n][1]), 0, 1, 2, 3, 4, 5, 6, 7), fb_ = __builtin_shufflevector(__builtin_bit_cast(v4i_, At[m][0]), __builtin_bit_cast(v4i_, At[m][1]), 0, 1, 2, 3, 4, 5, 6, 7); \
            acc[ai][bj][m][n] = __builtin_amdgcn_mfma_scale_f32_16x16x128_f8f6f4(fa_, fb_, acc[ai][bj][m][n], 0, 0, 0, 0x7f7f7f7f, 0, 0x7f7f7f7f); } \
        else { _Pragma("unroll") for (int k = 0; k < 2; ++k) acc[ai][bj][m][n] = __builtin_amdgcn_mfma_f32_16x16x32_bf16(Bt[n][k], At[m][k], acc[ai][bj][m][n], 0, 0, 0); } } __builtin_amdgcn_s_setprio(0); } while (0)
#define PG8_WAIT_V(n) asm volatile("s_waitcnt vmcnt(" #n ")" ::: "memory")
#define PG8_WAIT_L(n) asm volatile("s_waitcnt lgkmcnt(" #n ")" ::: "memory")
#define PG8_BAR __builtin_amdgcn_s_barrier()
#define PG8_SCHED __builtin_amdgcn_sched_barrier(0)
    Unit cur, nxt; int ui = 0;
    if (!S.next(0, cur)) return;
    f32x4 acc[2][2][4][2];
#pragma unroll
    for (int a = 0; a < 2; ++a)
#pragma unroll
        for (int b = 0; b < 2; ++b)
#pragma unroll
            for (int m = 0; m < 4; ++m)
#pragma unroll
                for (int n = 0; n < 2; ++n) acc[a][b][m][n] = (f32x4){0.f, 0.f, 0.f, 0.f};
    bf16x8 At[4][2], B0[2][2], B1[2][2];
    unsigned cva[2][2] = {{0u, 0u}, {0u, 0u}}, nva[2][2] = {{0u, 0u}, {0u, 0u}};
    const char* cA = S.a_base(cur); const char* cB = S.b_base(cur);
    if constexpr (GATHER) {
#pragma unroll
        for (int h = 0; h < 2; ++h)
#pragma unroll
            for (int i = 0; i < 2; ++i) cva[h][i] = S.row_off(cur, h * HALF + rowA[i]) + (unsigned)colA[i];
    }
    PG8_STAGE(PG8_SB(0, 0), cB, voffB); PG8_STAGE(PG8_SB(0, 1), cB + hstep, voffB); PG8_STAGE_A(PG8_SA(0, 0), cA, cva, 0); PG8_STAGE_A(PG8_SA(0, 1), cA, cva, 1);
    if (wr == 1) PG8_BAR;
    PG8_WAIT_V(2); PG8_BAR;
    PG8_STAGE(PG8_SB(1, 0), cB + kstep, voffB); PG8_STAGE_A(PG8_SA(1, 0), cA + kstep, cva, 0); PG8_STAGE(PG8_SB(1, 1), cB + hstep + kstep, voffB);
    PG8_WAIT_V(6); PG8_BAR;
    for (;;) {
        const bool has_next = S.next(ui + 1, nxt);
        const char* nA = has_next ? S.a_base(nxt) : cA; const char* nB = has_next ? S.b_base(nxt) : cB;
        if constexpr (GATHER) {
#pragma unroll
            for (int h = 0; h < 2; ++h)
#pragma unroll
                for (int i = 0; i < 2; ++i) nva[h][i] = has_next ? (S.row_off(nxt, h * HALF + rowA[i]) + (unsigned)colA[i]) : cva[h][i];
        }
#pragma unroll 1
        for (int t = 0; t < nt; t += 2) {
            const bool last = (t == nt - 2);
            asm volatile("" : "+v"(voffA[0]), "+v"(voffA[1]), "+v"(voffB[0]), "+v"(voffB[1]));
            const char* a1 = cA + (size_t)(t + 1) * kstep;
            const char* a2 = last ? nA : cA + (size_t)(t + 2) * kstep; const char* b2 = last ? nB : cB + (size_t)(t + 2) * kstep;
            const char* a3 = a2 + kstep; const char* b3 = b2 + kstep;
            PG8_LDB(B0, 0, 0); PG8_LDB(B1, 0, 1); PG8_SCHED; PG8_LDA(At, 0, 0); PG8_STAGE_A(PG8_SA(1, 1), a1, cva, 1);
            if constexpr (GATHER) { if (last) {
#pragma unroll
                for (int h = 0; h < 2; ++h)
#pragma unroll
                    for (int i = 0; i < 2; ++i) cva[h][i] = nva[h][i]; } }
            PG8_WAIT_V(8); PG8_WAIT_L(0); PG8_BAR; PG8_MMA(0, 0, At, B0); PG8_MMA(0, 1, At, B1); PG8_BAR; PG8_SCHED;
            PG8_LDA(At, 0, 1); PG8_STAGE(PG8_SB(0, 0), b2, voffB); PG8_STAGE(PG8_SB(0, 1), b2 + hstep, voffB); PG8_STAGE_A(PG8_SA(0, 0), a2, cva, 0);
            PG8_WAIT_V(8); PG8_WAIT_L(0); PG8_BAR; PG8_MMA(1, 0, At, B0); PG8_MMA(1, 1, At, B1); PG8_BAR; PG8_SCHED;
            PG8_LDB(B0, 1, 0); PG8_LDB(B1, 1, 1); PG8_SCHED; PG8_LDA(At, 1, 0); PG8_STAGE_A(PG8_SA(0, 1), a2, cva, 1);
            PG8_WAIT_V(8); PG8_WAIT_L(0); PG8_BAR; PG8_MMA(0, 0, At, B0); PG8_MMA(0, 1, At, B1); PG8_BAR; PG8_SCHED;
            PG8_LDA(At, 1, 1); PG8_STAGE(PG8_SB(1, 0), b3, voffB); PG8_STAGE(PG8_SB(1, 1), b3 + hstep, voffB); PG8_STAGE_A(PG8_SA(1, 0), a3, cva, 0);
            PG8_WAIT_V(8); PG8_WAIT_L(0); PG8_BAR; PG8_MMA(1, 0, At, B0); PG8_MMA(1, 1, At, B1); PG8_BAR; PG8_SCHED;
        }
        if constexpr (ALIGN_EPI) { if (wr == 0) PG8_BAR; }
#ifdef DBG_EPI_NOP
        asm volatile("s_nop 15\n s_nop 15\n s_nop 15\n s_nop 15" ::: "memory");
#endif
        { int le_ = lane; asm volatile("" : "+v"(le_));
          E(acc, cur, wr, wc, le_ & 15, le_ >> 4); }
        if (!has_next) break;
#pragma unroll
        for (int a = 0; a < 2; ++a)
#pragma unroll
            for (int b = 0; b < 2; ++b)
#pragma unroll
                for (int m = 0; m < 4; ++m)
#pragma unroll
                    for (int n = 0; n < 2; ++n) acc[a][b][m][n] = (f32x4){0.f, 0.f, 0.f, 0.f};
        cur = nxt; cA = nA; cB = nB; ++ui;
        if constexpr (ALIGN_EPI) { if (wr == 1) PG8_BAR; }
    }
    PG8_WAIT_V(0);
    if constexpr (!ALIGN_EPI) { if (wr == 0) PG8_BAR; }
    PG8_BAR;
#undef PG8_SA
#undef PG8_SB
#undef PG8_STAGE
#undef PG8_STAGE_A
#undef PG8_LDA
#undef PG8_LDB
#undef PG8_MMA
#undef PG8_WAIT_V
#undef PG8_WAIT_L
#undef PG8_BAR
#undef PG8_SCHED
}
}

constexpr int NWAVES = 8;
#ifndef MK_N_LAUNCHES
#define MK_N_LAUNCHES 1
#endif
constexpr int PER_PHASE = 13;
constexpr int N_LAUNCHES = MK_N_LAUNCHES;

constexpr int NTOK = 16384, SEQ = 2048, D = 1024, DIN = 3584, DSSM = 512, DCONV = 512, NGRP = 32, NST = 64, GWID = 16, CONVW = 31;
constexpr int NEXP = 32, EPG = 8, DEXP = 512, DPLE = 256, LC = 32, NCH = 64;
constexpr float EPS = 1e-6f;
enum In { I_X = 0, I_P, I_GMIX, I_WIN, I_BGATE, I_ARE, I_AIM, I_LOGDT, I_BRE, I_BIM, I_CRE, I_CIM, I_SD, I_WGLU, I_CDW, I_CDWB, I_CLNG, I_CLNB, I_WCO, I_WOUT, I_GMOE, I_WRG, I_BRG, I_WRE, I_BRE2,
          I_WEG, I_WEU, I_WED, I_GPLE, I_WPG, I_WPLE, I_GFIN, N_IN };

constexpr size_t MiB = 1u << 20;
constexpr size_t WS_CTL = 0, CTL_ZERO_BYTES = 1 * MiB;
constexpr size_t WS_LTOK = 1 * MiB;
constexpr size_t WS_TINFO = 3 * MiB;
constexpr size_t WS_R2 = 5 * MiB, WS_R3 = WS_R2 + 65536, WS_LAM32 = WS_R3 + 65536, WS_WRT = WS_R2 + 262144;
constexpr size_t WS_WST = 6 * MiB;
constexpr size_t WS_BT2 = 10 * MiB;
constexpr size_t WS_WING = 35 * MiB;
constexpr size_t WS_WIN = 31 * MiB, WS_WGLU = 38 * MiB, WS_WCO = 40 * MiB, WS_WO = 41 * MiB, WS_WPG = 43 * MiB, WS_WPLE = 45 * MiB;
constexpr size_t WS_PB = 46 * MiB;
constexpr size_t WS_WGU = 54 * MiB;
constexpr size_t WS_X2F = 86 * MiB;
constexpr size_t WS_WD = 118 * MiB;
constexpr float W8S = 64.0f, W8I = 1.0f / 64.0f;
constexpr size_t WS_B = 150 * MiB;
constexpr size_t WS_C = 182 * MiB;
constexpr size_t WS_E = 224 * MiB;
constexpr size_t WS_END = 288 * MiB;
constexpr int CW_TMO = 0, CW_CODE = 1, CW_BAR = 4096, CW_ECNT = 16384;
static_assert((CW_ECNT + 64 * NEXP) * 4 <= (int)CTL_ZERO_BYTES, "CTL words inside the memset region");

constexpr int RING_OFF = 0, RING_BYTES = 131072;
constexpr int LDSCTL_OFF = RING_BYTES, MISC_OFF = LDSCTL_OFF + 320;
constexpr int TB_OFF = LDSCTL_OFF + 1024;
constexpr int LDS_BYTES = 147456;
static_assert(TB_OFF + 100 * 4 <= LDS_BYTES, "LDS map");

#define GAS __attribute__((address_space(1)))
#define LAS __attribute__((address_space(3)))
typedef unsigned short bf16;
typedef unsigned v4u __attribute__((ext_vector_type(4)));
typedef unsigned v2u __attribute__((ext_vector_type(2)));
typedef float f32x4 __attribute__((ext_vector_type(4)));
typedef short bf16x8 __attribute__((ext_vector_type(8)));
typedef GAS unsigned gu32;
#define RLX_AGENT __ATOMIC_RELAXED, __HIP_MEMORY_SCOPE_AGENT
#define LDS_WAIT() asm volatile("s_waitcnt lgkmcnt(0)" ::: "memory")
#define VM_WAIT() asm volatile("s_waitcnt vmcnt(0)" ::: "memory")
__device__ __forceinline__ unsigned f2bf(float f) { unsigned u = __builtin_bit_cast(unsigned, f); return (u + 0x7fffu + ((u >> 16) & 1u)) >> 16; }
__device__ __forceinline__ unsigned pk2(float lo, float hi) { return pg8::cvt_pk_bf16(lo, hi); }
__device__ __forceinline__ unsigned pk4f8(float a, float b, float c, float d) { int w = __builtin_amdgcn_cvt_pk_fp8_f32(a, b, 0, false); w = __builtin_amdgcn_cvt_pk_fp8_f32(c, d, w, true); return (unsigned)w; }
__device__ __forceinline__ float bflo(unsigned v) { return __builtin_bit_cast(float, v << 16); }
__device__ __forceinline__ float bfhi(unsigned v) { return __builtin_bit_cast(float, v & 0xffff0000u); }
__device__ __forceinline__ float sigm(float x) { return __builtin_amdgcn_rcpf(1.0f + __expf(-x)); }
__device__ __forceinline__ float gelu_tanh(float y) { const float t = 1.5957691216f * (y + 0.044715f * y * y * y); return y * sigm(t); }

#define XB_TMO      128
#define XB_XCNT(j)  (256  + 64 * (j))
#define XB_XSUB(j)  (1280 + 64 * (j))
#define XB_XGEN(j)  (2304 + 64 * (j))
#define XB_TOP      3328
#define XB_TOPGEN   3392
#define XCD_BAR_WORDS 3456
#define XB_SPIN_CAP (1u << 18)

__device__ __forceinline__ unsigned xb_ld(unsigned* p)              { return __hip_atomic_load(p, __ATOMIC_RELAXED, __HIP_MEMORY_SCOPE_AGENT); }
__device__ __forceinline__ unsigned xb_add(unsigned* p, unsigned v) { return __hip_atomic_fetch_add(p, v, __ATOMIC_RELAXED, __HIP_MEMORY_SCOPE_AGENT); }
__device__ __forceinline__ unsigned xb_xcc_id() { return (unsigned)__builtin_amdgcn_s_getreg((3 << 11) | 20) & 0xFu; }
#define XB_SPIN(cond, bar) do { unsigned _sp = 0; while (cond) { __builtin_amdgcn_s_sleep(1); \
    if ((++_sp & 255u) == 0u) { if (xb_ld(&(bar)[XB_TMO])) break; if (_sp > XB_SPIN_CAP) { atomicAdd(&(bar)[XB_TMO], 1u); break; } } } } while (0)

struct XcdBarrier {
    unsigned* bar; unsigned x;
    volatile LAS unsigned* st;
    int wv;
};

__device__ __forceinline__ XcdBarrier xcd_barrier_post(unsigned* bar, volatile LAS unsigned* st) {
    XcdBarrier b; b.bar = bar; b.x = xb_xcc_id(); b.st = st; b.wv = 0;
    if (threadIdx.x == 0) (void)xb_add(&bar[XB_XCNT(b.x)], 1u);
    return b;
}
__device__ __forceinline__ void xcd_barrier_complete(unsigned* bar, unsigned x, unsigned& nloc, unsigned& nx) {
    const unsigned G = gridDim.x * gridDim.y * gridDim.z;
    unsigned sum, cnt, mine, sp = 0u;
    for (;;) {
        sum = 0u; cnt = 0u; mine = 0u;
#pragma unroll
        for (unsigned j = 0; j < 16; ++j) { const unsigned c = xb_ld(&bar[XB_XCNT(j)]); sum += c; cnt += (c > 0u) ? 1u : 0u; mine = (j == x) ? c : mine; }
        if (sum == G) break;
        __builtin_amdgcn_s_sleep(1);
        if ((++sp & 255u) == 0u) { if (xb_ld(&bar[XB_TMO])) break; if (sp > XB_SPIN_CAP) { atomicAdd(&bar[XB_TMO], 1u); break; } }
    }
    nloc = mine > 0u ? mine : 1u; nx = cnt > 0u ? cnt : 1u;
}

__device__ __forceinline__ void xcd_barrier(const XcdBarrier& b) {
    asm volatile("s_waitcnt vmcnt(0)" ::: "memory");
    __syncthreads();
    if (b.wv == 0 && __builtin_amdgcn_mbcnt_hi(~0u, __builtin_amdgcn_mbcnt_lo(~0u, 0u)) == 0u) {
        unsigned* bar = b.bar;
        __builtin_amdgcn_s_waitcnt(0);
        unsigned nloc = b.st[0], nx = b.st[1];
        if (nloc == 0u) { xcd_barrier_complete(bar, b.x, nloc, nx); b.st[0] = nloc; b.st[1] = nx; }
        const unsigned old = xb_add(&bar[XB_XSUB(b.x)], 1u);
        const unsigned gen = old / nloc;
        if (old + 1u == (gen + 1u) * nloc) {
            __builtin_amdgcn_fence(__ATOMIC_RELEASE, "agent");
            asm volatile("s_waitcnt vmcnt(0)" ::: "memory");
            const unsigned og = xb_add(&bar[XB_TOP], 1u);
            const unsigned tg = og / nx;
            if (og + 1u == (tg + 1u) * nx) xb_add(&bar[XB_TOPGEN], 1u);
            else XB_SPIN(xb_ld(&bar[XB_TOPGEN]) == tg, bar);
            __builtin_amdgcn_fence(__ATOMIC_ACQUIRE, "agent");
            xb_add(&bar[XB_XGEN(b.x)], 1u);
            asm volatile("s_waitcnt vmcnt(0)" ::: "memory");
        } else {
            XB_SPIN(xb_ld(&bar[XB_XGEN(b.x)]) == gen, bar);
            __builtin_amdgcn_fence(__ATOMIC_ACQUIRE, "agent");
            asm volatile("s_waitcnt vmcnt(0)" ::: "memory");
        }
    }
    __syncthreads();
}

struct Frame {
    LAS unsigned char* lds;
    volatile LAS unsigned* MISC;
    gu32* ctl;
    int tid, lane, wave;
    int vcu, G;
    const float* const* in;
    float* out; unsigned char* ws;
};
__device__ __forceinline__ float wave_sum(float v) {
#pragma unroll
    for (int o = 1; o < 64; o <<= 1) v += __shfl_xor(v, o);
    return v;
}

__device__ __forceinline__ int map_glu(int base, int o, int gate) { return base + 8 * (o >> 2) + 4 * gate + (o & 3); }
__device__ __forceinline__ int dest_row(int mode, int n, int half) {
    if (mode == 0) return n;
    if (mode == 1) { if (n < 512) return n; if (n < 1024) return map_glu(512, n - 512, 0); if (n < 1536) return map_glu(512, n - 1024, 1); return n; }
    if (mode == 2) return n < half ? map_glu(0, n, 0) : map_glu(0, n - half, 1);
    if (mode == 3) return map_glu(0, n, 0);
    if (mode == 5) return n - 1536;
    return map_glu(0, n, 1);
}
__device__ __forceinline__ void tr_item(const float* W, int K, int N, bf16* WT, int mode, int half, const float* ks, LAS unsigned* T, int item, int lane) {
    const int nblk = N / 64, kb = item / nblk, nb = item % nblk, k0 = 64 * kb, n0 = 64 * nb, nq = lane & 15, kq = lane >> 4;
    f32x4 v[8][2];
    const float* src = W + (size_t)(k0 + 2 * kq) * N + n0 + 4 * nq;
#pragma unroll
    for (int s = 0; s < 8; ++s) { v[s][0] = *(const GAS f32x4*)(src + (size_t)(8 * s) * N); v[s][1] = *(const GAS f32x4*)(src + (size_t)(8 * s + 1) * N); }
    if (ks) {
#pragma unroll
        for (int s = 0; s < 8; ++s) { const float a = ks[k0 + 8 * s + 2 * kq], b = ks[k0 + 8 * s + 2 * kq + 1]; v[s][0] *= a; v[s][1] *= b; } }
#pragma unroll
    for (int s = 0; s < 8; ++s)
#pragma unroll
        for (int jj = 0; jj < 4; ++jj) T[(4 * nq + jj) * 33 + 4 * s + kq] = pk2(v[s][0][jj], v[s][1][jj]);
    LDS_WAIT(); asm volatile("" ::: "memory");
    const int c = lane & 7;
#pragma unroll
    for (int i = 0; i < 8; ++i) { const int n = (lane >> 3) + 8 * i; const LAS unsigned* t = T + n * 33 + 4 * c;
        v4u o; o.x = t[0]; o.y = t[1]; o.z = t[2]; o.w = t[3];
        *(GAS v4u*)(WT + (size_t)dest_row(mode, n0 + n, half) * K + k0 + 8 * c) = o; }
    LDS_WAIT(); asm volatile("" ::: "memory");
}
__device__ __forceinline__ void tr_item8(const float* W, int K, int N, unsigned char* WT, int mode, int half, const float* ks, float sc, LAS unsigned* T, int item, int lane) {
    const int nblk = N / 64, kb = item / nblk, nb = item % nblk, k0 = 64 * kb, n0 = 64 * nb, nq = lane & 15, kq = lane >> 4;
    f32x4 v[4][4];
    const float* src = W + (size_t)(k0 + 4 * kq) * N + n0 + 4 * nq;
#pragma unroll
    for (int s = 0; s < 4; ++s)
#pragma unroll
        for (int r = 0; r < 4; ++r) v[s][r] = *(const GAS f32x4*)(src + (size_t)(16 * s + r) * N);
#pragma unroll
    for (int s = 0; s < 4; ++s)
#pragma unroll
        for (int r = 0; r < 4; ++r) v[s][r] *= ks ? ks[k0 + 16 * s + 4 * kq + r] * sc : sc;
#pragma unroll
    for (int s = 0; s < 4; ++s)
#pragma unroll
        for (int jj = 0; jj < 4; ++jj) T[(4 * nq + jj) * 17 + 4 * s + kq] = pk4f8(v[s][0][jj], v[s][1][jj], v[s][2][jj], v[s][3][jj]);
    LDS_WAIT(); asm volatile("" ::: "memory");
    const int c = lane & 3;
#pragma unroll
    for (int i = 0; i < 4; ++i) { const int n = (lane >> 2) + 16 * i; const LAS unsigned* t = T + n * 17 + 4 * c;
        v4u o; o.x = t[0]; o.y = t[1]; o.z = t[2]; o.w = t[3];
        *(GAS v4u*)(WT + (size_t)dest_row(mode, n0 + n, half) * K + k0 + 16 * c) = o; }
    LDS_WAIT(); asm volatile("" ::: "memory");
}
__device__ __forceinline__ void ssm_tables(Frame& F, int g) {
    LAS float* LP = (LAS float*)F.lds;
    LAS float* BB = LP + 33 * 64 * 2;
    LAS float* CC = BB + 2048;
    LAS float* KT = CC + 2048;
    const float* a_re = F.in[I_ARE]; const float* a_im = F.in[I_AIM]; const float* b_re = F.in[I_BRE]; const float* b_im = F.in[I_BIM];
    const float* c_re = F.in[I_CRE]; const float* c_im = F.in[I_CIM]; const float* sd = F.in[I_SD];
    {   const int n = F.tid & 63, tq = F.tid >> 6; const float dt = expf(F.in[I_LOGDT][g]); const float ar = a_re[g * 64 + n], ai = a_im[g * 64 + n]; const float bm = ar * dt, ba = ai * dt;
        for (int tau = tq; tau <= 32; tau += 8) { const float mag = expf(bm * (float)tau); float sn, cs; sincosf(ba * (float)tau, &sn, &cs); LP[(tau * 64 + n) * 2] = mag * cs; LP[(tau * 64 + n) * 2 + 1] = mag * sn; }
        const float mag = expf(bm); float sn, cs; sincosf(ba, &sn, &cs); const float lr = mag * cs, li = mag * sn;
        const float den = ar * ar + ai * ai, nr = lr - 1.0f, ni = li; const float zr = (nr * ar + ni * ai) / den, zi = (ni * ar - nr * ai) / den;
#pragma unroll
        for (int k = 0; k < 2; ++k) { const int ch = 2 * tq + k; const float br = b_re[(g * 64 + n) * 16 + ch], bi = b_im[(g * 64 + n) * 16 + ch];
            BB[(n * 16 + ch) * 2] = zr * br - zi * bi; BB[(n * 16 + ch) * 2 + 1] = zr * bi + zi * br; } }
    for (int e = F.tid; e < 1024; e += 512) { CC[e * 2] = c_re[g * 1024 + e]; CC[e * 2 + 1] = c_im[g * 1024 + e]; }
    __syncthreads();
    if (F.tid < 64) { float* l32 = (float*)(F.ws + WS_LAM32); l32[(g * 64 + F.tid) * 2] = LP[(32 * 64 + F.tid) * 2]; l32[(g * 64 + F.tid) * 2 + 1] = LP[(32 * 64 + F.tid) * 2 + 1]; }
    {
        const int p = F.tid & 255, cp = p >> 4, ch = p & 15, t0 = (F.tid >> 8) * 16; float kacc[16];
#pragma unroll
        for (int t = 0; t < 16; ++t) kacc[t] = 0.f;
        for (int n = 0; n < 64; ++n) {
            const float cr = CC[(cp * 64 + n) * 2], ci = CC[(cp * 64 + n) * 2 + 1], br = BB[(n * 16 + ch) * 2], bi = BB[(n * 16 + ch) * 2 + 1];
            const float pr = cr * br - ci * bi, pi = cr * bi + ci * br, l0r = LP[(t0 * 64 + n) * 2], l0i = LP[(t0 * 64 + n) * 2 + 1], lr = LP[(64 + n) * 2], li = LP[(64 + n) * 2 + 1];
            float wr_ = pr * l0r - pi * l0i, wi_ = pr * l0i + pi * l0r;
#pragma unroll
            for (int t = 0; t < 16; ++t) { kacc[t] += wr_; const float nr = wr_ * lr - wi_ * li, ni = wr_ * li + wi_ * lr; wr_ = nr; wi_ = ni; }
        }
#pragma unroll
        for (int t = 0; t < 16; ++t) KT[((t0 + t) << 8) + p] = kacc[t];
    }
    __syncthreads();
    bf16* Bt2 = (bf16*)(F.ws + WS_BT2) + (size_t)g * 512 * 640;
    for (int q = F.tid; q < 512 * 80; q += 512) {
        const int R = q / 80, cc = q % 80, t = R >> 4, cp = R & 15; float v[8];
        if (cc < 64) { const int j = cc >> 1, chb = (cc & 1) * 8;
#pragma unroll
            for (int i = 0; i < 8; ++i) { const int ch = chb + i; float x = (t >= j) ? KT[((t - j) << 8) + cp * 16 + ch] : 0.f; if (t == j && ch == cp) x += sd[g * 16 + ch]; v[i] = x; }
        } else { const int nb = (cc - 64) * 4;
#pragma unroll
            for (int i = 0; i < 4; ++i) { const int n = nb + i; const float cr = CC[(cp * 64 + n) * 2], ci = CC[(cp * 64 + n) * 2 + 1], lr = LP[((t + 1) * 64 + n) * 2], li = LP[((t + 1) * 64 + n) * 2 + 1];
                v[2 * i] = cr * lr - ci * li; v[2 * i + 1] = -(cr * li + ci * lr); }
        }
        v4u o; o.x = pk2(v[0], v[1]); o.y = pk2(v[2], v[3]); o.z = pk2(v[4], v[5]); o.w = pk2(v[6], v[7]);
        *(GAS v4u*)(Bt2 + (size_t)R * 640 + cc * 8) = o;
    }
    bf16* WsT = (bf16*)(F.ws + WS_WST) + (size_t)g * 128 * 512;
    for (int q = F.tid; q < 128 * 64; q += 512) {
        const int R = q >> 6, cc = q & 63, n = R >> 1, ri = R & 1, j = cc >> 1, chb = (cc & 1) * 8; float v[8];
        const float lr = LP[((31 - j) * 64 + n) * 2], li = LP[((31 - j) * 64 + n) * 2 + 1];
#pragma unroll
        for (int i = 0; i < 8; ++i) { const float br = BB[(n * 16 + chb + i) * 2], bi = BB[(n * 16 + chb + i) * 2 + 1]; v[i] = ri == 0 ? (lr * br - li * bi) : (lr * bi + li * br); }
        v4u o; o.x = pk2(v[0], v[1]); o.y = pk2(v[2], v[3]); o.z = pk2(v[4], v[5]); o.w = pk2(v[6], v[7]);
        *(GAS v4u*)(WsT + (size_t)R * 512 + cc * 8) = o;
    }
    __syncthreads();
}
__device__ __forceinline__ void p0_prologue(Frame& F) {
    const bool split = F.G > NGRP; const bool tabler = split && (int)blockIdx.x < NGRP;
#ifndef P0_REP_TAB
#define P0_REP_TAB 1
#define P0_REP_TR 1
#define P0_REP_ROWS 1
#endif
    for (int rp_ = 0; rp_ < P0_REP_TAB; ++rp_)
    if (!split || tabler) for (int g = blockIdx.x; g < NGRP; g += F.G) ssm_tables(F, g);
    LAS unsigned* scr = (LAS unsigned*)(F.lds + RING_OFF + F.wave * 16384);
    const int gw = F.vcu * NWAVES + F.wave, NGW = F.G * NWAVES;
    constexpr int I_IN = 16 * 56, I_GLU = 8 * 32, I_CO = 8 * 16, I_O = 16 * 16, I_PG = 16 * 16, I_PLE = 4 * 16, I_EG = 16 * 8, I_ED = 8 * 16;
    constexpr int NITEMS = I_IN + I_GLU + I_CO + I_O + I_PG + I_PLE + NEXP * (2 * I_EG + I_ED);
    const int tw = split ? ((int)blockIdx.x - NGRP) * NWAVES + F.wave : gw, NTW = split ? (F.G - NGRP) * NWAVES : NGW;
    for (int rp_ = 0; rp_ < P0_REP_TR; ++rp_)
    if (!tabler) for (int it = tw; it < NITEMS; it += NTW) {
        int r = it;
        if (r < I_IN) { if (r % (DIN / 64) < 24) tr_item(F.in[I_WIN], D, DIN, (bf16*)(F.ws + WS_WIN), 1, 0, nullptr, scr, r, F.lane);
                        else tr_item8(F.in[I_WIN], D, DIN, F.ws + WS_WING, 5, 0, nullptr, W8S, scr, r, F.lane); continue; } r -= I_IN;
        if (r < I_GLU) { tr_item(F.in[I_WGLU], DSSM, 2 * D, (bf16*)(F.ws + WS_WGLU), 2, D, nullptr, scr, r, F.lane); continue; } r -= I_GLU;
        if (r < I_CO) { tr_item(F.in[I_WCO], DCONV, D, (bf16*)(F.ws + WS_WCO), 0, 0, nullptr, scr, r, F.lane); continue; } r -= I_CO;
        if (r < I_O) { tr_item(F.in[I_WOUT], D, D, (bf16*)(F.ws + WS_WO), 0, 0, nullptr, scr, r, F.lane); continue; } r -= I_O;
        if (r < I_PG) { tr_item8(F.in[I_WPG], D, D, F.ws + WS_WPG, 0, 0, F.in[I_GPLE], W8S, scr, r, F.lane); continue; } r -= I_PG;
        if (r < I_PLE) { tr_item(F.in[I_WPLE], DPLE, D, (bf16*)(F.ws + WS_WPLE), 0, 0, nullptr, scr, r, F.lane); continue; } r -= I_PLE;
        const int e = r / (2 * I_EG + I_ED); r -= e * (2 * I_EG + I_ED);
        if (r < I_EG) { tr_item8(F.in[I_WEG] + (size_t)e * D * DEXP, D, DEXP, F.ws + WS_WGU + (size_t)e * D * D, 3, 0, F.in[I_GMOE], W8S, scr, r, F.lane); continue; } r -= I_EG;
        if (r < I_EG) { tr_item8(F.in[I_WEU] + (size_t)e * D * DEXP, D, DEXP, F.ws + WS_WGU + (size_t)e * D * D, 4, 0, F.in[I_GMOE], W8S, scr, r, F.lane); continue; } r -= I_EG;
        tr_item8(F.in[I_WED] + (size_t)e * DEXP * D, DEXP, D, F.ws + WS_WD + (size_t)e * D * DEXP, 0, 0, nullptr, W8S, scr, r, F.lane);
    }
    for (int rp_ = 0; rp_ < P0_REP_ROWS; ++rp_) { const float* x = F.in[I_X]; const float* gm = F.in[I_GMIX]; bf16* XN = (bf16*)(F.ws + WS_B);
      f32x4 gv[4];
#pragma unroll
      for (int j = 0; j < 4; ++j) gv[j] = *(const f32x4*)(gm + 4 * F.lane + 256 * j);
      for (int m = gw; m < NTOK; m += NGW) {
        const GAS f32x4* xr = (const GAS f32x4*)(x + (size_t)m * D) + F.lane; f32x4 v[4]; float s = 0.f;
#pragma unroll
        for (int j = 0; j < 4; ++j) { v[j] = xr[64 * j]; s += (v[j].x * v[j].x + v[j].y * v[j].y) + (v[j].z * v[j].z + v[j].w * v[j].w); }
        const float r = 1.0f / sqrtf(wave_sum(s) * (1.f / D) + EPS);
        GAS v2u* o8 = (GAS v2u*)(XN + (size_t)m * D) + F.lane;
#pragma unroll
        for (int j = 0; j < 4; ++j) { const f32x4 h = v[j] * r * gv[j]; v2u o; o.x = pk2(h.x, h.y); o.y = pk2(h.z, h.w); o8[64 * j] = o;
            *((GAS unsigned*)(F.ws + WS_E + (size_t)m * D) + F.lane + 64 * j) = pk4f8(h.x, h.y, h.z, h.w); }
      } }
    { const float* p = F.in[I_P]; bf16* PB = (bf16*)(F.ws + WS_PB); const int gt = F.vcu * 512 + F.tid, NGT = F.G * 512;
      for (int q = gt; q < NTOK * DPLE / 8; q += NGT) { const f32x4 a = *(const f32x4*)(p + (size_t)q * 8), b = *(const f32x4*)(p + (size_t)q * 8 + 4);
        v4u o; o.x = pk2(a.x, a.y); o.y = pk2(a.z, a.w); o.z = pk2(b.x, b.y); o.w = pk2(b.z, b.w); *(GAS v4u*)(PB + (size_t)q * 8) = o; }
      bf16* WRT = (bf16*)(F.ws + WS_WRT); const float* gmoe = F.in[I_GMOE];
      for (int q = gt; q < 48 * 1024; q += NGT) { const int o = q >> 10, k = q & 1023; float v = 0.f;
        if (o < 4) v = F.in[I_WRG][k * 4 + o] * gmoe[k]; else if (o < 36) v = F.in[I_WRE][k * 32 + (o - 4)] * gmoe[k];
        const unsigned h = f2bf(v); const float lo = v - __builtin_bit_cast(float, h << 16); WRT[q] = (bf16)h; WRT[48 * 1024 + q] = (bf16)f2bf(lo); } }
}

using pg8::Unit;
typedef const f32x4 (&AccRef)[2][2][4][2];
struct EpiP1 {
    bf16* U; bf16* Z;
    __device__ __forceinline__ void operator()(AccRef acc, const Unit& u, int wr, int wc, int fr, int fq) const {
        const int r0 = u.pm * 256 + wr * 64 + fr;
        if (u.pn < 2) {
#pragma unroll
            for (int ai = 0; ai < 2; ++ai)
#pragma unroll
                for (int m = 0; m < 4; ++m) { const int r = r0 + ai * 128 + m * 16, b = r >> 11, t = r & 2047;
#pragma unroll
                    for (int bj = 0; bj < 2; ++bj) { const int c0 = u.pn * 256 + bj * 128 + wc * 32 + fq * 8, g = c0 >> 4, ch0 = c0 & 15;
                        const f32x4 v0 = acc[ai][bj][m][0], v1 = acc[ai][bj][m][1];
                        v4u w; w.x = pk2(v0[0], v0[1]); w.y = pk2(v0[2], v0[3]); w.z = pk2(v1[0], v1[1]); w.w = pk2(v1[2], v1[3]);
                        *(GAS v4u*)(U + (((size_t)(b * 32 + g) * 2048 + t) * 16 + ch0)) = w; } }
        } else {
#pragma unroll
            for (int ai = 0; ai < 2; ++ai)
#pragma unroll
                for (int m = 0; m < 4; ++m) { const int r = r0 + ai * 128 + m * 16;
#pragma unroll
                    for (int bj = 0; bj < 2; ++bj) { const int o0 = (u.pn - 2) * 128 + bj * 64 + wc * 16 + fq * 4;
                        const f32x4 va = acc[ai][bj][m][0], ga = acc[ai][bj][m][1];
                        v2u w; w.x = pk2(va[0] * sigm(ga[0]), va[1] * sigm(ga[1])); w.y = pk2(va[2] * sigm(ga[2]), va[3] * sigm(ga[3]));
                        *(GAS v2u*)(Z + (size_t)r * 512 + o0) = w; } }
        }
    }
};
struct EpiGate {
    bf16* SG; const float* bg;
    __device__ __forceinline__ void operator()(AccRef acc, const Unit& u, int wr, int wc, int fr, int fq) const {
        const int r0 = u.pm * 256 + wr * 64 + fr;
#pragma unroll
        for (int bj = 0; bj < 2; ++bj) { const int s0 = u.pn * 256 + bj * 128 + wc * 32 + fq * 8;
            const f32x4 b0 = *(const f32x4*)(bg + s0), b1 = *(const f32x4*)(bg + s0 + 4);
#pragma unroll
            for (int ai = 0; ai < 2; ++ai)
#pragma unroll
                for (int m = 0; m < 4; ++m) { const int r = r0 + ai * 128 + m * 16;
                    const f32x4 v0 = acc[ai][bj][m][0] * W8I + b0, v1 = acc[ai][bj][m][1] * W8I + b1;
                    v4u w; w.x = pk2(sigm(v0[0]), sigm(v0[1])); w.y = pk2(sigm(v0[2]), sigm(v0[3])); w.z = pk2(sigm(v1[0]), sigm(v1[1])); w.w = pk2(sigm(v1[2]), sigm(v1[3]));
                    *(GAS v4u*)(SG + (size_t)r * 2048 + s0) = w; } }
    }
};
struct EpiGlu {
    bf16* MS; const bf16* SG;
    static __device__ __forceinline__ void run(AccRef acc, const Unit& u, int wr, int wc, int fr, int fq, bf16* __restrict__ MS, const bf16* __restrict__ SG) {
        const int r0 = u.pm * 256 + wr * 64 + fr;
#pragma unroll
        for (int ai = 0; ai < 2; ++ai)
#pragma unroll
            for (int m = 0; m < 4; ++m) { const int r = r0 + ai * 128 + m * 16;
#pragma unroll
                for (int bj = 0; bj < 2; ++bj) { const int o0 = u.pn * 128 + bj * 64 + wc * 16 + fq * 4;
                    const v2u sg = *(const GAS v2u*)(SG + (size_t)r * 2048 + o0);
                    const f32x4 va = acc[ai][bj][m][0], ga = acc[ai][bj][m][1];
                    v2u o; o.x = pk2(va[0] * sigm(ga[0]) * bflo(sg.x), va[1] * sigm(ga[1]) * bfhi(sg.x)); o.y = pk2(va[2] * sigm(ga[2]) * bflo(sg.y), va[3] * sigm(ga[3]) * bfhi(sg.y));
                    *(GAS v2u*)(MS + (size_t)r * 1024 + o0) = o; } }
    }
    __device__ __forceinline__ void operator()(AccRef acc, const Unit& u, int wr, int wc, int fr, int fq) const { run(acc, u, wr, wc, fr, fq, MS, SG); }
};
struct EpiCo {
    const bf16* MS; const bf16* SG; bf16* MG;
    static __device__ __forceinline__ void run(AccRef acc, const Unit& u, int wr, int wc, int fr, int fq, const bf16* __restrict__ MS, const bf16* __restrict__ SG, bf16* __restrict__ MG) {
        const int r0 = u.pm * 256 + wr * 64 + fr;
#pragma unroll
        for (int ai = 0; ai < 2; ++ai)
#pragma unroll
            for (int m = 0; m < 4; ++m) { const int r = r0 + ai * 128 + m * 16;
#pragma unroll
                for (int bj = 0; bj < 2; ++bj) { const int c0 = u.pn * 256 + bj * 128 + wc * 32 + fq * 8;
                    const v4u ms = *(const GAS v4u*)(MS + (size_t)r * 1024 + c0);
                    const v4u sg = *(const GAS v4u*)(SG + (size_t)r * 2048 + 1024 + c0);
                    const f32x4 v0 = acc[ai][bj][m][0], v1 = acc[ai][bj][m][1];
                    v4u w; w.x = pk2(bflo(ms.x) + bflo(sg.x) * v0[0], bfhi(ms.x) + bfhi(sg.x) * v0[1]); w.y = pk2(bflo(ms.y) + bflo(sg.y) * v0[2], bfhi(ms.y) + bfhi(sg.y) * v0[3]);
                    w.z = pk2(bflo(ms.z) + bflo(sg.z) * v1[0], bfhi(ms.z) + bfhi(sg.z) * v1[1]); w.w = pk2(bflo(ms.w) + bflo(sg.w) * v1[2], bfhi(ms.w) + bfhi(sg.w) * v1[3]);
                    *(GAS v4u*)(MG + (size_t)r * 1024 + c0) = w; } }
    }
    __device__ __forceinline__ void operator()(AccRef acc, const Unit& u, int wr, int wc, int fr, int fq) const { run(acc, u, wr, wc, fr, fq, MS, SG, MG); }
};
struct EpiRes {
    const float* X; bf16* X1B; unsigned char* X1F;
    static __device__ __forceinline__ void run(AccRef acc, const Unit& u, int wr, int wc, int fr, int fq, const float* __restrict__ X, bf16* __restrict__ X1B, unsigned char* __restrict__ X1F) {
        const int r0 = u.pm * 256 + wr * 64 + fr;
#pragma unroll
        for (int ai = 0; ai < 2; ++ai)
#pragma unroll
            for (int m = 0; m < 4; ++m) { const int r = r0 + ai * 128 + m * 16;
#pragma unroll
                for (int bj = 0; bj < 2; ++bj) { const size_t o = (size_t)r * 1024 + u.pn * 256 + bj * 128 + wc * 32 + fq * 8;
                    const f32x4 x0 = *(const GAS f32x4*)(X + o) + acc[ai][bj][m][0], x1 = *(const GAS f32x4*)(X + o + 4) + acc[ai][bj][m][1];
                    v4u w; w.x = pk2(x0[0], x0[1]); w.y = pk2(x0[2], x0[3]); w.z = pk2(x1[0], x1[1]); w.w = pk2(x1[2], x1[3]);
                    *(GAS v4u*)(X1B + o) = w;
                    v2u f; f.x = pk4f8(x0[0], x0[1], x0[2], x0[3]); f.y = pk4f8(x1[0], x1[1], x1[2], x1[3]); *(GAS v2u*)(X1F + o) = f; } }
    }
    __device__ __forceinline__ void operator()(AccRef acc, const Unit& u, int wr, int wc, int fr, int fq) const { run(acc, u, wr, wc, fr, fq, X, X1B, X1F); }
};
struct EpiAct {
    unsigned char* ACT; const int* ltok; const float* R2;
    static __device__ __forceinline__ void run(AccRef acc, const Unit& u, int wr, int wc, int fr, int fq, unsigned char* __restrict__ ACT, const int* __restrict__ ltok, const float* __restrict__ R2) {
        float rr[2][4];
#pragma unroll
        for (int ai = 0; ai < 2; ++ai)
#pragma unroll
            for (int m = 0; m < 4; ++m) { const int rl = ai * 128 + wr * 64 + m * 16 + fr; const int tok = (rl < u.rows) ? ltok[u.e * NTOK + u.mt * 256 + rl] : 0; rr[ai][m] = R2[tok] * W8I; }
#pragma unroll
        for (int ai = 0; ai < 2; ++ai)
#pragma unroll
            for (int m = 0; m < 4; ++m) { const int rl = ai * 128 + wr * 64 + m * 16 + fr;
                if (rl < u.rows) {
#pragma unroll
                    for (int bj = 0; bj < 2; ++bj) { const int o0 = u.pn * 128 + bj * 64 + wc * 16 + fq * 4;
                        const f32x4 ga = acc[ai][bj][m][0] * rr[ai][m], ua = acc[ai][bj][m][1] * rr[ai][m];
                        *(GAS unsigned*)(ACT + (size_t)(u.pm * 256 + rl) * 512 + o0) = pk4f8(ga[0] * sigm(ga[0]) * ua[0], ga[1] * sigm(ga[1]) * ua[1], ga[2] * sigm(ga[2]) * ua[2], ga[3] * sigm(ga[3]) * ua[3]); } } }
    }
    __device__ __forceinline__ void operator()(AccRef acc, const Unit& u, int wr, int wc, int fr, int fq) const { run(acc, u, wr, wc, fr, fq, ACT, ltok, R2); }
};
struct EpiY {
    bf16* Y;
    __device__ __forceinline__ void operator()(AccRef acc, const Unit& u, int wr, int wc, int fr, int fq) const {
#pragma unroll
        for (int ai = 0; ai < 2; ++ai)
#pragma unroll
            for (int m = 0; m < 4; ++m) { const int rl = ai * 128 + wr * 64 + m * 16 + fr;
                if (rl < u.rows) {
#pragma unroll
                    for (int bj = 0; bj < 2; ++bj) { const f32x4 v0 = acc[ai][bj][m][0] * W8I, v1 = acc[ai][bj][m][1] * W8I;
                        v4u w; w.x = pk2(v0[0], v0[1]); w.y = pk2(v0[2], v0[3]); w.z = pk2(v1[0], v1[1]); w.w = pk2(v1[2], v1[3]);
                        *(GAS v4u*)(Y + (size_t)(u.cb + rl) * 1024 + u.pn * 256 + bj * 128 + wc * 32 + fq * 8) = w; } } }
    }
};
struct EpiE {
    bf16* EO;
    __device__ __forceinline__ void operator()(AccRef acc, const Unit& u, int wr, int wc, int fr, int fq) const {
        const int r0 = u.pm * 256 + wr * 64 + fr;
#pragma unroll
        for (int ai = 0; ai < 2; ++ai)
#pragma unroll
            for (int m = 0; m < 4; ++m) { const int r = r0 + ai * 128 + m * 16;
#pragma unroll
                for (int bj = 0; bj < 2; ++bj) { const size_t o = (size_t)r * 1024 + u.pn * 256 + bj * 128 + wc * 32 + fq * 8; const f32x4 v0 = acc[ai][bj][m][0], v1 = acc[ai][bj][m][1];
                    v4u w; w.x = pk2(v0[0], v0[1]); w.y = pk2(v0[2], v0[3]); w.z = pk2(v1[0], v1[1]); w.w = pk2(v1[2], v1[3]);
                    *(GAS v4u*)(EO + o) = w; } }
    }
};
struct EpiPle {
    const bf16* X2; const bf16* EO; const float* R3; bf16* X3;
    static __device__ __forceinline__ void run(AccRef acc, const Unit& u, int wr, int wc, int fr, int fq, const bf16* __restrict__ X2, const bf16* __restrict__ EO, const float* __restrict__ R3, bf16* __restrict__ X3) {
        const int r0 = u.pm * 256 + wr * 64 + fr;
#pragma unroll
        for (int ai = 0; ai < 2; ++ai)
#pragma unroll
            for (int m = 0; m < 4; ++m) { const int r = r0 + ai * 128 + m * 16; const float r3 = R3[r] * W8I;
#pragma unroll
                for (int bj = 0; bj < 2; ++bj) { const size_t o = (size_t)r * 1024 + u.pn * 256 + bj * 128 + wc * 32 + fq * 8;
                    const v4u x = *(const GAS v4u*)(X2 + o), e = *(const GAS v4u*)(EO + o);
                    const f32x4 a0 = acc[ai][bj][m][0] * r3, a1 = acc[ai][bj][m][1] * r3;
                    v4u w; w.x = pk2(bflo(x.x) + sigm(a0[0]) * bflo(e.x), bfhi(x.x) + sigm(a0[1]) * bfhi(e.x)); w.y = pk2(bflo(x.y) + sigm(a0[2]) * bflo(e.y), bfhi(x.y) + sigm(a0[3]) * bfhi(e.y));
                    w.z = pk2(bflo(x.z) + sigm(a1[0]) * bflo(e.z), bfhi(x.z) + sigm(a1[1]) * bfhi(e.z)); w.w = pk2(bflo(x.w) + sigm(a1[2]) * bflo(e.w), bfhi(x.w) + sigm(a1[3]) * bfhi(e.w));
                    *(GAS v4u*)(X3 + o) = w; } }
    }
    __device__ __forceinline__ void operator()(AccRef acc, const Unit& u, int wr, int wc, int fr, int fq) const { run(acc, u, wr, wc, fr, fq, X2, EO, R3, X3); }
};
struct DenseOrder : pg8::StaticOrder {
    const char* A; const char* Bt; size_t tstep;
    __device__ __forceinline__ const char* a_base(const Unit& u) const { return A + (size_t)u.pm * tstep; }
    __device__ __forceinline__ const char* b_base(const Unit& u) const { return Bt + (size_t)u.pn * tstep; }
    __device__ __forceinline__ unsigned row_off(const Unit&, int) const { return 0u; }
};
struct DenseRowsOrder : DenseOrder {
    __device__ __forceinline__ const char* a_base(const Unit&) const { return A; }
    __device__ __forceinline__ unsigned row_off(const Unit& u, int r) const { return (unsigned)(u.pm * 256 + r) * (unsigned)(tstep / 256); }
};
struct GluPairOrder : DenseOrder {
    __device__ __forceinline__ bool next(int i, Unit& u) const { if (i >= 2) return false; Unit t; if (!pg8::StaticOrder::next(0, t)) return false; u = t; u.pn = 2 * t.pn + i; return true; }
};
struct MoeOrder {
    const LAS int* tb; const LAS int* cn; int G, c, K, npn;
    const char* A; const char* Bt; size_t b_estride; const int* ltok; bool gather;
    __device__ __forceinline__ bool next(int i, Unit& u) const {
        const int L = i * G + c, total = tb[NEXP] * npn; if (L >= total) return false;
        const int tile = L / npn; int e = 0;
        for (int k = 1; k < NEXP; ++k) e += (tb[k] <= tile) ? 1 : 0;
        u.e = e; u.pm = tile; u.pn = L % npn; u.mt = tile - tb[e]; const int left = cn[e] - u.mt * 256; u.rows = left < 256 ? left : 256; u.cb = cn[33 + e] + u.mt * 256; return true;
    }
    __device__ __forceinline__ const char* a_base(const Unit& u) const { return gather ? A : A + (size_t)u.pm * 256 * K * 2; }
    __device__ __forceinline__ const char* b_base(const Unit& u) const { return Bt + (size_t)u.e * b_estride + (size_t)u.pn * 256 * K * 2; }
    __device__ __forceinline__ unsigned row_off(const Unit& u, int r) const { if (!ltok) return (unsigned)(u.pm * 256 + r) * (unsigned)(K * 2);
        const int tok = (r < u.rows) ? ltok[u.e * NTOK + u.mt * 256 + r] : 0; return (unsigned)tok * (unsigned)(K * 2); }
};

constexpr int SSM_AP = 1296;
__device__ __forceinline__ void ssm_unit(Frame& F, int b, int g) {
    LAS unsigned char* Al = F.lds;
    LAS float* SL = (LAS float*)(F.lds + 64 * SSM_AP);
    const int fr = F.lane & 15, fq = F.lane >> 4, w = F.wave;
    const bf16* Ug = (const bf16*)(F.ws + WS_C) + (size_t)(b * 32 + g) * 2048 * 16;
    const bf16* WS = (const bf16*)(F.ws + WS_WST) + ((size_t)g * 128 + 16 * w + fr) * 512 + 8 * fq;
    const bf16* BT = (const bf16*)(F.ws + WS_BT2) + ((size_t)g * 512 + 64 * w + fr) * 640 + 8 * fq;
    bf16x8 bw[16];
#pragma unroll
    for (int s = 0; s < 16; ++s) bw[s] = *(const GAS bf16x8*)(WS + 32 * s);
    {   v4u ut[8];
#pragma unroll
        for (int i = 0; i < 8; ++i) { const int q = F.tid + 512 * i; ut[i] = *(const GAS v4u*)(Ug + (q >> 6) * 512 + (q & 63) * 8); }
#pragma unroll
        for (int i = 0; i < 8; ++i) { const int q = F.tid + 512 * i; *(LAS v4u*)(Al + (q >> 6) * SSM_AP + (q & 63) * 16) = ut[i]; } }
    __syncthreads();
    {
        f32x4 acc[4];
#pragma unroll
        for (int m = 0; m < 4; ++m) acc[m] = (f32x4){0.f, 0.f, 0.f, 0.f};
#pragma unroll
        for (int s = 0; s < 16; ++s) {
#pragma unroll
            for (int m = 0; m < 4; ++m) { const bf16x8 a = *(const LAS bf16x8*)(Al + (16 * m + fr) * SSM_AP + (32 * s + 8 * fq) * 2); acc[m] = __builtin_amdgcn_mfma_f32_16x16x32_bf16(bw[s], a, acc[m], 0, 0, 0); } }
#pragma unroll
        for (int m = 0; m < 4; ++m) *(LAS f32x4*)(SL + (16 * m + fr) * 132 + 16 * w + 4 * fq) = acc[m];
    }
    bf16x8 bq[3][4];
#pragma unroll
    for (int st = 0; st < 3; ++st)
#pragma unroll
        for (int n = 0; n < 4; ++n) bq[st][n] = *(const GAS bf16x8*)(BT + (size_t)n * 16 * 640 + 32 * st);
    __syncthreads();
    if (w == 0) {
        const int n = F.lane; const float* l32 = (const float*)(F.ws + WS_LAM32) + (g * 64 + n) * 2; const float lr = l32[0], li = l32[1]; float sr = 0.f, si = 0.f;
        for (int c = 0; c < NCH; ++c) { *(LAS unsigned*)(Al + c * SSM_AP + 1024 + 4 * n) = pk2(sr, si);
            const float ur = SL[c * 132 + 2 * n], ui = SL[c * 132 + 2 * n + 1]; const float nr = lr * sr - li * si + ur, ni = lr * si + li * sr + ui; sr = nr; si = ni; }
    }
    __syncthreads();
    {
        f32x4 acc[4][4];
#pragma unroll
        for (int m = 0; m < 4; ++m)
#pragma unroll
            for (int n = 0; n < 4; ++n) acc[m][n] = (f32x4){0.f, 0.f, 0.f, 0.f};
#pragma unroll
        for (int s = 0; s < 20; ++s) { bf16x8 af[4];
#pragma unroll
            for (int m = 0; m < 4; ++m) af[m] = *(const LAS bf16x8*)(Al + (16 * m + fr) * SSM_AP + (32 * s + 8 * fq) * 2);
#pragma unroll
            for (int m = 0; m < 4; ++m)
#pragma unroll
                for (int n = 0; n < 4; ++n) acc[m][n] = __builtin_amdgcn_mfma_f32_16x16x32_bf16(bq[s % 3][n], af[m], acc[m][n], 0, 0, 0);
            if (s + 3 < 20) {
#pragma unroll
                for (int n = 0; n < 4; ++n) bq[s % 3][n] = *(const GAS bf16x8*)(BT + (size_t)n * 16 * 640 + 32 * (s + 3)); }
        }
        bf16* GY = (bf16*)(F.ws + WS_B);
#pragma unroll
        for (int m = 0; m < 4; ++m)
#pragma unroll
            for (int n = 0; n < 4; ++n) { const int tok = b * SEQ + LC * (16 * m + fr) + 4 * w + n; const f32x4 y = acc[m][n];
                v2u o; o.x = pk2(gelu_tanh(y[0]), gelu_tanh(y[1])); o.y = pk2(gelu_tanh(y[2]), gelu_tanh(y[3]));
                *(GAS v2u*)(GY + (size_t)tok * 512 + 16 * g + 4 * fq) = o; }
    }
    __syncthreads();
}
__device__ __forceinline__ void conv_tile(Frame& F, int tile) {
    const int tok0 = tile * 64, b = tok0 >> 11, t0 = tok0 & 2047;
    LAS unsigned* zl = (LAS unsigned*)F.lds;
    LAS float* red = (LAS float*)(F.lds + 98304);
    const bf16* Z = (const bf16*)(F.ws + WS_C + 16 * MiB);
#pragma unroll 2
    for (int q = F.tid; q < 94 * 64; q += 512) { const int rr = q >> 6, cc = q & 63, t = t0 - 30 + rr; v4u v = (v4u){0u, 0u, 0u, 0u};
        if (t >= 0) v = *(const GAS v4u*)(Z + (size_t)(b * SEQ + t) * 512 + cc * 8); *(LAS v4u*)(zl + rr * 256 + cc * 4) = v; }
    __syncthreads();
    const int wq = F.wave & 3, th = F.wave >> 2, cp = wq * 64 + F.lane;
    typedef float f32x2 __attribute__((ext_vector_type(2)));
    f32x2 dw[31];
    {   const float* pw = F.in[I_CDW] + 2 * cp;
#pragma unroll
        for (int k = 0; k < 31; ++k) { dw[k] = *(const GAS f32x2*)pw; pw += 512; asm volatile("" : "+v"(pw)); } }
    const f32x2 cb = *(const GAS f32x2*)(F.in[I_CDWB] + 2 * cp), lg = *(const GAS f32x2*)(F.in[I_CLNG] + 2 * cp), lb = *(const GAS f32x2*)(F.in[I_CLNB] + 2 * cp);
    bf16* CA = (bf16*)(F.ws + WS_B + 16 * MiB);
    const bool h5 = F.lane & 32, h4 = F.lane & 16, h3 = F.lane & 8, h2 = F.lane & 4;
#pragma unroll 1
    for (int ch = 0; ch < 4; ++ch) {
        f32x2 a[8];
#pragma unroll
        for (int o = 0; o < 8; ++o) a[o] = cb;
        const int rbase = th * 32 + ch * 8;
#pragma unroll
        for (int r = 0; r < 38; ++r) { const unsigned v = zl[(rbase + r) * 256 + cp]; const f32x2 x = {bflo(v), bfhi(v)};
#pragma unroll
            for (int o = 0; o < 8; ++o) { const int k = r - o; if (k >= 0 && k <= 30) a[o] = __builtin_elementwise_fma(dw[k], x, a[o]); }
            __builtin_amdgcn_sched_barrier(0); }
        float v16[16];
#pragma unroll
        for (int o = 0; o < 8; ++o) { v16[o] = a[o].x + a[o].y; v16[8 + o] = a[o].x * a[o].x + a[o].y * a[o].y; }
        float v8[8], v4[4], v2[2], v1;
#pragma unroll
        for (int i = 0; i < 8; ++i) { const float mine = h5 ? v16[8 + i] : v16[i], oth = h5 ? v16[i] : v16[8 + i]; v8[i] = mine + __shfl_xor(oth, 32); }
#pragma unroll
        for (int i = 0; i < 4; ++i) { const float mine = h4 ? v8[4 + i] : v8[i], oth = h4 ? v8[i] : v8[4 + i]; v4[i] = mine + __shfl_xor(oth, 16); }
#pragma unroll
        for (int i = 0; i < 2; ++i) { const float mine = h3 ? v4[2 + i] : v4[i], oth = h3 ? v4[i] : v4[2 + i]; v2[i] = mine + __shfl_xor(oth, 8); }
        { const float mine = h2 ? v2[1] : v2[0], oth = h2 ? v2[0] : v2[1]; v1 = mine + __shfl_xor(oth, 4); }
        v1 += __shfl_xor(v1, 2); v1 += __shfl_xor(v1, 1);
        LAS float* rp = red + ((ch & 1) * 2 + th) * 64;
        if ((F.lane & 3) == 0) { const int idx = (F.lane >> 2) & 15; rp[((idx & 7) * 4 + wq) * 2 + (idx >> 3)] = v1; }
        __syncthreads();
#pragma unroll
        for (int o = 0; o < 8; ++o) { float sm = 0.f, q = 0.f;
#pragma unroll
            for (int k = 0; k < 4; ++k) { sm += rp[(o * 4 + k) * 2]; q += rp[(o * 4 + k) * 2 + 1]; }
            const float mean = sm * (1.f / 512.f), var = q * (1.f / 512.f) - mean * mean, rstd = __builtin_amdgcn_rsqf(var + EPS);
            const f32x2 y = (a[o] - mean) * rstd * lg + lb;
            *(GAS unsigned*)(CA + (size_t)(tok0 + rbase + o) * 512 + 2 * cp) = pk2(y.x * sigm(y.x), y.y * sigm(y.y)); }
    }
    __syncthreads();
}
__device__ __forceinline__ void router_phase(Frame& F) {
    const int fr = F.lane & 15, fq = F.lane >> 4, tp = F.wave & 1, kq = F.wave >> 1, tl = F.wave & 3, kh = F.wave >> 2;
    const bf16* XB = (const bf16*)(F.ws + WS_B); float* R2 = (float*)(F.ws + WS_R2);
    const bf16* WRT = (const bf16*)(F.ws + WS_WRT); int* ltok = (int*)(F.ws + WS_LTOK); int* tinfo = (int*)(F.ws + WS_TINFO);
    LAS float* part = (LAS float*)(F.lds + 16384);
    LAS float* lg = (LAS float*)(F.lds + tl * 4096);
    LAS unsigned* lcnt = (LAS unsigned*)(F.lds + 81920);
    LAS unsigned* lbase = lcnt + 32;
    LAS unsigned* dec = lcnt + 64;
    if (F.tid < NEXP) lcnt[F.tid] = 0u;
    __syncthreads();
    for (int tg = F.vcu; tg < NTOK / 64; tg += F.G) {
        const bf16* xr = XB + (size_t)(tg * 64 + tp * 32 + fr) * D + 256 * kq + 8 * fq; const bf16* wh = WRT + (size_t)fr * D + 256 * kq + 8 * fq;
        f32x4 acc[2][3]; float ss[2] = {0.f, 0.f};
#pragma unroll
        for (int t = 0; t < 2; ++t)
#pragma unroll
            for (int n = 0; n < 3; ++n) acc[t][n] = (f32x4){0.f, 0.f, 0.f, 0.f};
#pragma unroll
        for (int s = 0; s < 8; ++s) {
            bf16x8 wf[3];
#pragma unroll
            for (int n = 0; n < 3; ++n) wf[n] = *(const GAS bf16x8*)(wh + (size_t)n * 16 * D + 32 * s);
#pragma unroll
            for (int t = 0; t < 2; ++t) { const v4u h = *(const GAS v4u*)(xr + (size_t)t * 16 * D + 32 * s);
                const float a0 = bflo(h.x), a1 = bfhi(h.x), a2 = bflo(h.y), a3 = bfhi(h.y), a4 = bflo(h.z), a5 = bfhi(h.z), a6 = bflo(h.w), a7 = bfhi(h.w);
                ss[t] += (a0 * a0 + a1 * a1) + (a2 * a2 + a3 * a3) + (a4 * a4 + a5 * a5) + (a6 * a6 + a7 * a7);
                const bf16x8 xh = __builtin_bit_cast(bf16x8, h);
#pragma unroll
                for (int n = 0; n < 3; ++n) acc[t][n] = __builtin_amdgcn_mfma_f32_16x16x32_bf16(wf[n], xh, acc[t][n], 0, 0, 0); }
        }
#pragma unroll
        for (int t = 0; t < 2; ++t) { ss[t] += __shfl_xor(ss[t], 16); ss[t] += __shfl_xor(ss[t], 32);
            LAS float* pp = part + ((kq * 4 + 2 * tp + t) * 64 + F.lane) * 13;
#pragma unroll
            for (int n = 0; n < 3; ++n)
#pragma unroll
                for (int j = 0; j < 4; ++j) pp[4 * n + j] = acc[t][n][j];
            pp[12] = ss[t]; }
        __syncthreads();
        const int tile = tg * 4 + tl, tok = tile * 16 + fr;
        if (kh == 0) {
            float lsum[12], ssum = 0.f;
#pragma unroll
            for (int i = 0; i < 12; ++i) lsum[i] = 0.f;
#pragma unroll
            for (int q = 0; q < 4; ++q) { const LAS float* pp = part + ((q * 4 + tl) * 64 + F.lane) * 13;
#pragma unroll
                for (int i = 0; i < 12; ++i) lsum[i] += pp[i];
                ssum += pp[12]; }
            const float r = 1.0f / sqrtf(ssum * (1.f / D) + EPS);
            if (fq == 0) R2[tok] = r;
#pragma unroll
            for (int n = 0; n < 3; ++n)
#pragma unroll
                for (int j = 0; j < 4; ++j) { const int o = 16 * n + 4 * fq + j; if (o < 36) { const float bias = o < 4 ? F.in[I_BRG][o] : F.in[I_BRE2][o - 4]; lg[fr * 49 + o] = lsum[4 * n + j] * r + bias; } }
            LDS_WAIT(); asm volatile("" ::: "memory");
            if (F.lane < 16) {
                const LAS float* l = lg + F.lane * 49;
                float gm = l[0]; int gs = 0;
#pragma unroll
                for (int i = 1; i < 4; ++i) if (l[i] > gm) { gm = l[i]; gs = i; }
                float den = 0.f;
#pragma unroll
                for (int i = 0; i < 4; ++i) den += __expf(l[i] - gm);
                const float pg = 1.0f / den;
                const LAS float* el = l + 4 + 8 * gs;
                float v1 = el[0]; int j1 = 0;
#pragma unroll
                for (int i = 1; i < 8; ++i) if (el[i] > v1) { v1 = el[i]; j1 = i; }
                float v2 = -3.0e38f; int j2 = 0;
#pragma unroll
                for (int i = 0; i < 8; ++i) if (i != j1 && el[i] > v2) { v2 = el[i]; j2 = i; }
                const float w1 = pg / (1.0f + __expf(v2 - v1)), w2 = pg - w1;
                const int e1 = gs * 8 + j1, e2 = gs * 8 + j2;
                const unsigned s1 = __hip_atomic_fetch_add(lcnt + e1, 1u, __ATOMIC_RELAXED, __HIP_MEMORY_SCOPE_WORKGROUP), s2 = __hip_atomic_fetch_add(lcnt + e2, 1u, __ATOMIC_RELAXED, __HIP_MEMORY_SCOPE_WORKGROUP);
                LAS unsigned* dd = dec + (tl * 16 + F.lane) * 6; dd[0] = (unsigned)e1; dd[1] = s1; dd[2] = (unsigned)e2; dd[3] = s2; dd[4] = __builtin_bit_cast(unsigned, w1); dd[5] = __builtin_bit_cast(unsigned, w2);
            }
        }
        __syncthreads();
        if (F.tid < NEXP) { const unsigned c = lcnt[F.tid]; lbase[F.tid] = c ? __hip_atomic_fetch_add((unsigned*)(F.ctl + CW_ECNT + 64 * F.tid), c, RLX_AGENT) : 0u; lcnt[F.tid] = 0u; }
        __syncthreads();
        if (F.tid < 64) { const LAS unsigned* dd = dec + F.tid * 6; const int token = tg * 64 + F.tid; const int e1 = (int)dd[0], e2 = (int)dd[2]; const int s1 = (int)(lbase[e1] + dd[1]), s2 = (int)(lbase[e2] + dd[3]);
            ltok[e1 * NTOK + s1] = token; ltok[e2 * NTOK + s2] = token;
            typedef int i32x4 __attribute__((ext_vector_type(4))); *(GAS i32x4*)(tinfo + 4 * token) = (i32x4){e1 * NTOK + s1, e2 * NTOK + s2, (int)dd[4], (int)dd[5]}; }
        __syncthreads();
    }
}
__device__ __forceinline__ void rows_to_bf16(Frame& F, const float* X, bf16* XB, float* RR) {
    const int gw = F.vcu * NWAVES + F.wave, NGW = F.G * NWAVES;
    for (int m = gw; m < NTOK; m += NGW) {
        const GAS f32x4* xr = (const GAS f32x4*)(X + (size_t)m * D) + F.lane; f32x4 v[4]; float s = 0.f;
#pragma unroll
        for (int j = 0; j < 4; ++j) { v[j] = xr[64 * j]; s += (v[j].x * v[j].x + v[j].y * v[j].y) + (v[j].z * v[j].z + v[j].w * v[j].w); }
        const float r = 1.0f / sqrtf(wave_sum(s) * (1.f / D) + EPS);
        if (F.lane == 0) RR[m] = r;
        GAS v2u* o8 = (GAS v2u*)(XB + (size_t)m * D) + F.lane;
#pragma unroll
        for (int j = 0; j < 4; ++j) { v2u o; o.x = pk2(v[j].x, v[j].y); o.y = pk2(v[j].z, v[j].w); o8[64 * j] = o; }
    }
}
__device__ __forceinline__ void moe_combine_rows(Frame& F, const bf16* __restrict__ XB, const bf16* __restrict__ Y, bf16* __restrict__ XO, unsigned char* __restrict__ XF, float* __restrict__ RR) {
    const int gw = F.vcu * NWAVES + F.wave, NGW = F.G * NWAVES; const LAS int* cs = (const LAS int*)(F.lds + TB_OFF) + 66; const int* tinfo = (const int*)(F.ws + WS_TINFO);
    for (int m = gw; m < NTOK; m += NGW) {
        typedef int i32x4 __attribute__((ext_vector_type(4))); const i32x4 ti = *(const GAS i32x4*)(tinfo + 4 * m);
        const int r1 = cs[ti.x >> 14] + (ti.x & (NTOK - 1)), r2 = cs[ti.y >> 14] + (ti.y & (NTOK - 1)); const int wz = ti.z, ww = ti.w; const float w1 = __builtin_bit_cast(float, wz), w2 = __builtin_bit_cast(float, ww);
        const GAS v4u* xr = (const GAS v4u*)(XB + (size_t)m * D) + F.lane; GAS v4u* xo = (GAS v4u*)(XO + (size_t)m * D) + F.lane; const GAS v4u* y1 = (const GAS v4u*)(Y + (size_t)r1 * D) + F.lane; const GAS v4u* y2 = (const GAS v4u*)(Y + (size_t)r2 * D) + F.lane;
        v4u o[2]; float s = 0.f;
#pragma unroll
        for (int j = 0; j < 2; ++j) { const v4u x = xr[64 * j], a = y1[64 * j], b = y2[64 * j]; float v[8];
            v[0] = bflo(x.x) + w1 * bflo(a.x) + w2 * bflo(b.x); v[1] = bfhi(x.x) + w1 * bfhi(a.x) + w2 * bfhi(b.x); v[2] = bflo(x.y) + w1 * bflo(a.y) + w2 * bflo(b.y); v[3] = bfhi(x.y) + w1 * bfhi(a.y) + w2 * bfhi(b.y);
            v[4] = bflo(x.z) + w1 * bflo(a.z) + w2 * bflo(b.z); v[5] = bfhi(x.z) + w1 * bfhi(a.z) + w2 * bfhi(b.z); v[6] = bflo(x.w) + w1 * bflo(a.w) + w2 * bflo(b.w); v[7] = bfhi(x.w) + w1 * bfhi(a.w) + w2 * bfhi(b.w);
            o[j].x = pk2(v[0], v[1]); o[j].y = pk2(v[2], v[3]); o[j].z = pk2(v[4], v[5]); o[j].w = pk2(v[6], v[7]);
            { v2u f; f.x = pk4f8(v[0], v[1], v[2], v[3]); f.y = pk4f8(v[4], v[5], v[6], v[7]); *((GAS v2u*)(XF + (size_t)m * D) + F.lane + 64 * j) = f; }
            const float q0 = bflo(o[j].x), q1 = bfhi(o[j].x), q2 = bflo(o[j].y), q3 = bfhi(o[j].y), q4 = bflo(o[j].z), q5 = bfhi(o[j].z), q6 = bflo(o[j].w), q7 = bfhi(o[j].w);
            s += (q0 * q0 + q1 * q1) + (q2 * q2 + q3 * q3) + (q4 * q4 + q5 * q5) + (q6 * q6 + q7 * q7); }
        const float r = 1.0f / sqrtf(wave_sum(s) * (1.f / D) + EPS);
        if (F.lane == 0) RR[m] = r;
#pragma unroll
        for (int j = 0; j < 2; ++j) xo[64 * j] = o[j];
    }
}
__device__ __forceinline__ void final_norm(Frame& F, const bf16* X, float* out, const float* gf) {
    const int gw = F.vcu * NWAVES + F.wave, NGW = F.G * NWAVES;
    f32x4 gv[2][2];
#pragma unroll
    for (int j = 0; j < 2; ++j) { gv[j][0] = *(const f32x4*)(gf + 8 * F.lane + 512 * j); gv[j][1] = *(const f32x4*)(gf + 8 * F.lane + 512 * j + 4); }
    for (int m = gw; m < NTOK; m += NGW) {
        const GAS v4u* xr = (const GAS v4u*)(X + (size_t)m * D) + F.lane; f32x4 v[2][2]; float s = 0.f;
#pragma unroll
        for (int j = 0; j < 2; ++j) { const v4u x = xr[64 * j]; v[j][0] = (f32x4){bflo(x.x), bfhi(x.x), bflo(x.y), bfhi(x.y)}; v[j][1] = (f32x4){bflo(x.z), bfhi(x.z), bflo(x.w), bfhi(x.w)};
            s += (v[j][0].x * v[j][0].x + v[j][0].y * v[j][0].y) + (v[j][0].z * v[j][0].z + v[j][0].w * v[j][0].w) + (v[j][1].x * v[j][1].x + v[j][1].y * v[j][1].y) + (v[j][1].z * v[j][1].z + v[j][1].w * v[j][1].w); }
        const float r = 1.0f / sqrtf(wave_sum(s) * (1.f / D) + EPS);
        GAS f32x4* o = (GAS f32x4*)(out + (size_t)m * D) + 2 * F.lane;
#pragma unroll
        for (int j = 0; j < 2; ++j) { o[128 * j] = v[j][0] * r * gv[j][0]; o[128 * j + 1] = v[j][1] * r * gv[j][1]; }
    }
}
__device__ __forceinline__ void moe_tables(Frame& F) {
    LAS int* tb = (LAS int*)(F.lds + TB_OFF); LAS int* cn = tb + 33; LAS int* cs = cn + 33;
    if (F.tid == 0) { int t = 0, r = 0; for (int e = 0; e < NEXP; ++e) { const int c = (int)__hip_atomic_load((unsigned*)(F.ctl + CW_ECNT + 64 * e), RLX_AGENT); cn[e] = c; tb[e] = t; cs[e] = r; t += (c + 255) >> 8; r += c; } tb[NEXP] = t; cs[NEXP] = r; }
    __syncthreads();
}

struct Args { const float* in[N_IN]; float* out; unsigned char* ws; int ph_lo, ph_hi; };
__global__ void __launch_bounds__(NWAVES * 64, 2) mk_fwd(Args args) {
    extern __shared__ __attribute__((aligned(16))) unsigned char lds[];
    Frame F;
    F.lds = (LAS unsigned char*)lds;
    F.MISC = (volatile LAS unsigned*)(F.lds + MISC_OFF);
    F.tid = threadIdx.x; F.lane = F.tid & 63; F.wave = __builtin_amdgcn_readfirstlane(F.tid >> 6);
    const int wave_s = F.wave;
    F.G = gridDim.x; { const int bx = blockIdx.x; F.vcu = (F.G % 8 == 0) ? (bx % 8) * (F.G / 8) + bx / 8 : bx; }
    F.in = args.in; F.out = args.out; F.ws = args.ws; F.ctl = (gu32*)(args.ws + WS_CTL);
    for (int u = F.tid; u < (LDS_BYTES - LDSCTL_OFF) / 4; u += NWAVES * 64) ((LAS unsigned*)(F.lds + LDSCTL_OFF))[u] = 0u;
    __syncthreads();
    if (N_LAUNCHES != PER_PHASE) (void)xcd_barrier_post((unsigned*)(F.ctl + CW_BAR), F.MISC + 8);
#define GRID_BAR() do { if (N_LAUNCHES == PER_PHASE) { if (F.tid == 0) __hip_atomic_store(F.ctl + CW_TMO, 0xBADBA0u, RLX_AGENT); } else { \
        XcdBarrier bb_; bb_.bar = (unsigned*)(F.ctl + CW_BAR); bb_.x = xb_xcc_id(); bb_.st = (volatile LAS unsigned*)(F.lds + MISC_OFF) + 8; bb_.wv = wave_s; xcd_barrier(bb_); } } while (0)
#define PHASE_BEGIN() do { int l_ = (int)__builtin_amdgcn_mbcnt_hi(~0u, __builtin_amdgcn_mbcnt_lo(~0u, 0u)); asm volatile("" : "+v"(l_)); F.lane = l_; F.wave = wave_s; F.tid = wave_s * 64 + l_; \
        unsigned long long w_ = (unsigned long long)args.ws; asm volatile("" : "+s"(w_)); ws = (unsigned char*)(GAS unsigned char*)w_; F.ws = ws; F.ctl = (gu32*)(ws + WS_CTL); } while (0)
    const int lo = args.ph_lo, hi = args.ph_hi;
#ifndef PHASE_MASK
#define PHASE_MASK 0x1FFF
#endif
#define IN(k) (lo <= (k) && (k) < hi && ((PHASE_MASK >> (k)) & 1))
#define BOTH(k) (IN(k) && IN((k) + 1))
#ifndef REP_MASK
#define REP_MASK 0
#endif
#define REPS(k) (((REP_MASK >> (k)) & 1) ? 2 : 1)
    unsigned char* ws = args.ws;
    const size_t TS1024 = (size_t)256 * 1024 * 2, TS512 = (size_t)256 * 512 * 2, TS256 = (size_t)256 * 256 * 2;

    if (IN(0)) for (int rep_ = 0; rep_ < REPS(0); ++rep_) { PHASE_BEGIN(); p0_prologue(F); if (BOTH(0)) GRID_BAR(); }
    if (IN(1)) for (int rep_ = 0; rep_ < REPS(1); ++rep_) {
        PHASE_BEGIN();
        {
            DenseRowsOrder S; S.init(NTOK, 2 * D, F.G, (int)blockIdx.x); S.A = (const char*)(ws + WS_E); S.Bt = (const char*)(ws + WS_WING); S.tstep = TS512;
            EpiGate E{(bf16*)F.out, F.in[I_BGATE]};
            pg8::gemm_phase<EpiGate, DenseRowsOrder, true, true, true>(F.lds + RING_OFF, F.tid, D / 2, S, E); }
        {
            DenseOrder S; S.init(NTOK, 1536, F.G, (int)blockIdx.x); S.A = (const char*)(ws + WS_B); S.Bt = (const char*)(ws + WS_WIN); S.tstep = TS1024;
            EpiP1 E{(bf16*)(ws + WS_C), (bf16*)(ws + WS_C + 16 * MiB)};
            pg8::gemm_phase<EpiP1, DenseOrder>(F.lds + RING_OFF, F.tid, D, S, E); }
        {
            const int nfull = (NTOK / 256) * (1536 / 256) / F.G, heavy = (NTOK / 256) * (1536 / 256) - nfull * F.G;
            const int nl = F.G - heavy; const bool spread = heavy > 0 && 2 * nl >= (NTOK / 256) * (D / 256);
            DenseOrder S2; S2.A = (const char*)(ws + WS_PB); S2.Bt = (const char*)(ws + WS_WPLE); S2.tstep = TS256;
            if (spread) S2.init(NTOK, D, nl, (int)blockIdx.x - heavy); else S2.init(NTOK, D, F.G, (int)blockIdx.x);
            EpiE E2{(bf16*)(ws + WS_E + 32 * MiB)};
            if (!spread || (int)blockIdx.x >= heavy) pg8::gemm_phase<EpiE, DenseOrder>(F.lds + RING_OFF, F.tid, DPLE, S2, E2);
        }
        if (BOTH(1)) GRID_BAR();
    }
    if (IN(2)) for (int rep_ = 0; rep_ < REPS(2); ++rep_) {
        PHASE_BEGIN();
#ifndef NO_SSM
#ifndef P2_REP_SSM
#define P2_REP_SSM 1
#define P2_REP_CONV 1
#endif
        for (int rp_ = 0; rp_ < P2_REP_SSM; ++rp_)
        for (int u = F.vcu; u < 8 * NGRP; u += F.G) { const int x = u / 32, idx = u % 32; ssm_unit(F, idx & 7, 4 * x + (idx >> 3)); }
#endif
#ifndef NO_CONV
        PHASE_BEGIN();
        for (int rp_ = 0; rp_ < P2_REP_CONV; ++rp_)
        for (int t = blockIdx.x; t < NTOK / 64; t += F.G) conv_tile(F, t);
#endif
        if (BOTH(2)) GRID_BAR();
    }
    if (IN(3)) for (int rep_ = 0; rep_ < REPS(3); ++rep_) {
        PHASE_BEGIN();
        DenseOrder S; S.init(NTOK, 2 * D, F.G, (int)blockIdx.x); S.A = (const char*)(ws + WS_B); S.Bt = (const char*)(ws + WS_WGLU); S.tstep = TS512;
        EpiGlu E{(bf16*)(ws + WS_E), (const bf16*)F.out};
        pg8::gemm_phase<EpiGlu, DenseOrder>(F.lds + RING_OFF, F.tid, DSSM, S, E);
        if (BOTH(3)) GRID_BAR();
    }
    if (IN(4)) for (int rep_ = 0; rep_ < REPS(4); ++rep_) {
        PHASE_BEGIN();
        DenseOrder S; S.init(NTOK, D, F.G, (int)blockIdx.x); S.A = (const char*)(ws + WS_B + 16 * MiB); S.Bt = (const char*)(ws + WS_WCO); S.tstep = TS512;
        EpiCo E{(const bf16*)(ws + WS_E), (const bf16*)F.out, (bf16*)(ws + WS_C)};
        pg8::gemm_phase<EpiCo, DenseOrder>(F.lds + RING_OFF, F.tid, DCONV, S, E);
        if (BOTH(4)) GRID_BAR();
    }
    if (IN(5)) for (int rep_ = 0; rep_ < REPS(5); ++rep_) {
        PHASE_BEGIN();
        DenseOrder S; S.init(NTOK, D, F.G, (int)blockIdx.x); S.A = (const char*)(ws + WS_C); S.Bt = (const char*)(ws + WS_WO); S.tstep = TS1024;
        EpiRes E{F.in[I_X], (bf16*)(ws + WS_B), ws + WS_E};
        pg8::gemm_phase<EpiRes, DenseOrder>(F.lds + RING_OFF, F.tid, D, S, E);
        if (BOTH(5)) GRID_BAR();
    }
    if (IN(6)) for (int rep_ = 0; rep_ < REPS(6); ++rep_) { PHASE_BEGIN(); router_phase(F); if (BOTH(6)) GRID_BAR();
        if (rep_ + 1 < REPS(6)) { if (blockIdx.x == 0 && F.tid < NEXP) __hip_atomic_store((unsigned*)(F.ctl + CW_ECNT + 64 * F.tid), 0u, RLX_AGENT); GRID_BAR(); } }
    if (IN(7)) for (int rep_ = 0; rep_ < REPS(7); ++rep_) {
        PHASE_BEGIN();
        moe_tables(F);
        MoeOrder S; S.tb = (const LAS int*)(F.lds + TB_OFF); S.cn = S.tb + 33; S.G = F.G; S.c = F.vcu; S.K = D / 2; S.npn = 4;
        S.A = (const char*)(ws + WS_E); S.Bt = (const char*)(ws + WS_WGU); S.b_estride = (size_t)D * D; S.ltok = (const int*)(ws + WS_LTOK); S.gather = true;
        EpiAct E{ws + WS_C, (const int*)(ws + WS_LTOK), (const float*)(ws + WS_R2)};
        pg8::gemm_phase<EpiAct, MoeOrder, true, true, true>(F.lds + RING_OFF, F.tid, D / 2, S, E);
        if (BOTH(7)) GRID_BAR();
    }
    if (IN(8)) for (int rep_ = 0; rep_ < REPS(8); ++rep_) {
        PHASE_BEGIN();
        moe_tables(F);
        MoeOrder S; S.tb = (const LAS int*)(F.lds + TB_OFF); S.cn = S.tb + 33; S.G = F.G; S.c = F.vcu; S.K = DEXP / 2; S.npn = 4;
        S.A = (const char*)(ws + WS_C); S.Bt = (const char*)(ws + WS_WD); S.b_estride = (size_t)D * DEXP; S.ltok = nullptr; S.gather = true;
        EpiY E{(bf16*)F.out};
        pg8::gemm_phase<EpiY, MoeOrder, true, true, true>(F.lds + RING_OFF, F.tid, DEXP / 2, S, E);
        if (BOTH(8)) GRID_BAR();
    }
    if (IN(9)) for (int rep_ = 0; rep_ < REPS(9); ++rep_) { PHASE_BEGIN(); moe_tables(F); moe_combine_rows(F, (const bf16*)(ws + WS_B), (const bf16*)F.out, (bf16*)(ws + WS_E), ws + WS_X2F, (float*)(ws + WS_R3)); if (BOTH(9)) GRID_BAR(); }
#ifdef DBG_SG_COPY
    if (lo <= 10 && 10 < hi) { const int gt = F.vcu * 512 + (int)threadIdx.x, NGT = F.G * 512; const bf16* sgp = (const bf16*)args.out + (size_t)DBG_SG_COPY * NTOK * D; float* dst = (float*)(args.ws + WS_E);
        for (int q = gt; q < NTOK * D; q += NGT) { const float v = bflo((unsigned)sgp[q]); const int col = q & 2047;
#ifdef DBG_SG_SEL_LO
            dst[q] = (v >= 0.f && v <= 1.f) ? 0.f : ((col >= DBG_SG_SEL_LO && col < DBG_SG_SEL_HI) ? 1000.f : 0.f);
#else
            dst[q] = v;
#endif
        } }
#endif
    if (IN(11)) for (int rep_ = 0; rep_ < REPS(11); ++rep_) {
        PHASE_BEGIN();
        DenseRowsOrder S; S.init(NTOK, D, F.G, (int)blockIdx.x); S.A = (const char*)(ws + WS_X2F); S.Bt = (const char*)(ws + WS_WPG); S.tstep = TS512;
        EpiPle E{(const bf16*)(ws + WS_E), (const bf16*)(ws + WS_E + 32 * MiB), (const float*)(ws + WS_R3), (bf16*)(ws + WS_C)};
        pg8::gemm_phase<EpiPle, DenseRowsOrder, true, true, true>(F.lds + RING_OFF, F.tid, D / 2, S, E);
        if (BOTH(11)) GRID_BAR();
    }
#ifdef DBG_DUMP_OFF
    if (hi == PER_PHASE) {   PHASE_BEGIN();
        const int gt = F.vcu * 512 + F.tid, NGT = F.G * 512;
#if DBG_DUMP_BF16
        const bf16* src = (const bf16*)(ws + (size_t)DBG_DUMP_OFF);
        for (int q = gt; q < NTOK * D; q += NGT) F.out[q] = bflo((unsigned)src[q]);
#else
        const float* src = (const float*)(ws + (size_t)DBG_DUMP_OFF);
        for (int q = gt; q < NTOK * D; q += NGT) F.out[q] = src[q];
#endif
    }
#else
    if (IN(12)) for (int rep_ = 0; rep_ < REPS(12); ++rep_) { PHASE_BEGIN(); final_norm(F, (const bf16*)(ws + WS_C), F.out, F.in[I_GFIN]); }
#endif
#undef IN
#undef BOTH
}

extern "C" void kernel_launch(void* const* d_in, const int* in_sizes, int n_in, void* d_out, int out_size, void* d_ws, size_t ws_size, hipStream_t stream) {
    static int grid = 0;
    if (grid == 0) {
        if (n_in != N_IN || in_sizes[0] != NTOK * D || out_size != NTOK * D || ws_size < WS_END) { fprintf(stderr, "kernel_launch: unexpected shapes (n_in %d, in0 %d, out %d, ws %zu; need ws >= %zu); nothing launched\n", n_in, n_in > 0 ? in_sizes[0] : -1, out_size, ws_size, (size_t)WS_END); grid = -1; return; }
        int dev = 0, cus = 0, per_cu = 0;
        if (hipGetDevice(&dev) != hipSuccess || hipDeviceGetAttribute(&cus, hipDeviceAttributeMultiprocessorCount, dev) != hipSuccess) { grid = -1; return; }
        if (hipFuncSetAttribute((const void*)mk_fwd, hipFuncAttributeMaxDynamicSharedMemorySize, LDS_BYTES) != hipSuccess) { fprintf(stderr, "kernel_launch: hipFuncSetAttribute failed\n"); grid = -1; return; }
        if (hipOccupancyMaxActiveBlocksPerMultiprocessor(&per_cu, (const void*)mk_fwd, NWAVES * 64, LDS_BYTES) != hipSuccess || per_cu < 1) { fprintf(stderr, "kernel_launch: occupancy query reports %d workgroups per CU\n", per_cu); (void)hipGetLastError(); grid = -1; return; }
        grid = cus;
    }
    if (grid < 0) return;
    if (hipMemsetAsync((char*)d_ws + WS_CTL, 0, CTL_ZERO_BYTES, stream) != hipSuccess) return;
    Args a{};
    for (int i = 0; i < N_IN; ++i) a.in[i] = (const float*)d_in[i];
    a.out = (float*)d_out; a.ws = (unsigned char*)d_ws;
    for (int li = 0; li < N_LAUNCHES; ++li) {
        a.ph_lo = (N_LAUNCHES == PER_PHASE) ? li : 0; a.ph_hi = (N_LAUNCHES == PER_PHASE) ? li + 1 : PER_PHASE;
        hipLaunchKernelGGL(mk_fwd, dim3(grid), dim3(NWAVES * 64), LDS_BYTES, stream, a);
        if (hipPeekAtLastError() != hipSuccess) { fprintf(stderr, "kernel_launch: launch %d failed\n", li); break; }
    }
}
```
